# Optimizing an MI355X kernel written in HIP

```python
import jax, jax.numpy as jnp
from jax import lax
import numpy as np

D_MODEL = 2048
BATCH = 4
SEQ = 4096
DEPTH = 2

BRANCH_WIDTH = D_MODEL // 2
N_BRANCHES = 4
EPS = 1e-6

SSD_HEAD_DIM = 64
SSD_HEADS = BRANCH_WIDTH // SSD_HEAD_DIM
SSD_GROUPS = 2
SSD_STATE = 128
SSD_CONV = 4
SSD_CHUNK = 128
SSD_XBC = BRANCH_WIDTH + 2 * SSD_GROUPS * SSD_STATE

FOX_HEAD_DIM = 64
FOX_HEADS = BRANCH_WIDTH // FOX_HEAD_DIM
Q_BLOCK = 128

GLA_HEADS = 4
GLA_KEY_DIM = 128
GLA_VAL_DIM = BRANCH_WIDTH // GLA_HEADS
GLA_GATE_RANK = 16
GLA_GATE_TAU = 16.0
GLA_CHUNK = 64

MLA_HEADS = 8
MLA_NOPE = 128
MLA_ROPE = 64
MLA_V = BRANCH_WIDTH // MLA_HEADS
MLA_Q_RANK = 512
MLA_KV_RANK = 512
ROPE_BASE = 10000.0

IN_SPLITS = (
    BRANCH_WIDTH, SSD_XBC, SSD_HEADS,
    BRANCH_WIDTH, BRANCH_WIDTH, BRANCH_WIDTH, FOX_HEADS, BRANCH_WIDTH,
    GLA_HEADS * GLA_KEY_DIM, GLA_HEADS * GLA_KEY_DIM, BRANCH_WIDTH, GLA_GATE_RANK, BRANCH_WIDTH,
    MLA_Q_RANK, MLA_KV_RANK, MLA_ROPE, BRANCH_WIDTH,
    N_BRANCHES * D_MODEL,
)
N_IN = sum(IN_SPLITS)

kernel_name = "hybrid_gated_parallel_mixer_trunk"


def rmsnorm(x, w):
    xf = x.astype(jnp.float32)
    y = xf * lax.rsqrt(jnp.mean(xf * xf, axis=-1, keepdims=True) + EPS)
    return (y * w.astype(jnp.float32)).astype(x.dtype)


def causal_depthwise_conv(x, w, b):
    ch = x.shape[-1]
    y = lax.conv_general_dilated(
        x, w[:, None, :].astype(x.dtype), window_strides=(1,),
        padding=[(SSD_CONV - 1, 0)], dimension_numbers=('NWC', 'WIO', 'NWC'),
        feature_group_count=ch)
    return y + b.astype(x.dtype)


def ssd_chunked(x, dt, a, b_in, c_in):
    bsz, s, h, p = x.shape
    g, n = b_in.shape[-2:]
    r = h // g
    L = SSD_CHUNK
    nc = s // L
    log_a = (dt * a).reshape(bsz, nc, L, g, r)
    xdt = (x.astype(jnp.float32) * dt[..., None]).reshape(bsz, nc, L, g, r, p)
    bc = b_in.astype(jnp.float32).reshape(bsz, nc, L, g, n)
    cc = c_in.astype(jnp.float32).reshape(bsz, nc, L, g, n)
    a_cum = jnp.cumsum(log_a, axis=2)
    seg = a_cum[:, :, :, None] - a_cum[:, :, None, :]
    causal = jnp.tril(jnp.ones((L, L), bool))[None, None, :, :, None, None]
    decay = jnp.where(causal, jnp.exp(jnp.minimum(seg, 0.0)), 0.0)
    cb = jnp.einsum('bclgn,bcsgn->bclsg', cc, bc)
    y_diag = jnp.einsum('bclsgr,bcsgrp->bclgrp', cb[..., None] * decay, xdt)
    decay_to_end = jnp.exp(a_cum[:, :, -1:] - a_cum)
    chunk_states = jnp.einsum('bclgn,bclgrp->bcgrpn', bc, xdt * decay_to_end[..., None])
    chunk_decay = jnp.exp(a_cum[:, :, -1])

    def step(state, inp):
        st, dec = inp
        return state * dec[..., None, None] + st, state

    h0 = jnp.zeros((bsz, g, r, p, n), jnp.float32)
    _, prev = lax.scan(step, h0, (chunk_states.transpose(1, 0, 2, 3, 4, 5),
                                  chunk_decay.transpose(1, 0, 2, 3)))
    prev = prev.transpose(1, 0, 2, 3, 4, 5)
    y_off = jnp.einsum('bclgn,bcgrpn->bclgrp', cc, prev) * jnp.exp(a_cum)[..., None]
    return (y_diag + y_off).reshape(bsz, s, h, p)


def gla_chunked(q, k, v, log_a):
    bsz, h, s, dk = q.shape
    dv = v.shape[-1]
    C = GLA_CHUNK
    nc = s // C

    def to_chunks(t):
        return t.astype(jnp.float32).reshape(bsz, h, nc, C, t.shape[-1]).transpose(2, 0, 1, 3, 4)

    causal = jnp.tril(jnp.ones((C, C), bool))[:, :, None]

    def step(state, inp):
        qc, kc, vc, gc = inp
        bcum = jnp.cumsum(gc, axis=2)
        diff = bcum[:, :, :, None, :] - bcum[:, :, None, :, :]
        decay = jnp.where(causal, jnp.exp(jnp.minimum(diff, 0.0)), 0.0)
        attn = jnp.einsum('bhijd,bhjd->bhij', qc[:, :, :, None, :] * decay, kc)
        o = (jnp.einsum('bhij,bhje->bhie', attn, vc)
             + jnp.einsum('bhid,bhde->bhie', qc * jnp.exp(bcum), state))
        b_last = bcum[:, :, -1:, :]
        state = (state * jnp.exp(b_last)[:, :, 0, :, None]
                 + jnp.einsum('bhjd,bhje->bhde', kc * jnp.exp(b_last - bcum), vc))
        return state, o

    s0 = jnp.zeros((bsz, h, dk, dv), jnp.float32)
    _, o = lax.scan(step, s0, (to_chunks(q), to_chunks(k), to_chunks(v), to_chunks(log_a)))
    return o.transpose(1, 2, 0, 3, 4).reshape(bsz, h, s, dv)


def causal_block_attention(q, k, v, scale, log_f_cum=None):
    bsz, h, s, dk = q.shape
    dv = v.shape[-1]
    nb = s // Q_BLOCK
    qb = q.reshape(bsz, h, nb, Q_BLOCK, dk).transpose(2, 0, 1, 3, 4)
    key_pos = jnp.arange(s)

    def one_block(args):
        i, q_blk = args
        start = i * Q_BLOCK
        logits = jnp.einsum('bhqd,bhkd->bhqk', q_blk, k).astype(jnp.float32) * scale
        if log_f_cum is not None:
            fq = lax.dynamic_slice_in_dim(log_f_cum, start, Q_BLOCK, axis=2)
            logits = logits + fq[..., :, None] - log_f_cum[..., None, :]
        q_pos = start + jnp.arange(Q_BLOCK)
        logits = jnp.where(key_pos[None, :] <= q_pos[:, None], logits, -jnp.inf)
        probs = jax.nn.softmax(logits, axis=-1).astype(v.dtype)
        return jnp.einsum('bhqk,bhkd->bhqd', probs, v)

    out = lax.map(one_block, (jnp.arange(nb), qb))
    return out.transpose(1, 2, 0, 3, 4).reshape(bsz, h, s, dv)


def apply_rope(t, cos, sin):
    half = MLA_ROPE // 2
    tf = t.astype(jnp.float32)
    t1, t2 = tf[..., :half], tf[..., half:]
    return jnp.concatenate([t1 * cos - t2 * sin, t1 * sin + t2 * cos], axis=-1).astype(t.dtype)


def hybrid_layer(x, positions, pre_norm, post_norm, w_in, conv_w, conv_b, dt_bias, a_log, d_skip,
                 ssm_norm, fgate_b, gla_w2, gla_b, gla_norm, q_norm, kv_norm, w_uq, w_ukv,
                 w_branch, w_out):
    bsz, s, _ = x.shape
    f32 = jnp.float32
    h = rmsnorm(x, pre_norm)
    proj = h @ w_in
    (m_z, m_xbc, m_dt, f_q, f_k, f_v, f_f, f_gate, g_q, g_k, g_v, g_lr, g_gate,
     l_cq, l_ckv, l_kr, l_gate, merge) = jnp.split(
        proj, np.cumsum(IN_SPLITS)[:-1].tolist(), axis=-1)

    def heads(t, nh):
        return t.reshape(bsz, s, nh, -1).transpose(0, 2, 1, 3)

    xbc = jax.nn.silu(causal_depthwise_conv(m_xbc, conv_w, conv_b))
    xs, bs, cs = jnp.split(xbc, [BRANCH_WIDTH, BRANCH_WIDTH + SSD_GROUPS * SSD_STATE], axis=-1)
    xs = xs.reshape(bsz, s, SSD_HEADS, SSD_HEAD_DIM)
    dt = jax.nn.softplus(m_dt.astype(f32) + dt_bias.astype(f32))
    a = -jnp.exp(a_log.astype(f32))
    y = ssd_chunked(xs, dt, a, bs.reshape(bsz, s, SSD_GROUPS, SSD_STATE),
                    cs.reshape(bsz, s, SSD_GROUPS, SSD_STATE))
    y = y + xs.astype(f32) * d_skip.astype(f32)[:, None]
    y = (y.reshape(bsz, s, BRANCH_WIDTH) * jax.nn.silu(m_z.astype(f32))).astype(x.dtype)
    out_a = rmsnorm(y.reshape(bsz, s, SSD_GROUPS, -1),
                    ssm_norm.reshape(SSD_GROUPS, -1)).reshape(bsz, s, BRANCH_WIDTH)

    log_f = jax.nn.log_sigmoid(f_f.astype(f32) + fgate_b.astype(f32))
    f_cum = jnp.cumsum(log_f, axis=1).transpose(0, 2, 1)
    o = causal_block_attention(heads(f_q, FOX_HEADS), heads(f_k, FOX_HEADS), heads(f_v, FOX_HEADS),
                               FOX_HEAD_DIM ** -0.5, f_cum)
    out_b = o.transpose(0, 2, 1, 3).reshape(bsz, s, BRANCH_WIDTH) * jax.nn.silu(f_gate)

    log_alpha = jax.nn.log_sigmoid((g_lr @ gla_w2 + gla_b).astype(f32)) / GLA_GATE_TAU
    o = gla_chunked(heads(g_q, GLA_HEADS).astype(f32) * GLA_KEY_DIM ** -0.5,
                    heads(g_k, GLA_HEADS), heads(g_v, GLA_HEADS), heads(log_alpha, GLA_HEADS))
    o = o.transpose(0, 2, 1, 3).astype(x.dtype)
    out_c = rmsnorm(o, gla_norm).reshape(bsz, s, BRANCH_WIDTH) * jax.nn.silu(g_gate)

    cq = rmsnorm(l_cq, q_norm)
    ckv = rmsnorm(l_ckv, kv_norm)
    q = (cq @ w_uq).reshape(bsz, s, MLA_HEADS, MLA_NOPE + MLA_ROPE)
    kv = (ckv @ w_ukv).reshape(bsz, s, MLA_HEADS, MLA_NOPE + MLA_V)
    inv_freq = 1.0 / (ROPE_BASE ** (jnp.arange(MLA_ROPE // 2, dtype=f32) * 2.0 / MLA_ROPE))
    ang = positions.astype(f32)[..., None] * inv_freq
    cos, sin = jnp.cos(ang), jnp.sin(ang)
    q_rope = apply_rope(q[..., MLA_NOPE:], cos[:, :, None], sin[:, :, None])
    k_rope = apply_rope(l_kr, cos, sin)
    q_full = jnp.concatenate([q[..., :MLA_NOPE], q_rope], axis=-1).transpose(0, 2, 1, 3)
    k_full = jnp.concatenate(
        [kv[..., :MLA_NOPE], jnp.broadcast_to(k_rope[:, :, None], (bsz, s, MLA_HEADS, MLA_ROPE))],
        axis=-1).transpose(0, 2, 1, 3)
    v = kv[..., MLA_NOPE:].transpose(0, 2, 1, 3)
    o = causal_block_attention(q_full, k_full, v, (MLA_NOPE + MLA_ROPE) ** -0.5)
    out_d = o.transpose(0, 2, 1, 3).reshape(bsz, s, BRANCH_WIDTH) * jax.nn.silu(l_gate)

    gates = jax.nn.sigmoid(merge.reshape(bsz, s, N_BRANCHES, D_MODEL))
    mixed = (gates[:, :, 0] * (out_a @ w_branch[0])
             + gates[:, :, 1] * (out_b @ w_branch[1])
             + gates[:, :, 2] * (out_c @ w_branch[2])
             + gates[:, :, 3] * (out_d @ w_branch[3]))
    return x + rmsnorm(mixed @ w_out, post_norm)


def setup_inputs(seed: int = 0) -> dict:
    key = jax.random.key(seed)
    ks = jax.random.split(key, 24)
    L = DEPTH
    nrm = jax.random.normal
    dt0 = jnp.exp(jax.random.uniform(ks[7], (L, SSD_HEADS)) * (np.log(0.1) - np.log(0.001)) + np.log(0.001))
    offsets = jax.random.randint(ks[1], (BATCH, 1), 0, 1024)
    return {
        'x': nrm(ks[0], (BATCH, SEQ, D_MODEL), jnp.float32),
        'positions': (offsets + jnp.arange(SEQ)[None, :]).astype(jnp.int32),
        'pre_norm': 1.0 + 0.02 * nrm(ks[2], (L, D_MODEL)),
        'post_norm': 1.0 + 0.02 * nrm(ks[3], (L, D_MODEL)),
        'w_in': nrm(ks[4], (L, D_MODEL, N_IN)) * D_MODEL ** -0.5,
        'conv_w': nrm(ks[5], (L, SSD_CONV, SSD_XBC)) * SSD_CONV ** -0.5,
        'conv_b': 0.02 * nrm(ks[6], (L, SSD_XBC)),
        'dt_bias': dt0 + jnp.log(-jnp.expm1(-dt0)),
        'a_log': jnp.log(jax.random.uniform(ks[8], (L, SSD_HEADS), minval=1.0, maxval=16.0)),
        'd_skip': 1.0 + 0.1 * nrm(ks[9], (L, SSD_HEADS)),
        'ssm_norm': 1.0 + 0.02 * nrm(ks[10], (L, BRANCH_WIDTH)),
        'fgate_b': jax.random.uniform(ks[11], (L, FOX_HEADS), minval=1.0, maxval=4.0),
        'gla_w2': nrm(ks[12], (L, GLA_GATE_RANK, GLA_HEADS * GLA_KEY_DIM)) * GLA_GATE_RANK ** -0.5,
        'gla_b': 0.02 * nrm(ks[13], (L, GLA_HEADS * GLA_KEY_DIM)),
        'gla_norm': 1.0 + 0.02 * nrm(ks[14], (L, GLA_VAL_DIM)),
        'q_norm': 1.0 + 0.02 * nrm(ks[15], (L, MLA_Q_RANK)),
        'kv_norm': 1.0 + 0.02 * nrm(ks[16], (L, MLA_KV_RANK)),
        'w_uq': nrm(ks[17], (L, MLA_Q_RANK, MLA_HEADS * (MLA_NOPE + MLA_ROPE))) * MLA_Q_RANK ** -0.5,
        'w_ukv': nrm(ks[18], (L, MLA_KV_RANK, MLA_HEADS * (MLA_NOPE + MLA_V))) * MLA_KV_RANK ** -0.5,
        'w_branch': nrm(ks[19], (L, N_BRANCHES, BRANCH_WIDTH, D_MODEL)) * BRANCH_WIDTH ** -0.5,
        'w_out': nrm(ks[20], (L, D_MODEL, D_MODEL)) * D_MODEL ** -0.5,
    }


def reference(x, positions, pre_norm, post_norm, w_in, conv_w, conv_b, dt_bias, a_log, d_skip,
              ssm_norm, fgate_b, gla_w2, gla_b, gla_norm, q_norm, kv_norm, w_uq, w_ukv,
              w_branch, w_out):
    for l in range(DEPTH):
        x = hybrid_layer(x, positions, pre_norm[l], post_norm[l], w_in[l], conv_w[l], conv_b[l],
                         dt_bias[l], a_log[l], d_skip[l], ssm_norm[l], fgate_b[l], gla_w2[l],
                         gla_b[l], gla_norm[l], q_norm[l], kv_norm[l], w_uq[l], w_ukv[l],
                         w_branch[l], w_out[l])
    return x
```

```cpp
#include <hip/hip_runtime.h>
#include <hip/hip_cooperative_groups.h>
#include <cstdio>
#include <cstdint>
namespace cg = cooperative_groups;

#ifndef PHMASK
#define PHMASK 0x1ff
#endif
#ifndef MLA_FAST
#define MLA_FAST false
#endif
#ifndef FOX_FAST
#define FOX_FAST true
#endif
#ifndef REP_KPH
#define REP_KPH -2
#endif
#ifndef MK_SINGLE
#define MK_SINGLE 1
#endif

#define LAS __attribute__((address_space(3)))
#define DI __device__ __forceinline__
typedef unsigned short bf16_t;
typedef short bf16x8 __attribute__((ext_vector_type(8)));
typedef short s16x4 __attribute__((ext_vector_type(4)));
typedef float f32x4 __attribute__((ext_vector_type(4)));
typedef unsigned u32x4 __attribute__((ext_vector_type(4)));
typedef unsigned u32x2 __attribute__((ext_vector_type(2)));
#define MFMA16(a, b, c) __builtin_amdgcn_mfma_f32_16x16x32_bf16((a), (b), (c), 0, 0, 0)

constexpr int T_ = 16384, S_ = 4096, DM = 2048;
constexpr int NIN = 20080, NP1 = 11776, NPM = 8192, NW1 = 20224;
constexpr int C_MZ = 0, C_XBC = 1024, C_FQ = 2560, C_FK = 3584, C_FV = 4608, C_FG = 5632, C_GQ = 6656, C_GK = 7168, C_GV = 7680,
              C_GG = 8704, C_LCQ = 9728, C_LCKV = 10240, C_LG = 10752;
constexpr float EPS = 1e-6f;
constexpr float LOG2E = 1.4426950408889634f;

constexpr size_t MiB = 1u << 20;
constexpr size_t O_CTL = 0;
constexpr size_t O_SSQ = 1 * MiB;
constexpr size_t O_DT = 2 * MiB;
constexpr size_t O_ACUM = 3 * MiB;
constexpr size_t O_FCUM = 4 * MiB;
constexpr size_t O_CS = 5 * MiB;
constexpr size_t O_SN = 7 * MiB;
constexpr size_t O_KROPE = 9 * MiB;
constexpr size_t O_BLAST = 11 * MiB;
constexpr size_t O_PSMALL = 12 * MiB;
constexpr size_t O_WBT = 20 * MiB;
constexpr size_t O_WOT = 52 * MiB;
constexpr size_t O_WUQT = 68 * MiB;
constexpr size_t O_WUKVT = 71 * MiB;
constexpr size_t O_P1 = 75 * MiB;
constexpr size_t O_PM = 443 * MiB;
constexpr size_t O_OUT = 699 * MiB;
constexpr size_t O_WINT = O_OUT;
constexpr size_t O_H = 827 * MiB;
constexpr size_t O_GST = O_H;
constexpr size_t O_QM = 891 * MiB;
constexpr size_t O_KN = 939 * MiB;
constexpr size_t O_VTM = 971 * MiB;
constexpr size_t O_VTF = 1003 * MiB;
constexpr size_t O_XBC = 1035 * MiB;
constexpr size_t O_XBCT = 1083 * MiB;
constexpr size_t O_SST = 1123 * MiB;
constexpr size_t O_KTT = 1155 * MiB;
constexpr size_t O_VTG = 1171 * MiB;
constexpr size_t WS_END = 1203 * MiB;
constexpr size_t O_MIXF = O_P1;
constexpr size_t O_MIXB = O_P1 + 128 * MiB;
constexpr size_t O_Y = O_P1 + 192 * MiB;

constexpr int LDS_BYTES = 135168;
constexpr int MISC_OFF = 131072;
constexpr int NPHASE = 17;

DI unsigned f2bf(float f) { unsigned u = __float_as_uint(f); return (u + 0x7fffu + ((u >> 16) & 1u)) >> 16; }
typedef float f32x2_t __attribute__((ext_vector_type(2)));
typedef __bf16 bf16x2_t __attribute__((ext_vector_type(2)));
DI unsigned pk2(float lo, float hi) { f32x2_t v = {lo, hi}; bf16x2_t b = __builtin_convertvector(v, bf16x2_t); return __builtin_bit_cast(unsigned, b); }
DI float bflo(unsigned u) { return __uint_as_float(u << 16); }
DI float bfhi(unsigned u) { return __uint_as_float(u & 0xffff0000u); }
DI float bf1(bf16_t b) { return __uint_as_float(((unsigned)b) << 16); }
DI float sigm(float x) { return 1.f / (1.f + __expf(-x)); }
DI float silu(float x) { return x / (1.f + __expf(-x)); }
DI float softplus_(float x) { return fmaxf(x, 0.f) + log1pf(__expf(-fabsf(x))); }
DI float logsig(float x) { return fminf(x, 0.f) - log1pf(__expf(-fabsf(x))); }
DI float xmax_fq(float x) {
    auto a = __builtin_amdgcn_permlane32_swap(__float_as_uint(x), __float_as_uint(x), false, false);
    x = fmaxf(__uint_as_float(a[0]), __uint_as_float(a[1]));
    auto b = __builtin_amdgcn_permlane16_swap(__float_as_uint(x), __float_as_uint(x), false, false);
    return fmaxf(__uint_as_float(b[0]), __uint_as_float(b[1]));
}
DI float wave_sum(float v) {
#pragma unroll
    for (int o = 1; o < 64; o <<= 1) v += __shfl_xor(v, o);
    return v;
}
DI void unpack8(bf16x8 v, float (&f)[8]) {
    u32x4 u = __builtin_bit_cast(u32x4, v);
    f[0] = bflo(u.x); f[1] = bfhi(u.x); f[2] = bflo(u.y); f[3] = bfhi(u.y); f[4] = bflo(u.z); f[5] = bfhi(u.z); f[6] = bflo(u.w); f[7] = bfhi(u.w);
}
DI bf16x8 pack8(const float (&f)[8]) {
    u32x4 u; u.x = pk2(f[0], f[1]); u.y = pk2(f[2], f[3]); u.z = pk2(f[4], f[5]); u.w = pk2(f[6], f[7]);
    return __builtin_bit_cast(bf16x8, u);
}
DI bf16x8 pack44(f32x4 a, f32x4 b) {
    u32x4 u; u.x = pk2(a[0], a[1]); u.y = pk2(a[2], a[3]); u.z = pk2(b[0], b[1]); u.w = pk2(b[2], b[3]);
    return __builtin_bit_cast(bf16x8, u);
}
DI u32x2 pack4(f32x4 a) { u32x2 u; u.x = pk2(a[0], a[1]); u.y = pk2(a[2], a[3]); return u; }
DI f32x4 unpack4(u32x2 u) { return (f32x4){bflo(u.x), bfhi(u.x), bflo(u.y), bfhi(u.y)}; }
DI bf16x8 ld16(const bf16_t* p) { return *(const bf16x8*)p; }
DI bf16x8 ld8x2(const bf16_t* p0, const bf16_t* p1) {
    s16x4 a = *(const s16x4*)p0, b = *(const s16x4*)p1;
    return __builtin_shufflevector(a, b, 0, 1, 2, 3, 4, 5, 6, 7);
}

DI int otid() { int t = threadIdx.x; asm volatile("" : "+v"(t)); return t; }
#define LANEIDS const int tid = otid(), lane = tid & 63, wave = __builtin_amdgcn_readfirstlane(tid >> 6), r16 = lane & 15, fq = lane >> 4; (void)tid; (void)lane; (void)wave; (void)r16; (void)fq;
DI int osg(int v) { asm volatile("" : "+s"(v)); return v; }
struct Args { const void* in[21]; float* out; unsigned char* ws; int ph_lo, ph_hi; };

DI int next_item(unsigned* ctr, LAS unsigned char* lds) {
    volatile LAS int* s = (volatile LAS int*)(lds + MISC_OFF);
    __syncthreads();
    if (threadIdx.x == 0) *s = (int)atomicAdd(ctr, 1u);
    __syncthreads();
    return *s;
}

namespace pg8 {
constexpr int BM = 256, BK = 64, HALF = 128, HTB = HALF * BK * 2, STAGE_BYTES = 8 * HTB, NXCD = 8, WGM = 8;
DI int lds_byte(int r, int c) { const int st = (r >> 4) * 2 + (c >> 5), rr = r & 15, cc = c & 31, ob = rr * 64 + cc * 2; return st * 1024 + (ob ^ (((ob >> 9) & 1) << 5)); }
DI void stage_rc(int b, int& R, int& C) { const int st = b / 1024, sb = b % 1024, swz = sb ^ (((sb >> 9) & 1) << 5); R = (st >> 1) * 16 + swz / 64; C = (st & 1) * 32 + (swz % 64) / 2; }
DI int perm32(int rho) { const int n = rho >> 4, i = rho & 15; return 8 * (i >> 2) + 4 * n + (i & 3); }

struct Unit { int pm, pn, aux; const char* A; const char* B; };

DI void tile_of(int L, int nM, int nN, int& pm, int& pn) {
    const int nwg = nM * nN; int wgid = L;
    { const int q = nwg / NXCD, r = nwg % NXCD, xcd = wgid % NXCD, off = wgid / NXCD; wgid = (xcd < r ? xcd * (q + 1) : r * (q + 1) + (xcd - r) * q) + off; }
    const int nig = WGM * nN, gid = wgid / nig, fm = gid * WGM, gsz = (nM - fm) < WGM ? (nM - fm) : WGM;
    pm = fm + ((wgid % nig) % gsz); pn = (wgid % nig) / gsz;
}
struct PlainOrder {
    const char* A; const char* B; int nM, nN, G, c; size_t tsA, tsB;
    DI bool next(int i, Unit& u) const {
        const long L = (long)i * G + c; if (L >= (long)nM * nN) return false;
        tile_of((int)L, nM, nN, u.pm, u.pn); u.aux = 0; u.A = A + (size_t)u.pm * tsA; u.B = B + (size_t)u.pn * tsB; return true;
    }
};
struct ProjOrder {
    const char* A; const char* B; int G, c;
    DI bool next(int i, Unit& u) const {
        const long L = (long)i * G + c; if (L >= 64 * 79) return false;
        int pm, pn; tile_of((int)L, 64, 79, pm, pn);
        const size_t ts = (size_t)256 * 2048 * 2;
        const bool fv = (pn >= 18 && pn < 22), gv = (pn >= 30 && pn < 34);
        if (fv || gv) { u.pm = pn; u.pn = pm; u.aux = fv ? 1 : 2; u.A = B + (size_t)pn * ts; u.B = A + (size_t)pm * ts; }
        else { u.pm = pm; u.pn = pn; u.aux = 0; u.A = A + (size_t)pm * ts; u.B = B + (size_t)pn * ts; }
        return true;
    }
};
struct MlaOrder {
    const char* P1; const char* Wq; const char* Wkv; int G, c;
    DI bool next(int i, Unit& u) const {
        const long L = (long)i * G + c; if (L >= 64 * 10) return false;
        const int pm = (int)L / 10, rem = (int)L % 10; u.pm = pm; u.aux = rem;
        if (rem < 6) { u.pn = rem; u.A = P1 + ((size_t)pm * 256 * NP1 + C_LCQ) * 2; u.B = Wq + (size_t)rem * 256 * 512 * 2; }
        else { u.pn = rem - 6; u.A = P1 + ((size_t)pm * 256 * NP1 + C_LCKV) * 2; u.B = Wkv + (size_t)(rem - 6) * 256 * 512 * 2; }
        return true;
    }
};
struct MlaVOrder {
    const char* P1; const char* Wv; int G, c;
    DI bool next(int i, Unit& u) const {
        const long L = (long)i * G + c; if (L >= 256) return false;
        u.pm = (int)L & 3; u.pn = (int)L >> 2; u.aux = 0;
        u.A = Wv + (size_t)u.pm * 256 * 512 * 2; u.B = P1 + ((size_t)u.pn * 256 * NP1 + C_LCKV) * 2; return true;
    }
};
struct MergeOrder {
    const char* OUTp; const char* Wb; int G, c;
    DI bool next(int i, Unit& u) const {
        const int j = i >> 2, br = i & 3; const long L = (long)j * G + c; if (L >= 512) return false;
        tile_of((int)L, 64, 8, u.pm, u.pn); u.aux = br;
        u.A = OUTp + ((size_t)u.pm * 256 * 4096 + br * 1024) * 2; u.B = Wb + ((size_t)br * 2048 + u.pn * 256) * 1024 * 2; return true;
    }
};

template <class Epi, class Sched>
DI void gemm_phase(LAS unsigned char* lds, const int K, const int lda, const int ldb, const Sched& S, const Epi& E) {
    const int tid = otid(), wid = __builtin_amdgcn_readfirstlane(tid >> 6), lane = tid & 63, wr = wid >> 2, wc = wid & 3, fr = lane & 15, fq = lane >> 4;
    const int nt = K / BK;
    unsigned voffA[2], voffB[2];
#pragma unroll
    for (int i = 0; i < 2; ++i) { int R, C; stage_rc(tid * 16 + i * 8192, R, C); const int Rb = (R & ~31) + perm32(R & 31);
        voffA[i] = (unsigned)(R * lda + C) * 2u; voffB[i] = (unsigned)(Rb * ldb + C) * 2u; }
    const size_t kstep = (size_t)(BK * 2);
    const size_t hstepA = (size_t)HALF * lda * 2, hstepB = (size_t)HALF * ldb * 2;
    const unsigned ldsw = (unsigned)wid * 1024u;
    const int aoff = lds_byte(wr * 64 + fr, fq * 8), boff = lds_byte(wc * 32 + fr, fq * 8);
#define PG8_SA(b, h) (((b) * 2 + (h)) * HTB)
#define PG8_SB(b, h) ((4 + (b) * 2 + (h)) * HTB)
#define PG8_STAGE(bufoff, gbase, voff) do { _Pragma("unroll") for (int _i = 0; _i < 2; ++_i) \
        __builtin_amdgcn_global_load_lds((const unsigned*)((const char*)(gbase) + (voff)[_i]), (LAS unsigned*)(lds + (bufoff) + ldsw + _i * 8192), 16, 0, 0); } while (0)
#define PG8_LDA(dst, b, h) do { _Pragma("unroll") for (int m = 0; m < 4; ++m) _Pragma("unroll") for (int k = 0; k < 2; ++k) dst[m][k] = *(const LAS bf16x8*)(lds + PG8_SA(b, h) + aoff + m * 2048 + k * 1024); } while (0)
#define PG8_LDB(dst, b, h) do { _Pragma("unroll") for (int n = 0; n < 2; ++n) _Pragma("unroll") for (int k = 0; k < 2; ++k) dst[n][k] = *(const LAS bf16x8*)(lds + PG8_SB(b, h) + boff + n * 2048 + k * 1024); } while (0)
#define PG8_MMA(ai, bj, At, Bt) do { __builtin_amdgcn_s_setprio(1); _Pragma("unroll") for (int m = 0; m < 4; ++m) _Pragma("unroll") for (int n = 0; n < 2; ++n) _Pragma("unroll") for (int k = 0; k < 2; ++k) \
        acc[ai][bj][m][n] = __builtin_amdgcn_mfma_f32_16x16x32_bf16(Bt[n][k], At[m][k], acc[ai][bj][m][n], 0, 0, 0); __builtin_amdgcn_s_setprio(0); } while (0)
#define PG8_WAIT_V(n) asm volatile("s_waitcnt vmcnt(" #n ")" ::: "memory")
#define PG8_WAIT_L(n) asm volatile("s_waitcnt lgkmcnt(" #n ")" ::: "memory")
#define PG8_BAR __builtin_amdgcn_s_barrier()
#define PG8_SCHED __builtin_amdgcn_sched_barrier(0)
    Unit cur, nxt; int ui = 0;
    if (!S.next(0, cur)) return;
    f32x4 acc[2][2][4][2];
#pragma unroll
    for (int a = 0; a < 2; ++a)
#pragma unroll
        for (int b = 0; b < 2; ++b)
#pragma unroll
            for (int m = 0; m < 4; ++m)
#pragma unroll
                for (int n = 0; n < 2; ++n) acc[a][b][m][n] = (f32x4){0.f, 0.f, 0.f, 0.f};
    bf16x8 At[4][2], B0[2][2], B1[2][2];
    const char* cA = cur.A; const char* cB = cur.B;
    PG8_STAGE(PG8_SB(0, 0), cB, voffB); PG8_STAGE(PG8_SB(0, 1), cB + hstepB, voffB); PG8_STAGE(PG8_SA(0, 0), cA, voffA); PG8_STAGE(PG8_SA(0, 1), cA + hstepA, voffA);
    if (wr == 1) PG8_BAR;
    PG8_WAIT_V(2); PG8_BAR;
    PG8_STAGE(PG8_SB(1, 0), cB + kstep, voffB); PG8_STAGE(PG8_SA(1, 0), cA + kstep, voffA); PG8_STAGE(PG8_SB(1, 1), cB + hstepB + kstep, voffB);
    PG8_WAIT_V(6); PG8_BAR;
    for (;;) {
        const bool has_next = S.next(ui + 1, nxt);
        const char* nA = has_next ? nxt.A : cA; const char* nB = has_next ? nxt.B : cB;
        for (int t = 0; t < nt; t += 2) {
            const bool last = (t == nt - 2);
            const char* a1 = cA + (size_t)(t + 1) * kstep;
            const char* a2 = last ? nA : cA + (size_t)(t + 2) * kstep; const char* b2 = last ? nB : cB + (size_t)(t + 2) * kstep;
            const char* a3 = a2 + kstep; const char* b3 = b2 + kstep;
            PG8_LDB(B0, 0, 0); PG8_LDB(B1, 0, 1); PG8_SCHED; PG8_LDA(At, 0, 0); PG8_STAGE(PG8_SA(1, 1), a1 + hstepA, voffA);
            PG8_WAIT_V(8); PG8_WAIT_L(0); PG8_BAR; PG8_MMA(0, 0, At, B0); PG8_MMA(0, 1, At, B1); PG8_BAR; PG8_SCHED;
            PG8_LDA(At, 0, 1); PG8_STAGE(PG8_SB(0, 0), b2, voffB); PG8_STAGE(PG8_SB(0, 1), b2 + hstepB, voffB); PG8_STAGE(PG8_SA(0, 0), a2, voffA);
            PG8_WAIT_V(8); PG8_WAIT_L(0); PG8_BAR; PG8_MMA(1, 0, At, B0); PG8_MMA(1, 1, At, B1); PG8_BAR; PG8_SCHED;
            PG8_LDB(B0, 1, 0); PG8_LDB(B1, 1, 1); PG8_SCHED; PG8_LDA(At, 1, 0); PG8_STAGE(PG8_SA(0, 1), a2 + hstepA, voffA);
            PG8_WAIT_V(8); PG8_WAIT_L(0); PG8_BAR; PG8_MMA(0, 0, At, B0); PG8_MMA(0, 1, At, B1); PG8_BAR; PG8_SCHED;
            PG8_LDA(At, 1, 1); PG8_STAGE(PG8_SB(1, 0), b3, voffB); PG8_STAGE(PG8_SB(1, 1), b3 + hstepB, voffB); PG8_STAGE(PG8_SA(1, 0), a3, voffA);
            PG8_WAIT_V(8); PG8_WAIT_L(0); PG8_BAR; PG8_MMA(1, 0, At, B0); PG8_MMA(1, 1, At, B1); PG8_BAR; PG8_SCHED;
        }
        if (wr == 0) PG8_BAR;
        E(acc, cur, wr, wc, fr, fq);
        if (!has_next) break;
#pragma unroll
        for (int a = 0; a < 2; ++a)
#pragma unroll
            for (int b = 0; b < 2; ++b)
#pragma unroll
                for (int m = 0; m < 4; ++m)
#pragma unroll
                    for (int n = 0; n < 2; ++n) acc[a][b][m][n] = (f32x4){0.f, 0.f, 0.f, 0.f};
        cur = nxt; cA = nA; cB = nB; ++ui;
        if (wr == 1) PG8_BAR;
    }
    PG8_WAIT_V(0);
    PG8_BAR;
#undef PG8_SA
#undef PG8_SB
#undef PG8_STAGE
#undef PG8_LDA
#undef PG8_LDB
#undef PG8_MMA
#undef PG8_WAIT_V
#undef PG8_WAIT_L
#undef PG8_BAR
#undef PG8_SCHED
}

#define EPI_LOOP_BEGIN _Pragma("unroll") for (int ai = 0; ai < 2; ++ai) _Pragma("unroll") for (int m = 0; m < 4; ++m) { const int row = u.pm * 256 + ai * 128 + wr * 64 + m * 16 + fr;
#define EPI_BJ_BEGIN _Pragma("unroll") for (int bj = 0; bj < 2; ++bj) { const int lc = bj * 128 + wc * 32 + 8 * fq; const f32x4 v0 = acc[ai][bj][m][0], v1 = acc[ai][bj][m][1];
#define EPI_END __builtin_amdgcn_sched_barrier(0); } }

struct EpiProj {
    bf16_t* P1; bf16_t* PM; float* PS; float* SSQ; bf16_t* VTF; bf16_t* VTG;
    DI void operator()(const f32x4 (&acc)[2][2][4][2], const Unit& u, int wr, int wc, int fr, int fq) const {
        const int pn = u.pn;
        if (u.aux != 0) {
            EPI_LOOP_BEGIN
                EPI_BJ_BEGIN
                    const int tok = u.pn * 256 + lc;
                    if (u.aux == 1) *(bf16x8*)(VTF + ((size_t)(tok >> 12) * 1024 + (row - C_FV)) * 4096 + (tok & 4095)) = pack44(v0, v1);
                    else *(bf16x8*)(VTG + ((size_t)(tok >> 6) * 1024 + (row - C_GV)) * 64 + (tok & 63)) = pack44(v0, v1);
            EPI_END
        } else if (pn < 46) {
            const bool stat = (pn >= 38 && pn < 42);
            EPI_LOOP_BEGIN
                float ss = 0.f;
                EPI_BJ_BEGIN
                    *(bf16x8*)(P1 + (size_t)row * NP1 + pn * 256 + lc) = pack44(v0, v1);
                    ss += v0[0] * v0[0] + v0[1] * v0[1] + v0[2] * v0[2] + v0[3] * v0[3] + v1[0] * v1[0] + v1[1] * v1[1] + v1[2] * v1[2] + v1[3] * v1[3];
                    __builtin_amdgcn_sched_barrier(0);
                }
                if (stat && SSQ) { ss += __shfl_xor(ss, 16); ss += __shfl_xor(ss, 32); if (fq == 0) SSQ[(row * 2 + (pn >= 40 ? 1 : 0)) * 8 + (pn & 1) * 4 + wc] = ss; }
            }
        } else if (pn < 78) {
            EPI_LOOP_BEGIN
                EPI_BJ_BEGIN
                    f32x4 a = {sigm(v0[0]), sigm(v0[1]), sigm(v0[2]), sigm(v0[3])}, b = {sigm(v1[0]), sigm(v1[1]), sigm(v1[2]), sigm(v1[3])};
                    *(bf16x8*)(PM + (size_t)row * NPM + (pn - 46) * 256 + lc) = pack44(a, b);
            EPI_END
        } else {
            EPI_LOOP_BEGIN
                EPI_BJ_BEGIN
                    if (lc < 128) { *(f32x4*)(PS + (size_t)row * 128 + lc) = v0; *(f32x4*)(PS + (size_t)row * 128 + lc + 4) = v1; }
            EPI_END
        }
    }
};
struct EpiMla {
    const float* SSQ; bf16_t* QM; bf16_t* KN;
    DI void operator()(const f32x4 (&acc)[2][2][4][2], const Unit& u, int wr, int wc, int fr, int fq) const {
        const bool isq = u.aux < 6;
        bf16_t* dst = isq ? QM : KN; const int ld = isq ? 1536 : 1024;
        EPI_LOOP_BEGIN
            const f32x4 sa = *(const f32x4*)(SSQ + (row * 2 + (isq ? 0 : 1)) * 8), sb = *(const f32x4*)(SSQ + (row * 2 + (isq ? 0 : 1)) * 8 + 4);
            const float rs = rsqrtf((((sa[0] + sa[1]) + (sa[2] + sa[3])) + ((sb[0] + sb[1]) + (sb[2] + sb[3]))) * (1.f / 512.f) + EPS);
            EPI_BJ_BEGIN
                *(bf16x8*)(dst + (size_t)row * ld + u.pn * 256 + lc) = pack44(v0 * rs, v1 * rs);
        EPI_END
    }
};
struct EpiMlaV {
    const float* SSQ; bf16_t* VTM;
    DI void operator()(const f32x4 (&acc)[2][2][4][2], const Unit& u, int wr, int wc, int fr, int fq) const {
#pragma unroll
        for (int bj = 0; bj < 2; ++bj) { const int tok = u.pn * 256 + bj * 128 + wc * 32 + 8 * fq; const int bb = tok >> 12, s = tok & 4095;
            float rs[8];
#pragma unroll
            for (int e = 0; e < 8; ++e) { const f32x4 sa = *(const f32x4*)(SSQ + ((tok + e) * 2 + 1) * 8), sb = *(const f32x4*)(SSQ + ((tok + e) * 2 + 1) * 8 + 4);
                rs[e] = rsqrtf((((sa[0] + sa[1]) + (sa[2] + sa[3])) + ((sb[0] + sb[1]) + (sb[2] + sb[3]))) * (1.f / 512.f) + EPS); }
#pragma unroll
            for (int ai = 0; ai < 2; ++ai)
#pragma unroll
                for (int m = 0; m < 4; ++m) { const int row = u.pm * 256 + ai * 128 + wr * 64 + m * 16 + fr;
                    const f32x4 v0 = acc[ai][bj][m][0], v1 = acc[ai][bj][m][1];
                    const f32x4 a = {v0[0] * rs[0], v0[1] * rs[1], v0[2] * rs[2], v0[3] * rs[3]}, b = {v1[0] * rs[4], v1[1] * rs[5], v1[2] * rs[6], v1[3] * rs[7]};
                    *(bf16x8*)(VTM + ((size_t)bb * 1024 + row) * 4096 + s) = pack44(a, b); __builtin_amdgcn_sched_barrier(0); } }
    }
};
struct EpiMerge {
    const bf16_t* PM; float* MIXF; bf16_t* MIXB;
    DI void operator()(const f32x4 (&acc)[2][2][4][2], const Unit& u, int wr, int wc, int fr, int fq) const {
        const int br = u.aux;
        EPI_LOOP_BEGIN
            EPI_BJ_BEGIN
                const int gc = u.pn * 256 + lc; float g[8]; unpack8(*(const bf16x8*)(PM + (size_t)row * NPM + br * 2048 + gc), g);
                f32x4 a = {v0[0] * g[0], v0[1] * g[1], v0[2] * g[2], v0[3] * g[3]}, b = {v1[0] * g[4], v1[1] * g[5], v1[2] * g[6], v1[3] * g[7]};
                bf16_t* mp = MIXB + (size_t)row * 2048 + gc;
                if (br != 0) { float pv[8]; unpack8(*(const bf16x8*)mp, pv); a += (f32x4){pv[0], pv[1], pv[2], pv[3]}; b += (f32x4){pv[4], pv[5], pv[6], pv[7]}; }
                *(bf16x8*)mp = pack44(a, b);
        EPI_END
    }
};
struct EpiOut {
    float* Y;
    DI void operator()(const f32x4 (&acc)[2][2][4][2], const Unit& u, int wr, int wc, int fr, int fq) const {
        EPI_LOOP_BEGIN
            EPI_BJ_BEGIN
                float* yp = Y + (size_t)row * 2048 + u.pn * 256 + lc; *(f32x4*)yp = v0; *(f32x4*)(yp + 4) = v1;
        EPI_END
    }
};
}

DI int win_src(int n) {
    if (n < 2560) return n;
    if (n < 5632) return n + 16;
    if (n < 8704) return n + 32;
    if (n < 10752) return n + 48;
    if (n < 19968) return n + 112;
    const int r = n - 19968;
    if (r < 16) return 2560 + r;
    if (r < 32) return 5648 + (r - 16);
    if (r < 48) return 8736 + (r - 32);
    if (r < 112) return 10800 + (r - 48);
    return -1;
}
template <int MODE>
DI void wt_item(const float* __restrict__ src, int ld_src, int K, bf16_t* dst, int k0, int n0, const float* kscale, LAS float* scr) {
    const int tid = otid(), kk = tid >> 4, c4 = (tid & 15) * 4;
    int sc = n0 + c4; if (MODE == 1) sc = win_src(sc);
    if (MODE == 2) sc = ((sc >> 7) & 7) * 256 + (sc >> 10) * 128 + (sc & 127);
#pragma unroll
    for (int p = 0; p < 2; ++p) { const int k = kk + 32 * p;
        f32x4 v = {0.f, 0.f, 0.f, 0.f}; if (sc >= 0) v = *(const f32x4*)(src + (size_t)(k0 + k) * ld_src + sc);
        if (kscale) v = v * kscale[k0 + k];
        scr[k * 65 + c4] = v[0]; scr[k * 65 + c4 + 1] = v[1]; scr[k * 65 + c4 + 2] = v[2]; scr[k * 65 + c4 + 3] = v[3]; }
    __syncthreads();
    { const int n = tid >> 3, c = tid & 7; const LAS float* s = scr + (8 * c) * 65 + n;
      u32x4 o; o.x = pk2(s[0], s[65]); o.y = pk2(s[2 * 65], s[3 * 65]); o.z = pk2(s[4 * 65], s[5 * 65]); o.w = pk2(s[6 * 65], s[7 * 65]);
      *(u32x4*)(dst + (size_t)(n0 + n) * K + k0 + 8 * c) = o; }
    __syncthreads();
}
DI void bt_item(const bf16_t* src, bf16_t* dst, size_t rowbase, int rowlen, int pos0, LAS bf16_t* scr) {
    const int tid = otid(), a = tid >> 3, c8 = (tid & 7) * 8;
    *(LAS bf16x8*)(scr + a * 72 + c8) = *(const bf16x8*)(src + (size_t)a * NP1 + c8);
    __syncthreads();
    { u32x4 o; const LAS bf16_t* s = scr + c8 * 72 + a;
      o.x = (unsigned)s[0] | ((unsigned)s[72] << 16); o.y = (unsigned)s[2 * 72] | ((unsigned)s[3 * 72] << 16);
      o.z = (unsigned)s[4 * 72] | ((unsigned)s[5 * 72] << 16); o.w = (unsigned)s[6 * 72] | ((unsigned)s[7 * 72] << 16);
      *(u32x4*)(dst + (rowbase + a) * (size_t)rowlen + pos0 + c8) = o; }
    __syncthreads();
}
DI void rms_row_to_bf16(const float* xr, const float* w, bf16_t* o, int lane) {
    f32x4 v[8]; float s = 0.f;
#pragma unroll
    for (int j = 0; j < 8; ++j) { v[j] = ((const f32x4*)xr)[lane + 64 * j]; s += v[j][0] * v[j][0] + v[j][1] * v[j][1] + v[j][2] * v[j][2] + v[j][3] * v[j][3]; }
    const float r = rsqrtf(wave_sum(s) * (1.f / 2048.f) + EPS);
#pragma unroll
    for (int j = 0; j < 8; ++j) { const f32x4 ww = ((const f32x4*)w)[lane + 64 * j]; *(u32x2*)(o + (size_t)(lane + 64 * j) * 4) = pack4(v[j] * ww * r); }
}

template <int DQK, int DV, bool FOX, bool PIPE, bool FASTSM>
DI void attn_unit(LAS unsigned char* lds, int b, int h, int qb, const unsigned char* ws) {
    constexpr int KS = DQK / 32, DT = DV / 16, NH = FOX ? 16 : 8;
    constexpr int KROWB = DQK * 2, CPR = DQK / 8, KB = 64 * KROWB, VB = DV * 128, FB = FOX ? 2048 : 0, SLOT = KB + VB + FB;
    constexpr int NS = FOX ? 4 : 3, NKI = KB / 8192, NVI = VB / 8192, PER = NKI + NVI + (FOX ? 1 : 0);
    static_assert(NS * SLOT <= MISC_OFF, "attention LDS");
    const bf16_t* P1 = (const bf16_t*)(ws + O_P1); const bf16_t* QM = (const bf16_t*)(ws + O_QM); const float* FCUM = (const float*)(ws + O_FCUM);
    const float* CS = (const float*)(ws + O_CS); const float* SN = (const float*)(ws + O_SN); bf16_t* OUT = (bf16_t*)(ws + O_OUT);
    const int tid = otid(), wave = __builtin_amdgcn_readfirstlane(tid >> 6), lane = tid & 63, r16 = lane & 15, fq = lane >> 4;
    const float sc2 = (FOX ? 0.125f : 0.07216878364870322f) * LOG2E;
    const int tq0 = b * S_ + qb * 256 + wave * 32;
    const int q0 = qb * 256 + wave * 32;
    bf16x8 qf[KS][2]; float Fq2[2] = {0.f, 0.f};
#pragma unroll
    for (int nq = 0; nq < 2; ++nq) {
        const int t = tq0 + nq * 16 + r16;
        if constexpr (FOX) {
#pragma unroll
            for (int ks = 0; ks < KS; ++ks) qf[ks][nq] = ld16(P1 + (size_t)t * NP1 + C_FQ + h * 64 + ks * 32 + fq * 8);
            Fq2[nq] = FCUM[(size_t)(b * 16 + h) * S_ + q0 + nq * 16 + r16];
        } else {
#pragma unroll
            for (int ks = 0; ks < KS; ++ks) qf[ks][nq] = ld16(QM + (size_t)t * 1536 + h * 192 + ks * 32 + fq * 8);
            float r4[8], r5[8], o4[8], o5[8]; unpack8(qf[4][nq], r4); unpack8(qf[5][nq], r5);
            const f32x4 c0 = *(const f32x4*)(CS + (size_t)t * 32 + fq * 8), c1 = *(const f32x4*)(CS + (size_t)t * 32 + fq * 8 + 4);
            const f32x4 s0 = *(const f32x4*)(SN + (size_t)t * 32 + fq * 8), s1 = *(const f32x4*)(SN + (size_t)t * 32 + fq * 8 + 4);
#pragma unroll
            for (int j = 0; j < 8; ++j) { const float c = j < 4 ? c0[j & 3] : c1[j & 3], s = j < 4 ? s0[j & 3] : s1[j & 3];
                o4[j] = r4[j] * c - r5[j] * s; o5[j] = r4[j] * s + r5[j] * c; }
            qf[4][nq] = pack8(o4); qf[5][nq] = pack8(o5);
        }
    }
    f32x4 oacc[DT][2];
#pragma unroll
    for (int d = 0; d < DT; ++d) { oacc[d][0] = (f32x4){0.f, 0.f, 0.f, 0.f}; oacc[d][1] = (f32x4){0.f, 0.f, 0.f, 0.f}; }
    float mrow[2] = {-INFINITY, -INFINITY}, lsum[2] = {0.f, 0.f};
    const int ntiles = 4 * qb + 4;
    int kt0 = 0;
    if constexpr (FOX) {
        const unsigned* nm = (const unsigned*)(ws + O_CTL) + 256 + (b * 16 + h) * 2;
        const float smax2 = sqrtf(__uint_as_float(nm[0]) * __uint_as_float(nm[1])) * sc2, thr = -(2.f * smax2 + 40.f);
        const float f0 = FCUM[(size_t)(b * 16 + h) * S_ + qb * 256];
        const bool skip = (lane < 4 * qb) && (f0 - FCUM[(size_t)(b * 16 + h) * S_ + lane * 64 + 63] < thr);
        const unsigned long long mk = __ballot(skip);
        kt0 = __builtin_amdgcn_readfirstlane((int)__builtin_ctzll(~mk));
    }
    unsigned kof[NKI], kst[NKI], vof[NVI];
#pragma unroll
    for (int i = 0; i < NKI; ++i) { const int L = (wave + 8 * i) * 64 + lane, r = L / CPR, pos = L % CPR, c = (pos & ~7) | ((pos ^ (r >> 1)) & 7);
        if constexpr (FOX) { kof[i] = (unsigned)(O_P1 + ((size_t)(b * S_ + r) * NP1 + C_FK + h * 64 + c * 8) * 2); kst[i] = 64u * NP1 * 2u; }
        else if (c < 16) { kof[i] = (unsigned)(O_KN + ((size_t)(b * S_ + r) * 1024 + h * 128 + c * 8) * 2); kst[i] = 64u * 1024u * 2u; }
        else { kof[i] = (unsigned)(O_KROPE + ((size_t)(b * S_ + r) * 64 + (c - 16) * 8) * 2); kst[i] = 64u * 64u * 2u; } }
#pragma unroll
    for (int i = 0; i < NVI; ++i) { const int L = (wave + 8 * i) * 64 + lane, dv = L >> 3, pos = L & 7, c = pos ^ ((dv >> 1) & 7);
        vof[i] = (unsigned)((FOX ? O_VTF : O_VTM) + (((size_t)(b * NH + h) * DV + dv) * S_ + c * 8) * 2); }
    const unsigned fof = (unsigned)(O_FCUM + ((size_t)(b * 16 + h) * S_ + lane) * 4);
    int klo[2], vlo[2][2];
#pragma unroll
    for (int p = 0; p < 2; ++p) klo[p] = r16 * KROWB + (((p * 4 + fq) ^ ((r16 >> 1) & 7)) * 16);
#pragma unroll
    for (int ss = 0; ss < 2; ++ss)
#pragma unroll
        for (int q = 0; q < 2; ++q) vlo[ss][q] = KB + r16 * 128 + (((4 * ss + (fq >> 1) + 2 * q) ^ ((r16 >> 1) & 7)) * 16) + 8 * (fq & 1);
#define ATT_ISSUE(kt) do { LAS unsigned char* sp = lds + ((kt) % NS) * SLOT; \
        _Pragma("unroll") for (int i = 0; i < NKI; ++i) __builtin_amdgcn_global_load_lds((const unsigned*)(ws + (kof[i] + (unsigned)(kt) * kst[i])), (LAS unsigned*)(sp + (wave + 8 * i) * 1024), 16, 0, 0); \
        _Pragma("unroll") for (int i = 0; i < NVI; ++i) __builtin_amdgcn_global_load_lds((const unsigned*)(ws + (vof[i] + (unsigned)(kt) * 128u)), (LAS unsigned*)(sp + KB + (wave + 8 * i) * 1024), 16, 0, 0); \
        if constexpr (FOX) __builtin_amdgcn_global_load_lds((const unsigned*)(ws + (fof + (unsigned)(kt) * 256u)), (LAS unsigned*)(sp + KB + VB + wave * 256), 4, 0, 0); } while (0)
#define ATT_S(kt_, SA) do { const LAS unsigned char* bp = lds + ((kt_) % NS) * SLOT; \
        _Pragma("unroll") for (int mt = 0; mt < 4; ++mt) { SA[mt][0] = (f32x4){0.f, 0.f, 0.f, 0.f}; SA[mt][1] = (f32x4){0.f, 0.f, 0.f, 0.f}; } \
        bf16x8 kf[2][4]; \
        _Pragma("unroll") for (int mt = 0; mt < 4; ++mt) kf[0][mt] = *(const LAS bf16x8*)(bp + klo[0] + (mt * 16 * KROWB)); \
        _Pragma("unroll") for (int ks = 0; ks < KS; ++ks) { \
            if (ks + 1 < KS) { _Pragma("unroll") for (int mt = 0; mt < 4; ++mt) kf[(ks + 1) & 1][mt] = *(const LAS bf16x8*)(bp + klo[(ks + 1) & 1] + (mt * 16 * KROWB + ((ks + 1) >> 1) * 128)); } \
            _Pragma("unroll") for (int mt = 0; mt < 4; ++mt) { SA[mt][0] = MFMA16(kf[ks & 1][mt], qf[ks][0], SA[mt][0]); SA[mt][1] = MFMA16(kf[ks & 1][mt], qf[ks][1], SA[mt][1]); } \
            if (!PIPE) __builtin_amdgcn_sched_barrier(0); } } while (0)
#define ATT_SOFTMAX_(kt_, SA, MASKED) do { const LAS unsigned char* bp = lds + ((kt_) % NS) * SLOT; \
        _Pragma("unroll") for (int nq = 0; nq < 2; ++nq) { \
            const int qpos = q0 + nq * 16 + r16; float mx = -INFINITY; \
            _Pragma("unroll") for (int mt = 0; mt < 4; ++mt) { f32x4 fk = {0.f, 0.f, 0.f, 0.f}; if constexpr (FOX) fk = *(const LAS f32x4*)(bp + KB + VB + wave * 256 + (mt * 16 + fq * 4) * 4); \
                _Pragma("unroll") for (int j = 0; j < 4; ++j) { float x = FOX ? SA[mt][nq][j] * sc2 + (Fq2[nq] - fk[j]) : SA[mt][nq][j] * sc2; \
                    if (MASKED) { const int kpos = (kt_) * 64 + mt * 16 + fq * 4 + j; x = (kpos <= qpos) ? x : -INFINITY; } \
                    SA[mt][nq][j] = x; mx = fmaxf(mx, x); } } \
            mx = xmax_fq(mx); \
            const float mnew = fmaxf(mrow[nq], mx), alpha = __builtin_amdgcn_exp2f(mrow[nq] - mnew); mrow[nq] = mnew; \
            float ps = 0.f; \
            _Pragma("unroll") for (int mt = 0; mt < 4; ++mt) _Pragma("unroll") for (int j = 0; j < 4; ++j) { const float p = __builtin_amdgcn_exp2f(SA[mt][nq][j] - mnew); SA[mt][nq][j] = p; ps += p; } \
            lsum[nq] = lsum[nq] * alpha + ps; \
            _Pragma("unroll") for (int d = 0; d < DT; ++d) oacc[d][nq] = oacc[d][nq] * alpha; \
            pb[0][nq] = pack44(SA[0][nq], SA[1][nq]); pb[1][nq] = pack44(SA[2][nq], SA[3][nq]); } } while (0)
#define ATT_SOFTMAX_F(kt_, SA) do { const LAS unsigned char* bp = lds + ((kt_) % NS) * SLOT; float dlt[2], rmx[2]; \
        _Pragma("unroll") for (int nq = 0; nq < 2; ++nq) { float mx = -INFINITY; \
            _Pragma("unroll") for (int mt = 0; mt < 4; ++mt) { \
                if constexpr (FOX) { const f32x4 fk = *(const LAS f32x4*)(bp + KB + VB + wave * 256 + (mt * 16 + fq * 4) * 4); \
                    _Pragma("unroll") for (int j = 0; j < 4; ++j) SA[mt][nq][j] = SA[mt][nq][j] * sc2 - fk[j]; } \
                _Pragma("unroll") for (int j = 0; j < 4; ++j) mx = fmaxf(mx, SA[mt][nq][j]); } \
            mx = xmax_fq(mx); \
            rmx[nq] = FOX ? mx + Fq2[nq] : mx * sc2; dlt[nq] = rmx[nq] - mrow[nq]; } \
        const bool fast = __all((dlt[0] <= 8.f) && (dlt[1] <= 8.f)); \
        _Pragma("unroll") for (int nq = 0; nq < 2; ++nq) { \
            const float mnew = fast ? mrow[nq] : fmaxf(mrow[nq], rmx[nq]); \
            const float alpha = __builtin_amdgcn_exp2f(mrow[nq] - mnew); \
            const float cc = FOX ? Fq2[nq] - mnew : -mnew; mrow[nq] = mnew; float ps = 0.f; \
            _Pragma("unroll") for (int mt = 0; mt < 4; ++mt) _Pragma("unroll") for (int j = 0; j < 4; ++j) { \
                const float p = __builtin_amdgcn_exp2f(FOX ? SA[mt][nq][j] + cc : SA[mt][nq][j] * sc2 + cc); SA[mt][nq][j] = p; ps += p; } \
            lsum[nq] = lsum[nq] * alpha + ps; \
            pb[0][nq] = pack44(SA[0][nq], SA[1][nq]); pb[1][nq] = pack44(SA[2][nq], SA[3][nq]); \
            if (!fast) { _Pragma("unroll") for (int d = 0; d < DT; ++d) oacc[d][nq] = oacc[d][nq] * alpha; } } \
        } while (0)
#define ATT_SOFTMAX(kt_, SA) do { if ((kt_) * 64 + 63 > q0) ATT_SOFTMAX_(kt_, SA, true); else if constexpr (FASTSM) ATT_SOFTMAX_F(kt_, SA); else ATT_SOFTMAX_(kt_, SA, false); } while (0)
#define ATT_PV(kt_) do { const LAS unsigned char* bp = lds + ((kt_) % NS) * SLOT; constexpr int NG = 2 * DT / 4; \
        s16x4 vl[2][4], vh[2][4]; \
        _Pragma("unroll") for (int q = 0; q < 4; ++q) { vl[0][q] = *(const LAS s16x4*)(bp + vlo[0][0] + q * 2048); vh[0][q] = *(const LAS s16x4*)(bp + vlo[0][1] + q * 2048); } \
        _Pragma("unroll") for (int g = 0; g < NG; ++g) { \
            if (g + 1 < NG) { const int ss1 = ((g + 1) * 4) / DT, d1 = ((g + 1) * 4) % DT; \
                _Pragma("unroll") for (int q = 0; q < 4; ++q) { vl[(g + 1) & 1][q] = *(const LAS s16x4*)(bp + vlo[ss1][0] + (d1 + q) * 2048); vh[(g + 1) & 1][q] = *(const LAS s16x4*)(bp + vlo[ss1][1] + (d1 + q) * 2048); } } \
            const int ss = (g * 4) / DT, d0 = (g * 4) % DT; \
            _Pragma("unroll") for (int q = 0; q < 4; ++q) { const bf16x8 vf = __builtin_shufflevector(vl[g & 1][q], vh[g & 1][q], 0, 1, 2, 3, 4, 5, 6, 7); \
                oacc[d0 + q][0] = MFMA16(vf, pb[ss][0], oacc[d0 + q][0]); oacc[d0 + q][1] = MFMA16(vf, pb[ss][1], oacc[d0 + q][1]); } \
            __builtin_amdgcn_sched_barrier(0); } } while (0)
#define ATT_BAR() do { asm volatile("s_waitcnt lgkmcnt(0)" ::: "memory"); __builtin_amdgcn_s_barrier(); asm volatile("" ::: "memory"); } while (0)
#pragma unroll
    for (int p = 0; p < NS - 1; ++p) ATT_ISSUE(kt0 + p);
    bf16x8 pb[2][2];
    if constexpr (PIPE) {
        static_assert(!PIPE || NS == 4, "pipelined form needs a 4-slot ring");
        asm volatile("s_waitcnt vmcnt(%0)" :: "n"(2 * PER) : "memory");
        ATT_BAR();
        f32x4 sA[4][2];
        ATT_S(kt0, sA);
        for (int kt = kt0; kt < ntiles; ++kt) {
            if (kt + 2 < ntiles) asm volatile("s_waitcnt vmcnt(%0)" :: "n"(PER) : "memory");
            else asm volatile("s_waitcnt vmcnt(0)" ::: "memory");
            ATT_BAR();
            if (kt + 3 < ntiles) ATT_ISSUE(kt + 3);
            const bool a0 = (kt * 64 <= q0 + 31), a1 = (kt + 1 < ntiles) && ((kt + 1) * 64 <= q0 + 31);
            if (a1) {
                f32x4 sB[4][2];
                if (kt * 64 + 63 > q0) { ATT_S(kt + 1, sB); ATT_SOFTMAX_(kt, sA, true); }
                else { ATT_S(kt + 1, sB); if constexpr (FASTSM) ATT_SOFTMAX_F(kt, sA); else ATT_SOFTMAX_(kt, sA, false); }
                ATT_PV(kt);
#pragma unroll
                for (int mt = 0; mt < 4; ++mt) { sA[mt][0] = sB[mt][0]; sA[mt][1] = sB[mt][1]; }
            } else if (a0) {
                ATT_SOFTMAX(kt, sA);
                ATT_PV(kt);
            }
        }
    } else {
        for (int kt = 0; kt < ntiles; ++kt) {
            if (kt + NS - 2 < ntiles) asm volatile("s_waitcnt vmcnt(%0)" :: "n"((NS - 2) * PER) : "memory");
            else asm volatile("s_waitcnt vmcnt(0)" ::: "memory");
            ATT_BAR();
            if (kt + NS - 1 < ntiles) ATT_ISSUE(kt + NS - 1);
            if (kt * 64 <= q0 + 31) {
                f32x4 sA[4][2];
                ATT_S(kt, sA);
                ATT_SOFTMAX(kt, sA);
                ATT_PV(kt);
            }
        }
    }
#undef ATT_S
#undef ATT_SOFTMAX
#undef ATT_SOFTMAX_
#undef ATT_SOFTMAX_F
#undef ATT_PV
#undef ATT_BAR
#undef ATT_ISSUE
#pragma unroll
    for (int nq = 0; nq < 2; ++nq) {
        float l = lsum[nq]; l += __shfl_xor(l, 16); l += __shfl_xor(l, 32); const float inv = 1.f / l;
        const int t = tq0 + nq * 16 + r16;
#pragma unroll
        for (int d = 0; d < DT; ++d) { const int dv0 = d * 16 + fq * 4;
            const f32x4 g = unpack4(*(const u32x2*)(P1 + (size_t)t * NP1 + (FOX ? C_FG : C_LG) + h * DV + dv0));
            f32x4 o = oacc[d][nq] * inv; o = (f32x4){o[0] * silu(g[0]), o[1] * silu(g[1]), o[2] * silu(g[2]), o[3] * silu(g[3])};
            *(u32x2*)(OUT + (size_t)t * 4096 + (FOX ? 1024 : 3072) + h * DV + dv0) = pack4(o); }
    }
}

typedef const __attribute__((address_space(4))) unsigned char* kaptr_t;
DI const void* kaload(int off) { kaptr_t ka = (kaptr_t)__builtin_amdgcn_kernarg_segment_ptr(); asm volatile("" : "+s"(ka)); typedef const void* cvp_t; return *(const __attribute__((address_space(4))) cvp_t*)(ka + off); }
#define INP(k) ((const float*)kaload(8 * (k)))
#define x_in INP(0)
#define positions ((const int*)kaload(8))
#define pre_norm INP(2)
#define post_norm INP(3)
#define w_in INP(4)
#define conv_w INP(5)
#define conv_b INP(6)
#define dt_bias INP(7)
#define a_log INP(8)
#define d_skip INP(9)
#define ssm_norm INP(10)
#define fgate_b INP(11)
#define gla_w2 INP(12)
#define gla_b INP(13)
#define gla_norm INP(14)
#define q_norm INP(15)
#define kv_norm INP(16)
#define w_uq INP(17)
#define w_ukv INP(18)
#define w_branch INP(19)
#define w_out INP(20)
#define CTL ((unsigned*)(ws + O_CTL))
#define SSQ ((float*)(ws + O_SSQ))
#define DTV ((float*)(ws + O_DT))
#define ACUM ((float*)(ws + O_ACUM))
#define FCUM ((float*)(ws + O_FCUM))
#define CS ((float*)(ws + O_CS))
#define SN ((float*)(ws + O_SN))
#define KROPE ((bf16_t*)(ws + O_KROPE))
#define BLAST ((float*)(ws + O_BLAST))
#define PS ((float*)(ws + O_PSMALL))
#define WBT ((bf16_t*)(ws + O_WBT))
#define WOT ((bf16_t*)(ws + O_WOT))
#define WUQT ((bf16_t*)(ws + O_WUQT))
#define WUKVT ((bf16_t*)(ws + O_WUKVT))
#define P1 ((bf16_t*)(ws + O_P1))
#define PM ((bf16_t*)(ws + O_PM))
#define OUT ((bf16_t*)(ws + O_OUT))
#define WINT ((bf16_t*)(ws + O_WINT))
#define H ((bf16_t*)(ws + O_H))
#define GST ((bf16_t*)(ws + O_GST))
#define QM ((bf16_t*)(ws + O_QM))
#define KN ((bf16_t*)(ws + O_KN))
#define VTM ((bf16_t*)(ws + O_VTM))
#define VTF ((bf16_t*)(ws + O_VTF))
#define XBC ((bf16_t*)(ws + O_XBC))
#define XBCT ((bf16_t*)(ws + O_XBCT))
#define SST ((bf16_t*)(ws + O_SST))
#define KTT ((bf16_t*)(ws + O_KTT))
#define VTG ((bf16_t*)(ws + O_VTG))
#define MIXF ((float*)(ws + O_MIXF))
#define MIXB ((bf16_t*)(ws + O_MIXB))
#define Y ((float*)(ws + O_Y))
DI void phase_body(const int ph, LAS unsigned char* lds, const int rep = 0) {
    LAS float* scrf = (LAS float*)lds; LAS bf16_t* scrb = (LAS bf16_t*)lds;
    {
        const int l = ph == 0 ? 0 : (ph - 1) >> 3, kph = ph == 0 ? -1 : (ph - 1) & 7;
        unsigned char* ws = (unsigned char*)kaload(176);
        float* const outp = (float*)kaload(168);
        const int tid = otid(), lane = tid & 63, wave = __builtin_amdgcn_readfirstlane(tid >> 6), r16 = lane & 15, fq = lane >> 4;
        const int G = osg(gridDim.x), bid = osg(blockIdx.x);
        unsigned* ctr = CTL + 16 + ph + 32 * rep;
        if ((kph == -1 || kph == 7) && (PHMASK & 0x100)) {
            const int lw = (kph == -1) ? 0 : l + 1;
            if (kph == -1) {
                if (bid == 0 && tid < 128) CTL[tid] = 0u;
                const int NI = 2 * (2048 + 1024 + 192 + 256);
                for (int it = bid; it < NI; it += G) {
                    const int ll = it / 3520; int r = it % 3520;
                    if (r < 2048) { const int br = r / 512, q = r % 512, nt = q / 16, ktile = q % 16;
                        wt_item<0>(w_branch + (size_t)(ll * 4 + br) * 1024 * 2048, 2048, 1024, WBT + ((size_t)ll * 8192 + br * 2048) * 1024, ktile * 64, nt * 64, nullptr, scrf); continue; }
                    r -= 2048;
                    if (r < 1024) { const int nt = r / 32, ktile = r % 32;
                        wt_item<0>(w_out + (size_t)ll * 2048 * 2048, 2048, 2048, WOT + (size_t)ll * 2048 * 2048, ktile * 64, nt * 64, nullptr, scrf); continue; }
                    r -= 1024;
                    if (r < 192) { const int nt = r / 8, ktile = r % 8;
                        wt_item<0>(w_uq + (size_t)ll * 512 * 1536, 1536, 512, WUQT + (size_t)ll * 1536 * 512, ktile * 64, nt * 64, q_norm + ll * 512, scrf); continue; }
                    r -= 192;
                    { const int nt = r / 8, ktile = r % 8;
                        wt_item<2>(w_ukv + (size_t)ll * 512 * 2048, 2048, 512, WUKVT + (size_t)ll * 2048 * 512, ktile * 64, nt * 64, kv_norm + ll * 512, scrf); }
                }
                for (int row = bid * 8 + wave; row < T_; row += G * 8) rms_row_to_bf16(x_in + (size_t)row * DM, pre_norm, H + (size_t)row * DM, lane);
            } else {
                const float* xsrc = (l == 0) ? x_in : outp;
                for (int row = bid * 8 + wave; row < T_; row += G * 8) {
                    f32x4 v[8]; float s = 0.f;
#pragma unroll
                    for (int j = 0; j < 8; ++j) { v[j] = ((const f32x4*)(Y + (size_t)row * DM))[lane + 64 * j]; s += v[j][0] * v[j][0] + v[j][1] * v[j][1] + v[j][2] * v[j][2] + v[j][3] * v[j][3]; }
                    const float r = rsqrtf(wave_sum(s) * (1.f / 2048.f) + EPS); float s2 = 0.f;
#pragma unroll
                    for (int j = 0; j < 8; ++j) { const f32x4 pw = ((const f32x4*)(post_norm + l * DM))[lane + 64 * j]; const f32x4 xv = ((const f32x4*)(xsrc + (size_t)row * DM))[lane + 64 * j];
                        v[j] = xv + v[j] * pw * r; ((f32x4*)(outp + (size_t)row * DM))[lane + 64 * j] = v[j]; s2 += v[j][0] * v[j][0] + v[j][1] * v[j][1] + v[j][2] * v[j][2] + v[j][3] * v[j][3]; }
                    if (l == 0) { const float r2 = rsqrtf(wave_sum(s2) * (1.f / 2048.f) + EPS);
#pragma unroll
                        for (int j = 0; j < 8; ++j) { const f32x4 ww = ((const f32x4*)(pre_norm + DM))[lane + 64 * j]; *(u32x2*)(H + (size_t)row * DM + (size_t)(lane + 64 * j) * 4) = pack4(v[j] * ww * r2); } }
                }
            }
            if (lw < 2) {
                if (bid == 0 && tid < 128) CTL[256 + tid] = 0u;
                for (int it = bid; it < 316 * 32; it += G) { const int nt = it / 32, ktile = it % 32;
                    wt_item<1>(w_in + (size_t)lw * 2048 * NIN, NIN, 2048, WINT, ktile * 64, nt * 64, nullptr, scrf); }
            }
        } else if (kph == 0 && (PHMASK >> 0 & 1)) {
            pg8::ProjOrder S{(const char*)H, (const char*)WINT, G, bid};
            pg8::EpiProj E{P1, PM, PS, rep ? nullptr : SSQ, VTF, VTG};
            pg8::gemm_phase(lds, 2048, 2048, 2048, S, E);
        } else if (kph == 1 && (PHMASK >> 1 & 1)) {
#ifndef NO_M1GEMM
            { pg8::MlaOrder S{(const char*)P1, (const char*)(WUQT + (size_t)l * 1536 * 512), (const char*)(WUKVT + (size_t)l * 2048 * 512), G, bid};
              pg8::EpiMla E{SSQ, QM, KN};
              pg8::gemm_phase(lds, 512, NP1, 512, S, E); }
            { pg8::MlaVOrder S{(const char*)P1, (const char*)(WUKVT + ((size_t)l * 2048 + 1024) * 512), G, bid};
              pg8::EpiMlaV E{SSQ, VTM};
              pg8::gemm_phase(lds, 512, 512, NP1, S, E); }
#endif
            constexpr int N_C = 8, N_A = 384, N_E = 256, N_B = 128, N_N = 256, N_D = 1024;
            constexpr int NTOT = N_C + N_A + N_E + N_B + N_N + N_D;
            for (;;) {
                int it = next_item(ctr, lds); if (it >= NTOT) break;
                if (it < N_C) { LANEIDS
                    const int b = it >> 1, h = (it & 1) * 8 + wave; const float fb = fgate_b[l * 16 + h]; float carry = 0.f;
                    for (int j = 0; j < 64; ++j) { const int s = j * 64 + lane;
                        float v = logsig(PS[(size_t)(b * S_ + s) * 128 + 16 + h] + fb);
#pragma unroll
                        for (int o = 1; o < 64; o <<= 1) { const float y = __shfl_up(v, o); if (lane >= o) v += y; }
                        v += carry; FCUM[(size_t)(b * 16 + h) * S_ + s] = v * LOG2E; carry = __shfl(v, 63); }
                    continue; }
                it -= N_C;
                if (it < N_A) { LANEIDS
                    const int cgp = it % 3, bc = it / 3, ch = cgp * 512 + tid, t0 = bc * 128; const bool first = (bc & 31) == 0;
                    const float w0 = conv_w[(size_t)l * 4 * 1536 + ch], w1 = conv_w[(size_t)l * 4 * 1536 + 1536 + ch], w2 = conv_w[(size_t)l * 4 * 1536 + 2 * 1536 + ch], w3 = conv_w[(size_t)l * 4 * 1536 + 3 * 1536 + ch];
                    const float cb = conv_b[l * 1536 + ch];
                    float xm3 = 0.f, xm2 = 0.f, xm1 = 0.f;
                    if (!first) { xm3 = bf1(P1[(size_t)(t0 - 3) * NP1 + C_XBC + ch]); xm2 = bf1(P1[(size_t)(t0 - 2) * NP1 + C_XBC + ch]); xm1 = bf1(P1[(size_t)(t0 - 1) * NP1 + C_XBC + ch]); }
                    for (int l8 = 0; l8 < 16; ++l8) { float o8[8];
#pragma unroll
                        for (int i = 0; i < 8; ++i) { const int t = t0 + l8 * 8 + i; const float xin = bf1(P1[(size_t)t * NP1 + C_XBC + ch]);
                            const float y = cb + w0 * xm3 + w1 * xm2 + w2 * xm1 + w3 * xin; const float a = silu(y); o8[i] = a;
                            XBC[(size_t)t * 1536 + ch] = (bf16_t)f2bf(a); xm3 = xm2; xm2 = xm1; xm1 = xin; }
                        if (ch < 1280) *(bf16x8*)(XBCT + ((size_t)bc * 1280 + ch) * 128 + l8 * 8) = pack8(o8); }
                    continue; }
                it -= N_A;
                if (it < N_E) { LANEIDS
                    const int col = tid, t0 = it * 64; float w2r[16];
#pragma unroll
                    for (int r = 0; r < 16; ++r) w2r[r] = gla_w2[(size_t)l * 16 * 512 + r * 512 + col];
                    const float gb = gla_b[l * 512 + col]; float cum = 0.f;
                    for (int j8 = 0; j8 < 8; ++j8) { float k8[8];
#pragma unroll
                        for (int i = 0; i < 8; ++i) { const int t = t0 + j8 * 8 + i; float z = gb;
#pragma unroll
                            for (int r = 0; r < 16; ++r) z += PS[(size_t)t * 128 + 32 + r] * w2r[r];
                            cum += logsig(z) * (1.f / 16.f);
                            bf16_t* qp = P1 + (size_t)t * NP1 + C_GQ + col; bf16_t* kp = P1 + (size_t)t * NP1 + C_GK + col;
                            const float qt = bf1(*qp) * 0.08838834764831845f * __expf(cum), kt = bf1(*kp) * __expf(-cum);
                            *qp = (bf16_t)f2bf(qt); *kp = (bf16_t)f2bf(kt); k8[i] = kt; }
                        *(bf16x8*)(KTT + ((size_t)it * 512 + col) * 64 + j8 * 8) = pack8(k8); }
                    BLAST[(size_t)it * 512 + col] = cum;
                    continue; }
                it -= N_E;
                if (it < N_B) { LANEIDS
                    const int t0 = it * 128;
#pragma unroll
                    for (int hh = 0; hh < 2; ++hh) { const int h = wave * 2 + hh; const float a = -__expf(a_log[l * 16 + h]), db = dt_bias[l * 16 + h];
                        const float d0 = softplus_(PS[(size_t)(t0 + 2 * lane) * 128 + h] + db), d1 = softplus_(PS[(size_t)(t0 + 2 * lane + 1) * 128 + h] + db);
                        const float c0 = d0 * a, c1 = c0 + d1 * a; float v = c1;
#pragma unroll
                        for (int o = 1; o < 64; o <<= 1) { const float y = __shfl_up(v, o); if (lane >= o) v += y; }
                        const float pre = v - c1;
                        DTV[(size_t)(t0 + 2 * lane) * 16 + h] = d0; DTV[(size_t)(t0 + 2 * lane + 1) * 16 + h] = d1;
                        ACUM[(size_t)(t0 + 2 * lane) * 16 + h] = pre + c0; ACUM[(size_t)(t0 + 2 * lane + 1) * 16 + h] = pre + c1; }
                    continue; }
                it -= N_B;
                if (it < N_N) { LANEIDS
                    const int hh = tid & 15, t0 = it * 64, b = t0 >> 12; float qm = 0.f, km = 0.f;
#pragma unroll
                    for (int p = 0; p < 2; ++p) { const int t = t0 + p * 32 + (tid >> 4); float qs = 0.f, ks = 0.f;
#pragma unroll
                        for (int c = 0; c < 8; ++c) { float a[8], k8[8]; unpack8(ld16(P1 + (size_t)t * NP1 + C_FQ + hh * 64 + c * 8), a); unpack8(ld16(P1 + (size_t)t * NP1 + C_FK + hh * 64 + c * 8), k8);
#pragma unroll
                            for (int e = 0; e < 8; ++e) { qs += a[e] * a[e]; ks += k8[e] * k8[e]; } }
                        qm = fmaxf(qm, qs); km = fmaxf(km, ks); }
                    qm = fmaxf(qm, __shfl_xor(qm, 16)); qm = fmaxf(qm, __shfl_xor(qm, 32)); km = fmaxf(km, __shfl_xor(km, 16)); km = fmaxf(km, __shfl_xor(km, 32));
                    if (lane < 16) { atomicMax(CTL + 256 + (b * 16 + hh) * 2, __float_as_uint(qm)); atomicMax(CTL + 256 + (b * 16 + hh) * 2 + 1, __float_as_uint(km)); }
                    continue; }
                it -= N_N;
                { LANEIDS
                    const int t = it * 16 + (tid >> 5), j = tid & 31;
                    const float invf = exp2f(-(float)j * 0.41524101186092029f);
                    const float ang = (float)positions[t] * invf;
                    double rev = (double)ang * 0.15915494309189535; rev -= floor(rev + 0.5);
                    const float fr_ = (float)rev; const float c = __builtin_amdgcn_cosf(fr_), s = __builtin_amdgcn_sinf(fr_);
                    CS[(size_t)t * 32 + j] = c; SN[(size_t)t * 32 + j] = s;
                    const float lo = PS[(size_t)t * 128 + 48 + j], hi = PS[(size_t)t * 128 + 80 + j];
                    KROPE[(size_t)t * 64 + j] = (bf16_t)f2bf(lo * c - hi * s); KROPE[(size_t)t * 64 + 32 + j] = (bf16_t)f2bf(lo * s + hi * c);
                    continue; }
            }
        } else if (kph == 2 && (PHMASK >> 2 & 1)) {
            constexpr int N_M = 512, N_X = 1024, N_S = 2048, N_K = 1024, NTOT = N_M + N_X + N_S + N_K;
            for (;;) {
                int it = next_item(ctr, lds); if (it >= NTOT) break;
                if (it < N_M) { const int qb = 15 - (it >> 5), rem = it & 31;
                    attn_unit<192, 128, false, false, MLA_FAST>(lds, rem >> 3, rem & 7, qb, ws); continue; }
                it -= N_M;
                if (it < N_X) { const int qb = 15 - (it >> 6), rem = it & 63;
                    attn_unit<64, 64, true, true, FOX_FAST>(lds, rem >> 4, rem & 15, qb, ws); continue; }
                it -= N_X;
                if (it < N_S) { LANEIDS
                    const int h = it & 15, chunk = it >> 4, t0 = chunk * 128, g = h >> 3;
                    const float alast = ACUM[(size_t)(t0 + 127) * 16 + h];
                    f32x4 acc[4];
#pragma unroll
                    for (int p = 0; p < 4; ++p) acc[p] = (f32x4){0.f, 0.f, 0.f, 0.f};
#pragma unroll
                    for (int ks = 0; ks < 4; ++ks) {
                        float bv[8]; unpack8(ld16(XBCT + ((size_t)chunk * 1280 + 1024 + g * 128 + 16 * wave + r16) * 128 + ks * 32 + fq * 8), bv);
#pragma unroll
                        for (int i = 0; i < 8; ++i) { const int tl = t0 + ks * 32 + fq * 8 + i; bv[i] *= DTV[(size_t)tl * 16 + h] * __expf(alast - ACUM[(size_t)tl * 16 + h]); }
                        const bf16x8 bw = pack8(bv);
#pragma unroll
                        for (int p = 0; p < 4; ++p) acc[p] = MFMA16(bw, ld16(XBCT + ((size_t)chunk * 1280 + h * 64 + 16 * p + r16) * 128 + ks * 32 + fq * 8), acc[p]);
                    }
#pragma unroll
                    for (int p = 0; p < 4; ++p) *(u32x2*)(SST + ((size_t)chunk * 16 + h) * 8192 + (16 * p + r16) * 128 + 16 * wave + 4 * fq) = pack4(acc[p]);
                    continue; }
                it -= N_S;
                { LANEIDS
                    const int gc = it >> 2, h = it & 3, b = gc >> 6, c = gc & 63, bh = b * 4 + h;
                    bf16x8 kf[2];
#pragma unroll
                    for (int ks = 0; ks < 2; ++ks) kf[ks] = ld16(KTT + ((size_t)gc * 512 + h * 128 + 16 * wave + r16) * 64 + ks * 32 + fq * 8);
                    const f32x4 eb = *(const f32x4*)(BLAST + (size_t)gc * 512 + h * 128 + 16 * wave + 4 * fq);
                    const f32x4 ee = {__expf(eb[0]), __expf(eb[1]), __expf(eb[2]), __expf(eb[3])};
#pragma unroll 4
                    for (int et = 0; et < 16; ++et) { f32x4 acc = {0.f, 0.f, 0.f, 0.f};
#pragma unroll
                        for (int ks = 0; ks < 2; ++ks) acc = MFMA16(kf[ks], ld16(VTG + ((size_t)gc * 1024 + h * 256 + 16 * et + r16) * 64 + ks * 32 + fq * 8), acc);
                        *(u32x2*)(GST + (((size_t)bh * 64 + c) * 256 + 16 * et + r16) * 128 + 16 * wave + 4 * fq) = pack4(acc * ee); }
                }
            }
        } else if (kph == 3 && (PHMASK >> 3 & 1)) {
            for (int it = bid; it < 256; it += G) {
                if (it < 128) { const int e8 = (it * 512 + tid) * 8, bh = e8 >> 13, off = e8 & 8191, b = bh >> 4, h = bh & 15;
                    float st[8];
#pragma unroll
                    for (int i = 0; i < 8; ++i) st[i] = 0.f;
                    for (int cg8 = 0; cg8 < 4; ++cg8) { bf16x8 vv[8]; float dec[8];
#pragma unroll
                        for (int q = 0; q < 8; ++q) { const int c = cg8 * 8 + q; vv[q] = *(const bf16x8*)(SST + ((size_t)(b * 32 + c) * 16 + h) * 8192 + off); dec[q] = ACUM[(size_t)(b * S_ + c * 128 + 127) * 16 + h]; }
#pragma unroll
                        for (int q = 0; q < 8; ++q) { const int c = cg8 * 8 + q; float v[8]; unpack8(vv[q], v); const float d = __expf(dec[q]);
                            *(bf16x8*)(SST + ((size_t)(b * 32 + c) * 16 + h) * 8192 + off) = pack8(st);
#pragma unroll
                            for (int i = 0; i < 8; ++i) st[i] = st[i] * d + v[i]; } }
                } else { const int e8 = ((it - 128) * 512 + tid) * 8, bh = e8 >> 15, off = e8 & 32767, d0 = off & 127, b = bh >> 2, h = bh & 3;
                    float st[8];
#pragma unroll
                    for (int i = 0; i < 8; ++i) st[i] = 0.f;
                    for (int cg8 = 0; cg8 < 8; ++cg8) { bf16x8 vv[8]; f32x4 e0[8], e1[8];
#pragma unroll
                        for (int q = 0; q < 8; ++q) { const int c = cg8 * 8 + q; vv[q] = *(const bf16x8*)(GST + ((size_t)bh * 64 + c) * 32768 + off);
                            e0[q] = *(const f32x4*)(BLAST + (size_t)(b * 64 + c) * 512 + h * 128 + d0); e1[q] = *(const f32x4*)(BLAST + (size_t)(b * 64 + c) * 512 + h * 128 + d0 + 4); }
#pragma unroll
                        for (int q = 0; q < 8; ++q) { const int c = cg8 * 8 + q; float v[8]; unpack8(vv[q], v);
                            *(bf16x8*)(GST + ((size_t)bh * 64 + c) * 32768 + off) = pack8(st);
#pragma unroll
                            for (int i = 0; i < 8; ++i) st[i] = st[i] * __expf(i < 4 ? e0[q][i & 3] : e1[q][i & 3]) + v[i]; } }
                }
            }
        } else if (kph == 4 && (PHMASK >> 4 & 1)) {
            constexpr int N_S = 256, N_G = 1024, NTOT = N_S + N_G;
            for (;;) {
                int it = next_item(ctr, lds); if (it >= NTOT) break;
                if (it < N_S) { LANEIDS
                    const int g = it & 1, chunk = it >> 1, t0 = chunk * 128;
                    LAS float* sAc = (LAS float*)lds; LAS float* sDt = sAc + 1024;
                    for (int i = tid; i < 1024; i += 512) { const int hh = i >> 7, s = i & 127; sAc[i] = ACUM[(size_t)(t0 + s) * 16 + g * 8 + hh]; sDt[i] = DTV[(size_t)(t0 + s) * 16 + g * 8 + hh]; }
                    __syncthreads();
                    const int tl = t0 + 16 * wave + r16, lpos = 16 * wave + r16;
                    bf16x8 cf[4];
#pragma unroll
                    for (int ks = 0; ks < 4; ++ks) cf[ks] = ld16(XBC + (size_t)tl * 1536 + 1280 + g * 128 + ks * 32 + fq * 8);
                    f32x4 gacc[8];
#pragma unroll
                    for (int mt = 0; mt < 8; ++mt) { gacc[mt] = (f32x4){0.f, 0.f, 0.f, 0.f};
                        if (mt <= wave) {
#pragma unroll
                            for (int ks = 0; ks < 4; ++ks) gacc[mt] = MFMA16(ld16(XBC + (size_t)(t0 + 16 * mt + r16) * 1536 + 1024 + g * 128 + ks * 32 + fq * 8), cf[ks], gacc[mt]); } }
                    float ssq = 0.f;
#pragma unroll 2
                    for (int hh = 0; hh < 8; ++hh) { const int h = g * 8 + hh;
                        const float al = sAc[hh * 128 + lpos], el = __expf(al);
                        f32x4 acc1[4], acc2[4];
#pragma unroll
                        for (int p = 0; p < 4; ++p) { acc1[p] = (f32x4){0.f, 0.f, 0.f, 0.f}; acc2[p] = (f32x4){0.f, 0.f, 0.f, 0.f}; }
#pragma unroll
                        for (int ss = 0; ss < 4; ++ss) if (2 * ss <= wave) {
                            f32x4 wv[2];
#pragma unroll
                            for (int q = 0; q < 2; ++q) { const int mt = 2 * ss + q; const f32x4 as = *(const LAS f32x4*)(sAc + hh * 128 + 16 * mt + 4 * fq), ds = *(const LAS f32x4*)(sDt + hh * 128 + 16 * mt + 4 * fq);
#pragma unroll
                                for (int j = 0; j < 4; ++j) { const int spos = 16 * mt + 4 * fq + j; wv[q][j] = (spos <= lpos) ? gacc[mt][j] * __expf(fminf(al - as[j], 0.f)) * ds[j] : 0.f; } }
                            const bf16x8 wp = pack44(wv[0], wv[1]);
#pragma unroll
                            for (int p = 0; p < 4; ++p) { const bf16_t* xp = XBCT + ((size_t)chunk * 1280 + h * 64 + 16 * p + r16) * 128 + 32 * ss + 4 * fq;
                                acc1[p] = MFMA16(ld8x2(xp, xp + 16), wp, acc1[p]); }
                        }
#pragma unroll
                        for (int ks = 0; ks < 4; ++ks)
#pragma unroll
                            for (int p = 0; p < 4; ++p) acc2[p] = MFMA16(ld16(SST + ((size_t)chunk * 16 + h) * 8192 + (16 * p + r16) * 128 + ks * 32 + fq * 8), cf[ks], acc2[p]);
                        const float dsk = d_skip[l * 16 + h];
#pragma unroll
                        for (int p = 0; p < 4; ++p) { const int pc = h * 64 + 16 * p + 4 * fq;
                            const f32x4 xv = unpack4(*(const u32x2*)(XBC + (size_t)tl * 1536 + pc)), zv = unpack4(*(const u32x2*)(P1 + (size_t)tl * NP1 + C_MZ + pc));
                            f32x4 y = acc1[p] + acc2[p] * el + xv * dsk;
                            y = (f32x4){y[0] * silu(zv[0]), y[1] * silu(zv[1]), y[2] * silu(zv[2]), y[3] * silu(zv[3])};
                            ssq += y[0] * y[0] + y[1] * y[1] + y[2] * y[2] + y[3] * y[3];
                            *(u32x2*)(OUT + (size_t)tl * 4096 + pc) = pack4(y); }
                    }
                    ssq += __shfl_xor(ssq, 16); ssq += __shfl_xor(ssq, 32);
                    const float rs = rsqrtf(ssq * (1.f / 512.f) + EPS);
                    asm volatile("s_waitcnt vmcnt(0)" ::: "memory");
                    for (int hh = 0; hh < 8; ++hh)
#pragma unroll
                        for (int p = 0; p < 4; ++p) { const int pc = (g * 8 + hh) * 64 + 16 * p + 4 * fq; bf16_t* op = OUT + (size_t)tl * 4096 + pc;
                            const f32x4 nw = *(const f32x4*)(ssm_norm + l * 1024 + pc); *(u32x2*)op = pack4(unpack4(*(const u32x2*)op) * nw * rs); }
                    continue; }
                it -= N_S;
                { LANEIDS
                    const int gc = it >> 2, h = it & 3, b = gc >> 6, c = gc & 63, bh = b * 4 + h, t0 = gc * 64;
                    const int itl = wave & 3, eh = wave >> 2, ti = t0 + 16 * itl + r16, ipos = 16 * itl + r16;
                    LAS float* sSS = (LAS float*)(lds + MISC_OFF + 64);
                    bf16x8 qf[4];
#pragma unroll
                    for (int ks = 0; ks < 4; ++ks) qf[ks] = ld16(P1 + (size_t)ti * NP1 + C_GQ + h * 128 + ks * 32 + fq * 8);
                    f32x4 aacc[4];
#pragma unroll
                    for (int mt = 0; mt < 4; ++mt) { aacc[mt] = (f32x4){0.f, 0.f, 0.f, 0.f};
                        if (mt <= itl) {
#pragma unroll
                            for (int ks = 0; ks < 4; ++ks) aacc[mt] = MFMA16(ld16(P1 + (size_t)(t0 + 16 * mt + r16) * NP1 + C_GK + h * 128 + ks * 32 + fq * 8), qf[ks], aacc[mt]);
#pragma unroll
                            for (int j = 0; j < 4; ++j) if (16 * mt + 4 * fq + j > ipos) aacc[mt][j] = 0.f; } }
                    bf16x8 wp[2]; wp[0] = pack44(aacc[0], aacc[1]); wp[1] = pack44(aacc[2], aacc[3]);
                    f32x4 oacc[8]; float ssq = 0.f;
#pragma unroll
                    for (int et = 0; et < 8; ++et) { const int e = 16 * (8 * eh + et) + r16; f32x4 o = {0.f, 0.f, 0.f, 0.f};
#pragma unroll
                        for (int ss = 0; ss < 2; ++ss) if (2 * ss <= itl) { const bf16_t* vp = VTG + ((size_t)gc * 1024 + h * 256 + e) * 64 + 32 * ss + 4 * fq; o = MFMA16(ld8x2(vp, vp + 16), wp[ss], o); }
#pragma unroll
                        for (int ks = 0; ks < 4; ++ks) o = MFMA16(ld16(GST + (((size_t)bh * 64 + c) * 256 + e) * 128 + ks * 32 + fq * 8), qf[ks], o);
                        oacc[et] = o; ssq += o[0] * o[0] + o[1] * o[1] + o[2] * o[2] + o[3] * o[3]; }
                    ssq += __shfl_xor(ssq, 16); ssq += __shfl_xor(ssq, 32);
                    if (fq == 0) sSS[eh * 64 + ipos] = ssq;
                    __syncthreads();
                    const float rs = rsqrtf((sSS[ipos] + sSS[64 + ipos]) * (1.f / 256.f) + EPS);
#pragma unroll
                    for (int et = 0; et < 8; ++et) { const int e0 = 16 * (8 * eh + et) + 4 * fq;
                        const f32x4 gv = unpack4(*(const u32x2*)(P1 + (size_t)ti * NP1 + C_GG + h * 256 + e0)), nw = *(const f32x4*)(gla_norm + l * 256 + e0);
                        f32x4 o = oacc[et] * nw * rs; o = (f32x4){o[0] * silu(gv[0]), o[1] * silu(gv[1]), o[2] * silu(gv[2]), o[3] * silu(gv[3])};
                        *(u32x2*)(OUT + (size_t)ti * 4096 + 2048 + h * 256 + e0) = pack4(o); }
                }
            }
        } else if (kph == 5 && (PHMASK >> 5 & 1)) {
            pg8::MergeOrder S{(const char*)OUT, (const char*)(WBT + (size_t)l * 8192 * 1024), G, bid};
            pg8::EpiMerge E{PM, MIXF, MIXB};
            pg8::gemm_phase(lds, 1024, 4096, 1024, S, E);
        } else if (kph == 6 && (PHMASK >> 6 & 1)) {
            pg8::PlainOrder S{(const char*)MIXB, (const char*)(WOT + (size_t)l * 2048 * 2048), 64, 8, G, bid, (size_t)256 * 2048 * 2, (size_t)256 * 2048 * 2};
            pg8::EpiOut E{Y};
            pg8::gemm_phase(lds, 2048, 2048, 2048, S, E);
        }
    }
}
__global__ void __launch_bounds__(512, 2) mk_fwd(Args args) {
    extern __shared__ __attribute__((aligned(16))) unsigned char lds_raw[];
    LAS unsigned char* lds = (LAS unsigned char*)lds_raw;
    const int lo = args.ph_lo, hi = args.ph_hi;
#define PH(k) if (lo <= (k) && (k) < hi) { phase_body((k), lds); if ((k) > 0 && (((k) - 1) & 7) == REP_KPH) { cg::this_grid().sync(); phase_body((k), lds, 1); } if ((k) + 1 < hi) cg::this_grid().sync(); }
    PH(0) PH(1) PH(2) PH(3) PH(4) PH(5) PH(6) PH(7) PH(8) PH(9) PH(10) PH(11) PH(12) PH(13) PH(14) PH(15) PH(16)
#undef PH
}

extern "C" void kernel_launch(void* const* d_in, const int* in_sizes, int n_in, void* d_out, int out_size, void* d_ws, size_t ws_size, hipStream_t stream) {
    static int grid = 0;
    if (grid == 0) {
        if (n_in != 21 || ws_size < WS_END) { fprintf(stderr, "kernel_launch: unexpected n_in %d or ws_size %zu (< %zu)\n", n_in, ws_size, (size_t)WS_END); }
        int dev = 0, cus = 0, per_cu = 0;
        hipGetDevice(&dev); hipDeviceGetAttribute(&cus, hipDeviceAttributeMultiprocessorCount, dev);
        hipFuncSetAttribute((const void*)mk_fwd, hipFuncAttributeMaxDynamicSharedMemorySize, LDS_BYTES);
        hipOccupancyMaxActiveBlocksPerMultiprocessor(&per_cu, (const void*)mk_fwd, 512, LDS_BYTES);
        if (per_cu < 1) { fprintf(stderr, "kernel_launch: occupancy query says %d blocks/CU\n", per_cu); per_cu = 1; }
        (void)hipGetLastError();
        grid = cus * 1;
        if (grid <= 0) grid = 256;
    }
    Args a{};
    for (int i = 0; i < 21; ++i) a.in[i] = d_in[i];
    a.out = (float*)d_out; a.ws = (unsigned char*)d_ws;
#if MK_SINGLE
    a.ph_lo = 0; a.ph_hi = NPHASE;
    void* kargs[] = {&a};
    hipError_t e = hipLaunchCooperativeKernel((const void*)mk_fwd, dim3(grid), dim3(512), kargs, LDS_BYTES, stream);
    if (e != hipSuccess) fprintf(stderr, "cooperative launch failed: %s (grid %d)\n", hipGetErrorString(e), grid);
#else
    for (int ph = 0; ph < NPHASE; ++ph) { a.ph_lo = ph; a.ph_hi = ph + 1;
        hipLaunchKernelGGL(mk_fwd, dim3(grid), dim3(512), LDS_BYTES, stream, a); }
#endif
}
```

```cpp
#include <hip/hip_runtime.h>
#include <hip/hip_cooperative_groups.h>
#include <cstdio>
#include <cstdint>
namespace cg = cooperative_groups;

#ifndef PHMASK
#define PHMASK 0x1ff
#endif
#ifndef MLA_FAST
#define MLA_FAST false
#endif
#ifndef FOX_FAST
#define FOX_FAST true
#endif
#ifndef REP_KPH
#define REP_KPH -2
#endif
#ifndef MK_SINGLE
#define MK_SINGLE 1
#endif

#define LAS __attribute__((address_space(3)))
#define DI __device__ __forceinline__
typedef unsigned short bf16_t;
typedef short bf16x8 __attribute__((ext_vector_type(8)));
typedef short s16x4 __attribute__((ext_vector_type(4)));
typedef float f32x4 __attribute__((ext_vector_type(4)));
typedef unsigned u32x4 __attribute__((ext_vector_type(4)));
typedef unsigned u32x2 __attribute__((ext_vector_type(2)));
#define MFMA16(a, b, c) __builtin_amdgcn_mfma_f32_16x16x32_bf16((a), (b), (c), 0, 0, 0)

constexpr int T_ = 16384, S_ = 4096, DM = 2048;
constexpr int NIN = 20080, NP1 = 11776, NPM = 8192, NW1 = 20224;
constexpr int C_MZ = 0, C_XBC = 1024, C_FQ = 2560, C_FK = 3584, C_FV = 4608, C_FG = 5632, C_GQ = 6656, C_GK = 7168, C_GV = 7680,
              C_GG = 8704, C_LCQ = 9728, C_LCKV = 10240, C_LG = 10752;
constexpr float EPS = 1e-6f;
constexpr float LOG2E = 1.4426950408889634f;

constexpr size_t MiB = 1u << 20;
constexpr size_t O_CTL = 0;
constexpr size_t O_SSQ = 1 * MiB;
constexpr size_t O_DT = 2 * MiB;
constexpr size_t O_ACUM = 3 * MiB;
constexpr size_t O_FCUM = 4 * MiB;
constexpr size_t O_CS = 5 * MiB;
constexpr size_t O_SN = 7 * MiB;
constexpr size_t O_KROPE = 9 * MiB;
constexpr size_t O_BLAST = 11 * MiB;
constexpr size_t O_PSMALL = 12 * MiB;
constexpr size_t O_WBT = 20 * MiB;
constexpr size_t O_WOT = 52 * MiB;
constexpr size_t O_WUQT = 68 * MiB;
constexpr size_t O_WUKVT = 71 * MiB;
constexpr size_t O_P1 = 75 * MiB;
constexpr size_t O_PM = 443 * MiB;
constexpr size_t O_OUT = 699 * MiB;
constexpr size_t O_WINT = O_OUT;
constexpr size_t O_H = 827 * MiB;
constexpr size_t O_GST = O_H;
constexpr size_t O_QM = 891 * MiB;
constexpr size_t O_KN = 939 * MiB;
constexpr size_t O_VTM = 971 * MiB;
constexpr size_t O_VTF = 1003 * MiB;
constexpr size_t O_XBC = 1035 * MiB;
constexpr size_t O_XBCT = 1083 * MiB;
constexpr size_t O_SST = 1123 * MiB;
constexpr size_t O_KTT = 1155 * MiB;
constexpr size_t O_VTG = 1171 * MiB;
constexpr size_t WS_END = 1203 * MiB;
constexpr size_t O_MIXF = O_P1;
constexpr size_t O_MIXB = O_P1 + 128 * MiB;
constexpr size_t O_Y = O_P1 + 192 * MiB;

constexpr int LDS_BYTES = 135168;
constexpr int MISC_OFF = 131072;
constexpr int NPHASE = 17;

DI unsigned f2bf(float f) { unsigned u = __float_as_uint(f); return (u + 0x7fffu + ((u >> 16) & 1u)) >> 16; }
typedef float f32x2_t __attribute__((ext_vector_type(2)));
typedef __bf16 bf16x2_t __attribute__((ext_vector_type(2)));
DI unsigned pk2(float lo, float hi) { f32x2_t v = {lo, hi}; bf16x2_t b = __builtin_convertvector(v, bf16x2_t); return __builtin_bit_cast(unsigned, b); }
DI float bflo(unsigned u) { return __uint_as_float(u << 16); }
DI float bfhi(unsigned u) { return __uint_as_float(u & 0xffff0000u); }
DI float bf1(bf16_t b) { return __uint_as_float(((unsigned)b) << 16); }
DI float sigm(float x) { return 1.f / (1.f + __expf(-x)); }
DI float silu(float x) { return x / (1.f + __expf(-x)); }
DI float softplus_(float x) { return fmaxf(x, 0.f) + log1pf(__expf(-fabsf(x))); }
DI float logsig(float x) { return fminf(x, 0.f) - log1pf(__expf(-fabsf(x))); }
DI float xmax_fq(float x) {
    auto a = __builtin_amdgcn_permlane32_swap(__float_as_uint(x), __float_as_uint(x), false, false);
    x = fmaxf(__uint_as_float(a[0]), __uint_as_float(a[1]));
    auto b = __builtin_amdgcn_permlane16_swap(__float_as_uint(x), __float_as_uint(x), false, false);
    return fmaxf(__uint_as_float(b[0]), __uint_as_float(b[1]));
}
DI float wave_sum(float v) {
#pragma unroll
    for (int o = 1; o < 64; o <<= 1) v += __shfl_xor(v, o);
    return v;
}
DI void unpack8(bf16x8 v, float (&f)[8]) {
    u32x4 u = __builtin_bit_cast(u32x4, v);
    f[0] = bflo(u.x); f[1] = bfhi(u.x); f[2] = bflo(u.y); f[3] = bfhi(u.y); f[4] = bflo(u.z); f[5] = bfhi(u.z); f[6] = bflo(u.w); f[7] = bfhi(u.w);
}
DI bf16x8 pack8(const float (&f)[8]) {
    u32x4 u; u.x = pk2(f[0], f[1]); u.y = pk2(f[2], f[3]); u.z = pk2(f[4], f[5]); u.w = pk2(f[6], f[7]);
    return __builtin_bit_cast(bf16x8, u);
}
DI bf16x8 pack44(f32x4 a, f32x4 b) {
    u32x4 u; u.x = pk2(a[0], a[1]); u.y = pk2(a[2], a[3]); u.z = pk2(b[0], b[1]); u.w = pk2(b[2], b[3]);
    return __builtin_bit_cast(bf16x8, u);
}
DI u32x2 pack4(f32x4 a) { u32x2 u; u.x = pk2(a[0], a[1]); u.y = pk2(a[2], a[3]); return u; }
DI f32x4 unpack4(u32x2 u) { return (f32x4){bflo(u.x), bfhi(u.x), bflo(u.y), bfhi(u.y)}; }
DI bf16x8 ld16(const bf16_t* p) { return *(const bf16x8*)p; }
DI bf16x8 ld8x2(const bf16_t* p0, const bf16_t* p1) {
    s16x4 a = *(const s16x4*)p0, b = *(const s16x4*)p1;
    return __builtin_shufflevector(a, b, 0, 1, 2, 3, 4, 5, 6, 7);
}

DI int otid() { int t = threadIdx.x; asm volatile("" : "+v"(t)); return t; }
#define LANEIDS const int tid = otid(), lane = tid & 63, wave = __builtin_amdgcn_readfirstlane(tid >> 6), r16 = lane & 15, fq = lane >> 4; (void)tid; (void)lane; (void)wave; (void)r16; (void)fq;
DI int osg(int v) { asm volatile("" : "+s"(v)); return v; }
struct Args { const void* in[21]; float* out; unsigned char* ws; int ph_lo, ph_hi; };

DI int next_item(unsigned* ctr, LAS unsigned char* lds) {
    volatile LAS int* s = (volatile LAS int*)(lds + MISC_OFF);
    __syncthreads();
    if (threadIdx.x == 0) *s = (int)atomicAdd(ctr, 1u);
    __syncthreads();
    return *s;
}

namespace pg8 {
constexpr int BM = 256, BK = 64, HALF = 128, HTB = HALF * BK * 2, STAGE_BYTES = 8 * HTB, NXCD = 8, WGM = 8;
DI int lds_byte(int r, int c) { const int st = (r >> 4) * 2 + (c >> 5), rr = r & 15, cc = c & 31, ob = rr * 64 + cc * 2; return st * 1024 + (ob ^ (((ob >> 9) & 1) << 5)); }
DI void stage_rc(int b, int& R, int& C) { const int st = b / 1024, sb = b % 1024, swz = sb ^ (((sb >> 9) & 1) << 5); R = (st >> 1) * 16 + swz / 64; C = (st & 1) * 32 + (swz % 64) / 2; }
DI int perm32(int rho) { const int n = rho >> 4, i = rho & 15; return 8 * (i >> 2) + 4 * n + (i & 3); }

struct Unit { int pm, pn, aux; const char* A; const char* B; };

DI void tile_of(int L, int nM, int nN, int& pm, int& pn) {
    const int nwg = nM * nN; int wgid = L;
    { const int q = nwg / NXCD, r = nwg % NXCD, xcd = wgid % NXCD, off = wgid / NXCD; wgid = (xcd < r ? xcd * (q + 1) : r * (q + 1) + (xcd - r) * q) + off; }
    const int nig = WGM * nN, gid = wgid / nig, fm = gid * WGM, gsz = (nM - fm) < WGM ? (nM - fm) : WGM;
    pm = fm + ((wgid % nig) % gsz); pn = (wgid % nig) / gsz;
}
struct PlainOrder {
    const char* A; const char* B; int nM, nN, G, c; size_t tsA, tsB;
    DI bool next(int i, Unit& u) const {
        const long L = (long)i * G + c; if (L >= (long)nM * nN) return false;
        tile_of((int)L, nM, nN, u.pm, u.pn); u.aux = 0; u.A = A + (size_t)u.pm * tsA; u.B = B + (size_t)u.pn * tsB; return true;
    }
};
struct ProjOrder {
    const char* A; const char* B; int G, c;
    DI bool next(int i, Unit& u) const {
        const long L = (long)i * G + c; if (L >= 64 * 79) return false;
        int pm, pn; tile_of((int)L, 64, 79, pm, pn);
        const size_t ts = (size_t)256 * 2048 * 2;
        const bool fv = (pn >= 18 && pn < 22), gv = (pn >= 30 && pn < 34);
        if (fv || gv) { u.pm = pn; u.pn = pm; u.aux = fv ? 1 : 2; u.A = B + (size_t)pn * ts; u.B = A + (size_t)pm * ts; }
        else { u.pm = pm; u.pn = pn; u.aux = 0; u.A = A + (size_t)pm * ts; u.B = B + (size_t)pn * ts; }
        return true;
    }
};
struct MlaOrder {
    const char* P1; const char* Wq; const char* Wkv; int G, c;
    DI bool next(int i, Unit& u) const {
        const long L = (long)i * G + c; if (L >= 64 * 10) return false;
        const int pm = (int)L / 10, rem = (int)L % 10; u.pm = pm; u.aux = rem;
        if (rem < 6) { u.pn = rem; u.A = P1 + ((size_t)pm * 256 * NP1 + C_LCQ) * 2; u.B = Wq + (size_t)rem * 256 * 512 * 2; }
        else { u.pn = rem - 6; u.A = P1 + ((size_t)pm * 256 * NP1 + C_LCKV) * 2; u.B = Wkv + (size_t)(rem - 6) * 256 * 512 * 2; }
        return true;
    }
};
struct MlaVOrder {
    const char* P1; const char* Wv; int G, c;
    DI bool next(int i, Unit& u) const {
        const long L = (long)i * G + c; if (L >= 256) return false;
        u.pm = (int)L & 3; u.pn = (int)L >> 2; u.aux = 0;
        u.A = Wv + (size_t)u.pm * 256 * 512 * 2; u.B = P1 + ((size_t)u.pn * 256 * NP1 + C_LCKV) * 2; return true;
    }
};
struct MergeOrder {
    const char* OUTp; const char* Wb; int G, c;
    DI bool next(int i, Unit& u) const {
        const int j = i >> 2, br = i & 3; const long L = (long)j * G + c; if (L >= 512) return false;
        tile_of((int)L, 64, 8, u.pm, u.pn); u.aux = br;
        u.A = OUTp + ((size_t)u.pm * 256 * 4096 + br * 1024) * 2; u.B = Wb + ((size_t)br * 2048 + u.pn * 256) * 1024 * 2; return true;
    }
};

template <class Epi, class Sched>
DI void gemm_phase(LAS unsigned char* lds, const int K, const int lda, const int ldb, const Sched& S, const Epi& E) {
    const int tid = otid(), wid = __builtin_amdgcn_readfirstlane(tid >> 6), lane = tid & 63, wr = wid >> 2, wc = wid & 3, fr = lane & 15, fq = lane >> 4;
    const int nt = K / BK;
    unsigned voffA[2], voffB[2];
#pragma unroll
    for (int i = 0; i < 2; ++i) { int R, C; stage_rc(tid * 16 + i * 8192, R, C); const int Rb = (R & ~31) + perm32(R & 31);
        voffA[i] = (unsigned)(R * lda + C) * 2u; voffB[i] = (unsigned)(Rb * ldb + C) * 2u; }
    const size_t kstep = (size_t)(BK * 2);
    const size_t hstepA = (size_t)HALF * lda * 2, hstepB = (size_t)HALF * ldb * 2;
    const unsigned ldsw = (unsigned)wid * 1024u;
    const int aoff = lds_byte(wr * 64 + fr, fq * 8), boff = lds_byte(wc * 32 + fr, fq * 8);
#define PG8_SA(b, h) (((b) * 2 + (h)) * HTB)
#define PG8_SB(b, h) ((4 + (b) * 2 + (h)) * HTB)
#define PG8_STAGE(bufoff, gbase, voff) do { _Pragma("unroll") for (int _i = 0; _i < 2; ++_i) \
        __builtin_amdgcn_global_load_lds((const unsigned*)((const char*)(gbase) + (voff)[_i]), (LAS unsigned*)(lds + (bufoff) + ldsw + _i * 8192), 16, 0, 0); } while (0)
#define PG8_LDA(dst, b, h) do { _Pragma("unroll") for (int m = 0; m < 4; ++m) _Pragma("unroll") for (int k = 0; k < 2; ++k) dst[m][k] = *(const LAS bf16x8*)(lds + PG8_SA(b, h) + aoff + m * 2048 + k * 1024); } while (0)
#define PG8_LDB(dst, b, h) do { _Pragma("unroll") for (int n = 0; n < 2; ++n) _Pragma("unroll") for (int k = 0; k < 2; ++k) dst[n][k] = *(const LAS bf16x8*)(lds + PG8_SB(b, h) + boff + n * 2048 + k * 1024); } while (0)
#define PG8_MMA(ai, bj, At, Bt) do { __builtin_amdgcn_s_setprio(1); _Pragma("unroll") for (int m = 0; m < 4; ++m) _Pragma("unroll") for (int n = 0; n < 2; ++n) _Pragma("unroll") for (int k = 0; k < 2; ++k) \
        acc[ai][bj][m][n] = __builtin_amdgcn_mfma_f32_16x16x32_bf16(Bt[n][k], At[m][k], acc[ai][bj][m][n], 0, 0, 0); __builtin_amdgcn_s_setprio(0); } while (0)
#define PG8_WAIT_V(n) asm volatile("s_waitcnt vmcnt(" #n ")" ::: "memory")
#define PG8_WAIT_L(n) asm volatile("s_waitcnt lgkmcnt(" #n ")" ::: "memory")
#define PG8_BAR __builtin_amdgcn_s_barrier()
#define PG8_SCHED __builtin_amdgcn_sched_barrier(0)
    Unit cur, nxt; int ui = 0;
    if (!S.next(0, cur)) return;
    f32x4 acc[2][2][4][2];
#pragma unroll
    for (int a = 0; a < 2; ++a)
#pragma unroll
        for (int b = 0; b < 2; ++b)
#pragma unroll
            for (int m = 0; m < 4; ++m)
#pragma unroll
                for (int n = 0; n < 2; ++n) acc[a][b][m][n] = (f32x4){0.f, 0.f, 0.f, 0.f};
    bf16x8 At[4][2], B0[2][2], B1[2][2];
    const char* cA = cur.A; const char* cB = cur.B;
    PG8_STAGE(PG8_SB(0, 0), cB, voffB); PG8_STAGE(PG8_SB(0, 1), cB + hstepB, voffB); PG8_STAGE(PG8_SA(0, 0), cA, voffA); PG8_STAGE(PG8_SA(0, 1), cA + hstepA, voffA);
    if (wr == 1) PG8_BAR;
    PG8_WAIT_V(2); PG8_BAR;
    PG8_STAGE(PG8_SB(1, 0), cB + kstep, voffB); PG8_STAGE(PG8_SA(1, 0), cA + kstep, voffA); PG8_STAGE(PG8_SB(1, 1), cB + hstepB + kstep, voffB);
    PG8_WAIT_V(6); PG8_BAR;
    for (;;) {
        const bool has_next = S.next(ui + 1, nxt);
        const char* nA = has_next ? nxt.A : cA; const char* nB = has_next ? nxt.B : cB;
        for (int t = 0; t < nt; t += 2) {
            const bool last = (t == nt - 2);
            const char* a1 = cA + (size_t)(t + 1) * kstep;
            const char* a2 = last ? nA : cA + (size_t)(t + 2) * kstep; const char* b2 = last ? nB : cB + (size_t)(t + 2) * kstep;
            const char* a3 = a2 + kstep; const char* b3 = b2 + kstep;
            PG8_LDB(B0, 0, 0); PG8_LDB(B1, 0, 1); PG8_SCHED; PG8_LDA(At, 0, 0); PG8_STAGE(PG8_SA(1, 1), a1 + hstepA, voffA);
            PG8_WAIT_V(8); PG8_WAIT_L(0); PG8_BAR; PG8_MMA(0, 0, At, B0); PG8_MMA(0, 1, At, B1); PG8_BAR; PG8_SCHED;
            PG8_LDA(At, 0, 1); PG8_STAGE(PG8_SB(0, 0), b2, voffB); PG8_STAGE(PG8_SB(0, 1), b2 + hstepB, voffB); PG8_STAGE(PG8_SA(0, 0), a2, voffA);
            PG8_WAIT_V(8); PG8_WAIT_L(0); PG8_BAR; PG8_MMA(1, 0, At, B0); PG8_MMA(1, 1, At, B1); PG8_BAR; PG8_SCHED;
            PG8_LDB(B0, 1, 0); PG8_LDB(B1, 1, 1); PG8_SCHED; PG8_LDA(At, 1, 0); PG8_STAGE(PG8_SA(0, 1), a2 + hstepA, voffA);
            PG8_WAIT_V(8); PG8_WAIT_L(0); PG8_BAR; PG8_MMA(0, 0, At, B0); PG8_MMA(0, 1, At, B1); PG8_BAR; PG8_SCHED;
            PG8_LDA(At, 1, 1); PG8_STAGE(PG8_SB(1, 0), b3, voffB); PG8_STAGE(PG8_SB(1, 1), b3 + hstepB, voffB); PG8_STAGE(PG8_SA(1, 0), a3, voffA);
            PG8_WAIT_V(8); PG8_WAIT_L(0); PG8_BAR; PG8_MMA(1, 0, At, B0); PG8_MMA(1, 1, At, B1); PG8_BAR; PG8_SCHED;
        }
        if (wr == 0) PG8_BAR;
        E(acc, cur, wr, wc, fr, fq);
        if (!has_next) break;
#pragma unroll
        for (int a = 0; a < 2; ++a)
#pragma unroll
            for (int b = 0; b < 2; ++b)
#pragma unroll
                for (int m = 0; m < 4; ++m)
#pragma unroll
                    for (int n = 0; n < 2; ++n) acc[a][b][m][n] = (f32x4){0.f, 0.f, 0.f, 0.f};
        cur = nxt; cA = nA; cB = nB; ++ui;
        if (wr == 1) PG8_BAR;
    }
    PG8_WAIT_V(0);
    PG8_BAR;
#undef PG8_SA
#undef PG8_SB
#undef PG8_STAGE
#undef PG8_LDA
#undef PG8_LDB
#undef PG8_MMA
#undef PG8_WAIT_V
#undef PG8_WAIT_L
#undef PG8_BAR
#undef PG8_SCHED
}

#define EPI_LOOP_BEGIN _Pragma("unroll") for (int ai = 0; ai < 2; ++ai) _Pragma("unroll") for (int m = 0; m < 4; ++m) { const int row = u.pm * 256 + ai * 128 + wr * 64 + m * 16 + fr;
#define EPI_BJ_BEGIN _Pragma("unroll") for (int bj = 0; bj < 2; ++bj) { const int lc = bj * 128 + wc * 32 + 8 * fq; const f32x4 v0 = acc[ai][bj][m][0], v1 = acc[ai][bj][m][1];
#define EPI_END __builtin_amdgcn_sched_barrier(0); } }

struct EpiProj {
    bf16_t* P1; bf16_t* PM; float* PS; float* SSQ; bf16_t* VTF; bf16_t* VTG;
    DI void operator()(const f32x4 (&acc)[2][2][4][2], const Unit& u, int wr, int wc, int fr, int fq) const {
        const int pn = u.pn;
        if (u.aux != 0) {
            EPI_LOOP_BEGIN
                EPI_BJ_BEGIN
                    const int tok = u.pn * 256 + lc;
                    if (u.aux == 1) *(bf16x8*)(VTF + ((size_t)(tok >> 12) * 1024 + (row - C_FV)) * 4096 + (tok & 4095)) = pack44(v0, v1);
                    else *(bf16x8*)(VTG + ((size_t)(tok >> 6) * 1024 + (row - C_GV)) * 64 + (tok & 63)) = pack44(v0, v1);
            EPI_END
        } else if (pn < 46) {
            const bool stat = (pn >= 38 && pn < 42);
            EPI_LOOP_BEGIN
                float ss = 0.f;
                EPI_BJ_BEGIN
                    *(bf16x8*)(P1 + (size_t)row * NP1 + pn * 256 + lc) = pack44(v0, v1);
                    ss += v0[0] * v0[0] + v0[1] * v0[1] + v0[2] * v0[2] + v0[3] * v0[3] + v1[0] * v1[0] + v1[1] * v1[1] + v1[2] * v1[2] + v1[3] * v1[3];
                    __builtin_amdgcn_sched_barrier(0);
                }
                if (stat && SSQ) { ss += __shfl_xor(ss, 16); ss += __shfl_xor(ss, 32); if (fq == 0) SSQ[(row * 2 + (pn >= 40 ? 1 : 0)) * 8 + (pn & 1) * 4 + wc] = ss; }
            }
        } else if (pn < 78) {
            EPI_LOOP_BEGIN
                EPI_BJ_BEGIN
                    f32x4 a = {sigm(v0[0]), sigm(v0[1]), sigm(v0[2]), sigm(v0[3])}, b = {sigm(v1[0]), sigm(v1[1]), sigm(v1[2]), sigm(v1[3])};
                    *(bf16x8*)(PM + (size_t)row * NPM + (pn - 46) * 256 + lc) = pack44(a, b);
            EPI_END
        } else {
            EPI_LOOP_BEGIN
                EPI_BJ_BEGIN
                    if (lc < 128) { *(f32x4*)(PS + (size_t)row * 128 + lc) = v0; *(f32x4*)(PS + (size_t)row * 128 + lc + 4) = v1; }
            EPI_END
        }
    }
};
struct EpiMla {
    const float* SSQ; bf16_t* QM; bf16_t* KN;
    DI void operator()(const f32x4 (&acc)[2][2][4][2], const Unit& u, int wr, int wc, int fr, int fq) const {
        const bool isq = u.aux < 6;
        bf16_t* dst = isq ? QM : KN; const int ld = isq ? 1536 : 1024;
        EPI_LOOP_BEGIN
            const f32x4 sa = *(const f32x4*)(SSQ + (row * 2 + (isq ? 0 : 1)) * 8), sb = *(const f32x4*)(SSQ + (row * 2 + (isq ? 0 : 1)) * 8 + 4);
            const float rs = rsqrtf((((sa[0] + sa[1]) + (sa[2] + sa[3])) + ((sb[0] + sb[1]) + (sb[2] + sb[3]))) * (1.f / 512.f) + EPS);
            EPI_BJ_BEGIN
                *(bf16x8*)(dst + (size_t)row * ld + u.pn * 256 + lc) = pack44(v0 * rs, v1 * rs);
        EPI_END
    }
};
struct EpiMlaV {
    const float* SSQ; bf16_t* VTM;
    DI void operator()(const f32x4 (&acc)[2][2][4][2], const Unit& u, int wr, int wc, int fr, int fq) const {
#pragma unroll
        for (int bj = 0; bj < 2; ++bj) { const int tok = u.pn * 256 + bj * 128 + wc * 32 + 8 * fq; const int bb = tok >> 12, s = tok & 4095;
            float rs[8];
#pragma unroll
            for (int e = 0; e < 8; ++e) { const f32x4 sa = *(const f32x4*)(SSQ + ((tok + e) * 2 + 1) * 8), sb = *(const f32x4*)(SSQ + ((tok + e) * 2 + 1) * 8 + 4);
                rs[e] = rsqrtf((((sa[0] + sa[1]) + (sa[2] + sa[3])) + ((sb[0] + sb[1]) + (sb[2] + sb[3]))) * (1.f / 512.f) + EPS); }
#pragma unroll
            for (int ai = 0; ai < 2; ++ai)
#pragma unroll
                for (int m = 0; m < 4; ++m) { const int row = u.pm * 256 + ai * 128 + wr * 64 + m * 16 + fr;
                    const f32x4 v0 = acc[ai][bj][m][0], v1 = acc[ai][bj][m][1];
                    const f32x4 a = {v0[0] * rs[0], v0[1] * rs[1], v0[2] * rs[2], v0[3] * rs[3]}, b = {v1[0] * rs[4], v1[1] * rs[5], v1[2] * rs[6], v1[3] * rs[7]};
                    *(bf16x8*)(VTM + ((size_t)bb * 1024 + row) * 4096 + s) = pack44(a, b); __builtin_amdgcn_sched_barrier(0); } }
    }
};
struct EpiMerge {
    const bf16_t* PM; float* MIXF; bf16_t* MIXB;
    DI void operator()(const f32x4 (&acc)[2][2][4][2], const Unit& u, int wr, int wc, int fr, int fq) const {
        const int br = u.aux;
        EPI_LOOP_BEGIN
            EPI_BJ_BEGIN
                const int gc = u.pn * 256 + lc; float g[8]; unpack8(*(const bf16x8*)(PM + (size_t)row * NPM + br * 2048 + gc), g);
                f32x4 a = {v0[0] * g[0], v0[1] * g[1], v0[2] * g[2], v0[3] * g[3]}, b = {v1[0] * g[4], v1[1] * g[5], v1[2] * g[6], v1[3] * g[7]};
                bf16_t* mp = MIXB + (size_t)row * 2048 + gc;
                if (br != 0) { float pv[8]; unpack8(*(const bf16x8*)mp, pv); a += (f32x4){pv[0], pv[1], pv[2], pv[3]}; b += (f32x4){pv[4], pv[5], pv[6], pv[7]}; }
                *(bf16x8*)mp = pack44(a, b);
        EPI_END
    }
};
struct EpiOut {
    float* Y;
    DI void operator()(const f32x4 (&acc)[2][2][4][2], const Unit& u, int wr, int wc, int fr, int fq) const {
        EPI_LOOP_BEGIN
            EPI_BJ_BEGIN
                float* yp = Y + (size_t)row * 2048 + u.pn * 256 + lc; *(f32x4*)yp = v0; *(f32x4*)(yp + 4) = v1;
        EPI_END
    }
};
}

DI int win_src(int n) {
    if (n < 2560) return n;
    if (n < 5632) return n + 16;
    if (n < 8704) return n + 32;
    if (n < 10752) return n + 48;
    if (n < 19968) return n + 112;
    const int r = n - 19968;
    if (r < 16) return 2560 + r;
    if (r < 32) return 5648 + (r - 16);
    if (r < 48) return 8736 + (r - 32);
    if (r < 112) return 10800 + (r - 48);
    return -1;
}
struct WtDesc { const float* src; bf16_t* dst; const float* ks; int ld, K, k0, n0, mode; };
DI void wt_load(const WtDesc& d, int tid, f32x4 (&v)[2]) {
    const int kk = tid >> 4, c4 = (tid & 15) * 4;
    int sc = d.n0 + c4; if (d.mode == 1) sc = win_src(sc);
    if (d.mode == 2) sc = ((sc >> 7) & 7) * 256 + (sc >> 10) * 128 + (sc & 127);
#pragma unroll
    for (int p = 0; p < 2; ++p) { const int k = kk + 32 * p;
        v[p] = (f32x4){0.f, 0.f, 0.f, 0.f}; if (sc >= 0) v[p] = *(const f32x4*)(d.src + (size_t)(d.k0 + k) * d.ld + sc);
        if (d.ks) v[p] = v[p] * d.ks[d.k0 + k]; }
}
DI void wt_to_lds(int tid, const f32x4 (&v)[2], LAS float* scr) {
    const int kk = tid >> 4, c4 = (tid & 15) * 4;
#pragma unroll
    for (int p = 0; p < 2; ++p) { const int k = kk + 32 * p;
        scr[k * 65 + c4] = v[p][0]; scr[k * 65 + c4 + 1] = v[p][1]; scr[k * 65 + c4 + 2] = v[p][2]; scr[k * 65 + c4 + 3] = v[p][3]; }
}
DI void wt_write(const WtDesc& d, int tid, LAS float* scr) {
    const int n = tid >> 3, c = tid & 7; const LAS float* s = scr + (8 * c) * 65 + n;
    u32x4 o; o.x = pk2(s[0], s[65]); o.y = pk2(s[2 * 65], s[3 * 65]); o.z = pk2(s[4 * 65], s[5 * 65]); o.w = pk2(s[6 * 65], s[7 * 65]);
    *(u32x4*)(d.dst + (size_t)(d.n0 + n) * d.K + d.k0 + 8 * c) = o;
}
DI void bt_item(const bf16_t* src, bf16_t* dst, size_t rowbase, int rowlen, int pos0, LAS bf16_t* scr) {
    const int tid = otid(), a = tid >> 3, c8 = (tid & 7) * 8;
    *(LAS bf16x8*)(scr + a * 72 + c8) = *(const bf16x8*)(src + (size_t)a * NP1 + c8);
    __syncthreads();
    { u32x4 o; const LAS bf16_t* s = scr + c8 * 72 + a;
      o.x = (unsigned)s[0] | ((unsigned)s[72] << 16); o.y = (unsigned)s[2 * 72] | ((unsigned)s[3 * 72] << 16);
      o.z = (unsigned)s[4 * 72] | ((unsigned)s[5 * 72] << 16); o.w = (unsigned)s[6 * 72] | ((unsigned)s[7 * 72] << 16);
      *(u32x4*)(dst + (rowbase + a) * (size_t)rowlen + pos0 + c8) = o; }
    __syncthreads();
}
DI void rms_row_to_bf16(const float* xr, const float* w, bf16_t* o, int lane) {
    f32x4 v[8]; float s = 0.f;
#pragma unroll
    for (int j = 0; j < 8; ++j) { v[j] = ((const f32x4*)xr)[lane + 64 * j]; s += v[j][0] * v[j][0] + v[j][1] * v[j][1] + v[j][2] * v[j][2] + v[j][3] * v[j][3]; }
    const float r = rsqrtf(wave_sum(s) * (1.f / 2048.f) + EPS);
#pragma unroll
    for (int j = 0; j < 8; ++j) { const f32x4 ww = ((const f32x4*)w)[lane + 64 * j]; *(u32x2*)(o + (size_t)(lane + 64 * j) * 4) = pack4(v[j] * ww * r); }
}

template <int DQK, int DV, bool FOX, bool PIPE, bool FASTSM>
DI void attn_unit(LAS unsigned char* lds, int b, int h, int qb, const unsigned char* ws) {
    constexpr int KS = DQK / 32, DT = DV / 16, NH = FOX ? 16 : 8;
    constexpr int KROWB = DQK * 2, CPR = DQK / 8, KB = 64 * KROWB, VB = DV * 128, FB = FOX ? 2048 : 0, SLOT = KB + VB + FB;
    constexpr int NS = FOX ? 4 : 3, NKI = KB / 8192, NVI = VB / 8192, PER = NKI + NVI + (FOX ? 1 : 0);
    static_assert(NS * SLOT <= MISC_OFF, "attention LDS");
    const bf16_t* P1 = (const bf16_t*)(ws + O_P1); const bf16_t* QM = (const bf16_t*)(ws + O_QM); const float* FCUM = (const float*)(ws + O_FCUM);
    const float* CS = (const float*)(ws + O_CS); const float* SN = (const float*)(ws + O_SN); bf16_t* OUT = (bf16_t*)(ws + O_OUT);
    const int tid = otid(), wave = __builtin_amdgcn_readfirstlane(tid >> 6), lane = tid & 63, r16 = lane & 15, fq = lane >> 4;
    const float sc2 = (FOX ? 0.125f : 0.07216878364870322f) * LOG2E;
    const int tq0 = b * S_ + qb * 256 + wave * 32;
    const int q0 = qb * 256 + wave * 32;
    bf16x8 qf[KS][2]; float Fq2[2] = {0.f, 0.f};
#pragma unroll
    for (int nq = 0; nq < 2; ++nq) {
        const int t = tq0 + nq * 16 + r16;
        if constexpr (FOX) {
#pragma unroll
            for (int ks = 0; ks < KS; ++ks) qf[ks][nq] = ld16(P1 + (size_t)t * NP1 + C_FQ + h * 64 + ks * 32 + fq * 8);
            Fq2[nq] = FCUM[(size_t)(b * 16 + h) * S_ + q0 + nq * 16 + r16];
        } else {
#pragma unroll
            for (int ks = 0; ks < KS; ++ks) qf[ks][nq] = ld16(QM + (size_t)t * 1536 + h * 192 + ks * 32 + fq * 8);
            float r4[8], r5[8], o4[8], o5[8]; unpack8(qf[4][nq], r4); unpack8(qf[5][nq], r5);
            const f32x4 c0 = *(const f32x4*)(CS + (size_t)t * 32 + fq * 8), c1 = *(const f32x4*)(CS + (size_t)t * 32 + fq * 8 + 4);
            const f32x4 s0 = *(const f32x4*)(SN + (size_t)t * 32 + fq * 8), s1 = *(const f32x4*)(SN + (size_t)t * 32 + fq * 8 + 4);
#pragma unroll
            for (int j = 0; j < 8; ++j) { const float c = j < 4 ? c0[j & 3] : c1[j & 3], s = j < 4 ? s0[j & 3] : s1[j & 3];
                o4[j] = r4[j] * c - r5[j] * s; o5[j] = r4[j] * s + r5[j] * c; }
            qf[4][nq] = pack8(o4); qf[5][nq] = pack8(o5);
        }
    }
    f32x4 oacc[DT][2];
#pragma unroll
    for (int d = 0; d < DT; ++d) { oacc[d][0] = (f32x4){0.f, 0.f, 0.f, 0.f}; oacc[d][1] = (f32x4){0.f, 0.f, 0.f, 0.f}; }
    float mrow[2] = {-INFINITY, -INFINITY}, lsum[2] = {0.f, 0.f};
    const int ntiles = 4 * qb + 4;
    int kt0 = 0;
    if constexpr (FOX) {
        const unsigned* nm = (const unsigned*)(ws + O_CTL) + 256 + (b * 16 + h) * 2;
        const float smax2 = sqrtf(__uint_as_float(nm[0]) * __uint_as_float(nm[1])) * sc2, thr = -(2.f * smax2 + 40.f);
        const float f0 = FCUM[(size_t)(b * 16 + h) * S_ + qb * 256];
        const bool skip = (lane < 4 * qb) && (f0 - FCUM[(size_t)(b * 16 + h) * S_ + lane * 64 + 63] < thr);
        const unsigned long long mk = __ballot(skip);
        kt0 = __builtin_amdgcn_readfirstlane((int)__builtin_ctzll(~mk));
    }
    unsigned kof[NKI], kst[NKI], vof[NVI];
#pragma unroll
    for (int i = 0; i < NKI; ++i) { const int L = (wave + 8 * i) * 64 + lane, r = L / CPR, pos = L % CPR, c = (pos & ~7) | ((pos ^ (r >> 1)) & 7);
        if constexpr (FOX) { kof[i] = (unsigned)(O_P1 + ((size_t)(b * S_ + r) * NP1 + C_FK + h * 64 + c * 8) * 2); kst[i] = 64u * NP1 * 2u; }
        else if (c < 16) { kof[i] = (unsigned)(O_KN + ((size_t)(b * S_ + r) * 1024 + h * 128 + c * 8) * 2); kst[i] = 64u * 1024u * 2u; }
        else { kof[i] = (unsigned)(O_KROPE + ((size_t)(b * S_ + r) * 64 + (c - 16) * 8) * 2); kst[i] = 64u * 64u * 2u; } }
#pragma unroll
    for (int i = 0; i < NVI; ++i) { const int L = (wave + 8 * i) * 64 + lane, dv = L >> 3, pos = L & 7, c = pos ^ ((dv >> 1) & 7);
        vof[i] = (unsigned)((FOX ? O_VTF : O_VTM) + (((size_t)(b * NH + h) * DV + dv) * S_ + c * 8) * 2); }
    const unsigned fof = (unsigned)(O_FCUM + ((size_t)(b * 16 + h) * S_ + lane) * 4);
    int klo[2], vlo[2][2];
#pragma unroll
    for (int p = 0; p < 2; ++p) klo[p] = r16 * KROWB + (((p * 4 + fq) ^ ((r16 >> 1) & 7)) * 16);
#pragma unroll
    for (int ss = 0; ss < 2; ++ss)
#pragma unroll
        for (int q = 0; q < 2; ++q) vlo[ss][q] = KB + r16 * 128 + (((4 * ss + (fq >> 1) + 2 * q) ^ ((r16 >> 1) & 7)) * 16) + 8 * (fq & 1);
#define ATT_ISSUE(kt) do { LAS unsigned char* sp = lds + ((kt) % NS) * SLOT; \
        _Pragma("unroll") for (int i = 0; i < NKI; ++i) __builtin_amdgcn_global_load_lds((const unsigned*)(ws + (kof[i] + (unsigned)(kt) * kst[i])), (LAS unsigned*)(sp + (wave + 8 * i) * 1024), 16, 0, 0); \
        _Pragma("unroll") for (int i = 0; i < NVI; ++i) __builtin_amdgcn_global_load_lds((const unsigned*)(ws + (vof[i] + (unsigned)(kt) * 128u)), (LAS unsigned*)(sp + KB + (wave + 8 * i) * 1024), 16, 0, 0); \
        if constexpr (FOX) __builtin_amdgcn_global_load_lds((const unsigned*)(ws + (fof + (unsigned)(kt) * 256u)), (LAS unsigned*)(sp + KB + VB + wave * 256), 4, 0, 0); } while (0)
#define ATT_S(kt_, SA) do { const LAS unsigned char* bp = lds + ((kt_) % NS) * SLOT; \
        _Pragma("unroll") for (int mt = 0; mt < 4; ++mt) { SA[mt][0] = (f32x4){0.f, 0.f, 0.f, 0.f}; SA[mt][1] = (f32x4){0.f, 0.f, 0.f, 0.f}; } \
        bf16x8 kf[2][4]; \
        _Pragma("unroll") for (int mt = 0; mt < 4; ++mt) kf[0][mt] = *(const LAS bf16x8*)(bp + klo[0] + (mt * 16 * KROWB)); \
        _Pragma("unroll") for (int ks = 0; ks < KS; ++ks) { \
            if (ks + 1 < KS) { _Pragma("unroll") for (int mt = 0; mt < 4; ++mt) kf[(ks + 1) & 1][mt] = *(const LAS bf16x8*)(bp + klo[(ks + 1) & 1] + (mt * 16 * KROWB + ((ks + 1) >> 1) * 128)); } \
            _Pragma("unroll") for (int mt = 0; mt < 4; ++mt) { SA[mt][0] = MFMA16(kf[ks & 1][mt], qf[ks][0], SA[mt][0]); SA[mt][1] = MFMA16(kf[ks & 1][mt], qf[ks][1], SA[mt][1]); } \
            if (!PIPE) __builtin_amdgcn_sched_barrier(0); } } while (0)
#define ATT_SOFTMAX_(kt_, SA, MASKED) do { const LAS unsigned char* bp = lds + ((kt_) % NS) * SLOT; \
        _Pragma("unroll") for (int nq = 0; nq < 2; ++nq) { \
            const int qpos = q0 + nq * 16 + r16; float mx = -INFINITY; \
            _Pragma("unroll") for (int mt = 0; mt < 4; ++mt) { f32x4 fk = {0.f, 0.f, 0.f, 0.f}; if constexpr (FOX) fk = *(const LAS f32x4*)(bp + KB + VB + wave * 256 + (mt * 16 + fq * 4) * 4); \
                _Pragma("unroll") for (int j = 0; j < 4; ++j) { float x = FOX ? SA[mt][nq][j] * sc2 + (Fq2[nq] - fk[j]) : SA[mt][nq][j] * sc2; \
                    if (MASKED) { const int kpos = (kt_) * 64 + mt * 16 + fq * 4 + j; x = (kpos <= qpos) ? x : -INFINITY; } \
                    SA[mt][nq][j] = x; mx = fmaxf(mx, x); } } \
            mx = xmax_fq(mx); \
            const float mnew = fmaxf(mrow[nq], mx), alpha = __builtin_amdgcn_exp2f(mrow[nq] - mnew); mrow[nq] = mnew; \
            float ps = 0.f; \
            _Pragma("unroll") for (int mt = 0; mt < 4; ++mt) _Pragma("unroll") for (int j = 0; j < 4; ++j) { const float p = __builtin_amdgcn_exp2f(SA[mt][nq][j] - mnew); SA[mt][nq][j] = p; ps += p; } \
            lsum[nq] = lsum[nq] * alpha + ps; \
            _Pragma("unroll") for (int d = 0; d < DT; ++d) oacc[d][nq] = oacc[d][nq] * alpha; \
            pb[0][nq] = pack44(SA[0][nq], SA[1][nq]); pb[1][nq] = pack44(SA[2][nq], SA[3][nq]); } } while (0)
#define ATT_SOFTMAX_F(kt_, SA) do { const LAS unsigned char* bp = lds + ((kt_) % NS) * SLOT; float dlt[2], rmx[2]; \
        _Pragma("unroll") for (int nq = 0; nq < 2; ++nq) { float mx = -INFINITY; \
            _Pragma("unroll") for (int mt = 0; mt < 4; ++mt) { \
                if constexpr (FOX) { const f32x4 fk = *(const LAS f32x4*)(bp + KB + VB + wave * 256 + (mt * 16 + fq * 4) * 4); \
                    _Pragma("unroll") for (int j = 0; j < 4; ++j) SA[mt][nq][j] = SA[mt][nq][j] * sc2 - fk[j]; } \
                _Pragma("unroll") for (int j = 0; j < 4; ++j) mx = fmaxf(mx, SA[mt][nq][j]); } \
            mx = xmax_fq(mx); \
            rmx[nq] = FOX ? mx + Fq2[nq] : mx * sc2; dlt[nq] = rmx[nq] - mrow[nq]; } \
        const bool fast = __all((dlt[0] <= 8.f) && (dlt[1] <= 8.f)); \
        _Pragma("unroll") for (int nq = 0; nq < 2; ++nq) { \
            const float mnew = fast ? mrow[nq] : fmaxf(mrow[nq], rmx[nq]); \
            const float alpha = __builtin_amdgcn_exp2f(mrow[nq] - mnew); \
            const float cc = FOX ? Fq2[nq] - mnew : -mnew; mrow[nq] = mnew; float ps = 0.f; \
            _Pragma("unroll") for (int mt = 0; mt < 4; ++mt) _Pragma("unroll") for (int j = 0; j < 4; ++j) { \
                const float p = __builtin_amdgcn_exp2f(FOX ? SA[mt][nq][j] + cc : SA[mt][nq][j] * sc2 + cc); SA[mt][nq][j] = p; ps += p; } \
            lsum[nq] = lsum[nq] * alpha + ps; \
            pb[0][nq] = pack44(SA[0][nq], SA[1][nq]); pb[1][nq] = pack44(SA[2][nq], SA[3][nq]); \
            if (!fast) { _Pragma("unroll") for (int d = 0; d < DT; ++d) oacc[d][nq] = oacc[d][nq] * alpha; } } \
        } while (0)
#define ATT_SOFTMAX(kt_, SA) do { if ((kt_) * 64 + 63 > q0) ATT_SOFTMAX_(kt_, SA, true); else if constexpr (FASTSM) ATT_SOFTMAX_F(kt_, SA); else ATT_SOFTMAX_(kt_, SA, false); } while (0)
#define ATT_PV(kt_) do { const LAS unsigned char* bp = lds + ((kt_) % NS) * SLOT; constexpr int NG = 2 * DT / 4; \
        s16x4 vl[2][4], vh[2][4]; \
        _Pragma("unroll") for (int q = 0; q < 4; ++q) { vl[0][q] = *(const LAS s16x4*)(bp + vlo[0][0] + q * 2048); vh[0][q] = *(const LAS s16x4*)(bp + vlo[0][1] + q * 2048); } \
        _Pragma("unroll") for (int g = 0; g < NG; ++g) { \
            if (g + 1 < NG) { const int ss1 = ((g + 1) * 4) / DT, d1 = ((g + 1) * 4) % DT; \
                _Pragma("unroll") for (int q = 0; q < 4; ++q) { vl[(g + 1) & 1][q] = *(const LAS s16x4*)(bp + vlo[ss1][0] + (d1 + q) * 2048); vh[(g + 1) & 1][q] = *(const LAS s16x4*)(bp + vlo[ss1][1] + (d1 + q) * 2048); } } \
            const int ss = (g * 4) / DT, d0 = (g * 4) % DT; \
            _Pragma("unroll") for (int q = 0; q < 4; ++q) { const bf16x8 vf = __builtin_shufflevector(vl[g & 1][q], vh[g & 1][q], 0, 1, 2, 3, 4, 5, 6, 7); \
                oacc[d0 + q][0] = MFMA16(vf, pb[ss][0], oacc[d0 + q][0]); oacc[d0 + q][1] = MFMA16(vf, pb[ss][1], oacc[d0 + q][1]); } \
            __builtin_amdgcn_sched_barrier(0); } } while (0)
#define ATT_BAR() do { asm volatile("s_waitcnt lgkmcnt(0)" ::: "memory"); __builtin_amdgcn_s_barrier(); asm volatile("" ::: "memory"); } while (0)
#pragma unroll
    for (int p = 0; p < NS - 1; ++p) ATT_ISSUE(kt0 + p);
    bf16x8 pb[2][2];
    if constexpr (PIPE) {
        static_assert(!PIPE || NS == 4, "pipelined form needs a 4-slot ring");
        asm volatile("s_waitcnt vmcnt(%0)" :: "n"(2 * PER) : "memory");
        ATT_BAR();
        f32x4 sA[4][2];
        ATT_S(kt0, sA);
        for (int kt = kt0; kt < ntiles; ++kt) {
            if (kt + 2 < ntiles) asm volatile("s_waitcnt vmcnt(%0)" :: "n"(PER) : "memory");
            else asm volatile("s_waitcnt vmcnt(0)" ::: "memory");
            ATT_BAR();
            if (kt + 3 < ntiles) ATT_ISSUE(kt + 3);
            const bool a0 = (kt * 64 <= q0 + 31), a1 = (kt + 1 < ntiles) && ((kt + 1) * 64 <= q0 + 31);
            if (a1) {
                f32x4 sB[4][2];
                if (kt * 64 + 63 > q0) { ATT_S(kt + 1, sB); ATT_SOFTMAX_(kt, sA, true); }
                else { ATT_S(kt + 1, sB); if constexpr (FASTSM) ATT_SOFTMAX_F(kt, sA); else ATT_SOFTMAX_(kt, sA, false); }
                ATT_PV(kt);
#pragma unroll
                for (int mt = 0; mt < 4; ++mt) { sA[mt][0] = sB[mt][0]; sA[mt][1] = sB[mt][1]; }
            } else if (a0) {
                ATT_SOFTMAX(kt, sA);
                ATT_PV(kt);
            }
        }
    } else {
        for (int kt = 0; kt < ntiles; ++kt) {
            if (kt + NS - 2 < ntiles) asm volatile("s_waitcnt vmcnt(%0)" :: "n"((NS - 2) * PER) : "memory");
            else asm volatile("s_waitcnt vmcnt(0)" ::: "memory");
            ATT_BAR();
            if (kt + NS - 1 < ntiles) ATT_ISSUE(kt + NS - 1);
            if (kt * 64 <= q0 + 31) {
                f32x4 sA[4][2];
                ATT_S(kt, sA);
                ATT_SOFTMAX(kt, sA);
                ATT_PV(kt);
            }
        }
    }
#undef ATT_S
#undef ATT_SOFTMAX
#undef ATT_SOFTMAX_
#undef ATT_SOFTMAX_F
#undef ATT_PV
#undef ATT_BAR
#undef ATT_ISSUE
#pragma unroll
    for (int nq = 0; nq < 2; ++nq) {
        float l = lsum[nq]; l += __shfl_xor(l, 16); l += __shfl_xor(l, 32); const float inv = 1.f / l;
        const int t = tq0 + nq * 16 + r16;
#pragma unroll
        for (int d = 0; d < DT; ++d) { const int dv0 = d * 16 + fq * 4;
            const f32x4 g = unpack4(*(const u32x2*)(P1 + (size_t)t * NP1 + (FOX ? C_FG : C_LG) + h * DV + dv0));
            f32x4 o = oacc[d][nq] * inv; o = (f32x4){o[0] * silu(g[0]), o[1] * silu(g[1]), o[2] * silu(g[2]), o[3] * silu(g[3])};
            *(u32x2*)(OUT + (size_t)t * 4096 + (FOX ? 1024 : 3072) + h * DV + dv0) = pack4(o); }
    }
}

typedef const __attribute__((address_space(4))) unsigned char* kaptr_t;
DI const void* kaload(int off) { kaptr_t ka = (kaptr_t)__builtin_amdgcn_kernarg_segment_ptr(); asm volatile("" : "+s"(ka)); typedef const void* cvp_t; return *(const __attribute__((address_space(4))) cvp_t*)(ka + off); }
#define INP(k) ((const float*)kaload(8 * (k)))
#define x_in INP(0)
#define positions ((const int*)kaload(8))
#define pre_norm INP(2)
#define post_norm INP(3)
#define w_in INP(4)
#define conv_w INP(5)
#define conv_b INP(6)
#define dt_bias INP(7)
#define a_log INP(8)
#define d_skip INP(9)
#define ssm_norm INP(10)
#define fgate_b INP(11)
#define gla_w2 INP(12)
#define gla_b INP(13)
#define gla_norm INP(14)
#define q_norm INP(15)
#define kv_norm INP(16)
#define w_uq INP(17)
#define w_ukv INP(18)
#define w_branch INP(19)
#define w_out INP(20)
#define CTL ((unsigned*)(ws + O_CTL))
#define SSQ ((float*)(ws + O_SSQ))
#define DTV ((float*)(ws + O_DT))
#define ACUM ((float*)(ws + O_ACUM))
#define FCUM ((float*)(ws + O_FCUM))
#define CS ((float*)(ws + O_CS))
#define SN ((float*)(ws + O_SN))
#define KROPE ((bf16_t*)(ws + O_KROPE))
#define BLAST ((float*)(ws + O_BLAST))
#define PS ((float*)(ws + O_PSMALL))
#define WBT ((bf16_t*)(ws + O_WBT))
#define WOT ((bf16_t*)(ws + O_WOT))
#define WUQT ((bf16_t*)(ws + O_WUQT))
#define WUKVT ((bf16_t*)(ws + O_WUKVT))
#define P1 ((bf16_t*)(ws + O_P1))
#define PM ((bf16_t*)(ws + O_PM))
#define OUT ((bf16_t*)(ws + O_OUT))
#define WINT ((bf16_t*)(ws + O_WINT))
#define H ((bf16_t*)(ws + O_H))
#define GST ((bf16_t*)(ws + O_GST))
#define QM ((bf16_t*)(ws + O_QM))
#define KN ((bf16_t*)(ws + O_KN))
#define VTM ((bf16_t*)(ws + O_VTM))
#define VTF ((bf16_t*)(ws + O_VTF))
#define XBC ((bf16_t*)(ws + O_XBC))
#define XBCT ((bf16_t*)(ws + O_XBCT))
#define SST ((bf16_t*)(ws + O_SST))
#define KTT ((bf16_t*)(ws + O_KTT))
#define VTG ((bf16_t*)(ws + O_VTG))
#define MIXF ((float*)(ws + O_MIXF))
#define MIXB ((bf16_t*)(ws + O_MIXB))
#define Y ((float*)(ws + O_Y))
DI void phase_body(const int ph, LAS unsigned char* lds, const int rep = 0) {
    LAS float* scrf = (LAS float*)lds; LAS bf16_t* scrb = (LAS bf16_t*)lds;
    {
        const int l = ph == 0 ? 0 : (ph - 1) >> 3, kph = ph == 0 ? -1 : (ph - 1) & 7;
        unsigned char* ws = (unsigned char*)kaload(176);
        float* const outp = (float*)kaload(168);
        const int tid = otid(), lane = tid & 63, wave = __builtin_amdgcn_readfirstlane(tid >> 6), r16 = lane & 15, fq = lane >> 4;
        const int G = osg(gridDim.x), bid = osg(blockIdx.x);
        unsigned* ctr = CTL + 16 + ph + 32 * rep;
        if ((kph == -1 || kph == 7) && (PHMASK & 0x100)) {
            const int lw = (kph == -1) ? 0 : l + 1;
            if (kph == -1) {
                if (bid == 0 && tid < 128) CTL[tid] = 0u;
                const int NI = 2 * (2048 + 1024 + 192 + 256);
#define WT_DECODE(it_, d_) do { const int ll = (it_) / 3520; int r = (it_) % 3520; \
                    if (r < 2048) { const int br = r / 512, q = r % 512; d_ = WtDesc{w_branch + (size_t)(ll * 4 + br) * 1024 * 2048, WBT + ((size_t)ll * 8192 + br * 2048) * 1024, nullptr, 2048, 1024, (q % 16) * 64, (q / 16) * 64, 0}; } \
                    else if (r < 3072) { r -= 2048; d_ = WtDesc{w_out + (size_t)ll * 2048 * 2048, WOT + (size_t)ll * 2048 * 2048, nullptr, 2048, 2048, (r % 32) * 64, (r / 32) * 64, 0}; } \
                    else if (r < 3264) { r -= 3072; d_ = WtDesc{w_uq + (size_t)ll * 512 * 1536, WUQT + (size_t)ll * 1536 * 512, q_norm + ll * 512, 1536, 512, (r % 8) * 64, (r / 8) * 64, 0}; } \
                    else { r -= 3264; d_ = WtDesc{w_ukv + (size_t)ll * 512 * 2048, WUKVT + (size_t)ll * 2048 * 512, kv_norm + ll * 512, 2048, 512, (r % 8) * 64, (r / 8) * 64, 2}; } } while (0)
                { int it = bid; WtDesc d{}; f32x4 v[2];
                  if (it < NI) { WT_DECODE(it, d); wt_load(d, tid, v); }
                  while (it < NI) {
                      wt_to_lds(tid, v, scrf); __syncthreads();
                      const int nx = it + G; WtDesc dn{}; if (nx < NI) { WT_DECODE(nx, dn); wt_load(dn, tid, v); }
                      wt_write(d, tid, scrf); __syncthreads();
                      d = dn; it = nx; } }
#undef WT_DECODE
                for (int row = bid * 8 + wave; row < T_; row += G * 8) rms_row_to_bf16(x_in + (size_t)row * DM, pre_norm, H + (size_t)row * DM, lane);
            } else {
                const float* xsrc = (l == 0) ? x_in : outp;
                for (int row = bid * 8 + wave; row < T_; row += G * 8) {
                    f32x4 v[8]; float s = 0.f;
#pragma unroll
                    for (int j = 0; j < 8; ++j) { v[j] = ((const f32x4*)(Y + (size_t)row * DM))[lane + 64 * j]; s += v[j][0] * v[j][0] + v[j][1] * v[j][1] + v[j][2] * v[j][2] + v[j][3] * v[j][3]; }
                    const float r = rsqrtf(wave_sum(s) * (1.f / 2048.f) + EPS); float s2 = 0.f;
#pragma unroll
                    for (int j = 0; j < 8; ++j) { const f32x4 pw = ((const f32x4*)(post_norm + l * DM))[lane + 64 * j]; const f32x4 xv = ((const f32x4*)(xsrc + (size_t)row * DM))[lane + 64 * j];
                        v[j] = xv + v[j] * pw * r; ((f32x4*)(outp + (size_t)row * DM))[lane + 64 * j] = v[j]; s2 += v[j][0] * v[j][0] + v[j][1] * v[j][1] + v[j][2] * v[j][2] + v[j][3] * v[j][3]; }
                    if (l == 0) { const float r2 = rsqrtf(wave_sum(s2) * (1.f / 2048.f) + EPS);
#pragma unroll
                        for (int j = 0; j < 8; ++j) { const f32x4 ww = ((const f32x4*)(pre_norm + DM))[lane + 64 * j]; *(u32x2*)(H + (size_t)row * DM + (size_t)(lane + 64 * j) * 4) = pack4(v[j] * ww * r2); } }
                }
            }
            if (lw < 2) {
                if (bid == 0 && tid < 128) CTL[256 + tid] = 0u;
                { int it = bid; const int NI = 316 * 32; const float* wsrc = w_in + (size_t)lw * 2048 * NIN; bf16_t* wdst = WINT; WtDesc d{}; f32x4 v[2];
                  if (it < NI) { d = WtDesc{wsrc, wdst, nullptr, NIN, 2048, (it % 32) * 64, (it / 32) * 64, 1}; wt_load(d, tid, v); }
                  while (it < NI) {
                      wt_to_lds(tid, v, scrf); __syncthreads();
                      const int nx = it + G; WtDesc dn{}; if (nx < NI) { dn = WtDesc{wsrc, wdst, nullptr, NIN, 2048, (nx % 32) * 64, (nx / 32) * 64, 1}; wt_load(dn, tid, v); }
                      wt_write(d, tid, scrf); __syncthreads();
                      d = dn; it = nx; } }
            }
        } else if (kph == 0 && (PHMASK >> 0 & 1)) {
            pg8::ProjOrder S{(const char*)H, (const char*)WINT, G, bid};
            pg8::EpiProj E{P1, PM, PS, rep ? nullptr : SSQ, VTF, VTG};
            pg8::gemm_phase(lds, 2048, 2048, 2048, S, E);
        } else if (kph == 1 && (PHMASK >> 1 & 1)) {
#ifndef NO_M1GEMM
            { pg8::MlaOrder S{(const char*)P1, (const char*)(WUQT + (size_t)l * 1536 * 512), (const char*)(WUKVT + (size_t)l * 2048 * 512), G, bid};
              pg8::EpiMla E{SSQ, QM, KN};
              pg8::gemm_phase(lds, 512, NP1, 512, S, E); }
            { pg8::MlaVOrder S{(const char*)P1, (const char*)(WUKVT + ((size_t)l * 2048 + 1024) * 512), G, bid};
              pg8::EpiMlaV E{SSQ, VTM};
              pg8::gemm_phase(lds, 512, 512, NP1, S, E); }
#endif
            constexpr int N_C = 8, N_A = 384, N_E = 256, N_B = 128, N_N = 256, N_D = 1024;
            constexpr int NTOT = N_C + N_A + N_E + N_B + N_N + N_D;
            for (;;) {
                int it = next_item(ctr, lds); if (it >= NTOT) break;
                if (it < N_C) { LANEIDS
                    const int b = it >> 1, h = (it & 1) * 8 + wave; const float fb = fgate_b[l * 16 + h]; float carry = 0.f;
                    for (int j = 0; j < 64; ++j) { const int s = j * 64 + lane;
                        float v = logsig(PS[(size_t)(b * S_ + s) * 128 + 16 + h] + fb);
#pragma unroll
                        for (int o = 1; o < 64; o <<= 1) { const float y = __shfl_up(v, o); if (lane >= o) v += y; }
                        v += carry; FCUM[(size_t)(b * 16 + h) * S_ + s] = v * LOG2E; carry = __shfl(v, 63); }
                    continue; }
                it -= N_C;
                if (it < N_A) { LANEIDS
                    const int cgp = it % 3, bc = it / 3, ch = cgp * 512 + tid, t0 = bc * 128; const bool first = (bc & 31) == 0;
                    const float w0 = conv_w[(size_t)l * 4 * 1536 + ch], w1 = conv_w[(size_t)l * 4 * 1536 + 1536 + ch], w2 = conv_w[(size_t)l * 4 * 1536 + 2 * 1536 + ch], w3 = conv_w[(size_t)l * 4 * 1536 + 3 * 1536 + ch];
                    const float cb = conv_b[l * 1536 + ch];
                    float xm3 = 0.f, xm2 = 0.f, xm1 = 0.f;
                    if (!first) { xm3 = bf1(P1[(size_t)(t0 - 3) * NP1 + C_XBC + ch]); xm2 = bf1(P1[(size_t)(t0 - 2) * NP1 + C_XBC + ch]); xm1 = bf1(P1[(size_t)(t0 - 1) * NP1 + C_XBC + ch]); }
                    for (int l8 = 0; l8 < 16; ++l8) { float o8[8];
#pragma unroll
                        for (int i = 0; i < 8; ++i) { const int t = t0 + l8 * 8 + i; const float xin = bf1(P1[(size_t)t * NP1 + C_XBC + ch]);
                            const float y = cb + w0 * xm3 + w1 * xm2 + w2 * xm1 + w3 * xin; const float a = silu(y); o8[i] = a;
                            XBC[(size_t)t * 1536 + ch] = (bf16_t)f2bf(a); xm3 = xm2; xm2 = xm1; xm1 = xin; }
                        if (ch < 1280) *(bf16x8*)(XBCT + ((size_t)bc * 1280 + ch) * 128 + l8 * 8) = pack8(o8); }
                    continue; }
                it -= N_A;
                if (it < N_E) { LANEIDS
                    const int col = tid, t0 = it * 64; float w2r[16];
#pragma unroll
                    for (int r = 0; r < 16; ++r) w2r[r] = gla_w2[(size_t)l * 16 * 512 + r * 512 + col];
                    const float gb = gla_b[l * 512 + col]; float cum = 0.f;
                    for (int j8 = 0; j8 < 8; ++j8) { float k8[8];
#pragma unroll
                        for (int i = 0; i < 8; ++i) { const int t = t0 + j8 * 8 + i; float z = gb;
#pragma unroll
                            for (int r = 0; r < 16; ++r) z += PS[(size_t)t * 128 + 32 + r] * w2r[r];
                            cum += logsig(z) * (1.f / 16.f);
                            bf16_t* qp = P1 + (size_t)t * NP1 + C_GQ + col; bf16_t* kp = P1 + (size_t)t * NP1 + C_GK + col;
                            const float qt = bf1(*qp) * 0.08838834764831845f * __expf(cum), kt = bf1(*kp) * __expf(-cum);
                            *qp = (bf16_t)f2bf(qt); *kp = (bf16_t)f2bf(kt); k8[i] = kt; }
                        *(bf16x8*)(KTT + ((size_t)it * 512 + col) * 64 + j8 * 8) = pack8(k8); }
                    BLAST[(size_t)it * 512 + col] = cum;
                    continue; }
                it -= N_E;
                if (it < N_B) { LANEIDS
                    const int t0 = it * 128;
#pragma unroll
                    for (int hh = 0; hh < 2; ++hh) { const int h = wave * 2 + hh; const float a = -__expf(a_log[l * 16 + h]), db = dt_bias[l * 16 + h];
                        const float d0 = softplus_(PS[(size_t)(t0 + 2 * lane) * 128 + h] + db), d1 = softplus_(PS[(size_t)(t0 + 2 * lane + 1) * 128 + h] + db);
                        const float c0 = d0 * a, c1 = c0 + d1 * a; float v = c1;
#pragma unroll
                        for (int o = 1; o < 64; o <<= 1) { const float y = __shfl_up(v, o); if (lane >= o) v += y; }
                        const float pre = v - c1;
                        DTV[(size_t)(t0 + 2 * lane) * 16 + h] = d0; DTV[(size_t)(t0 + 2 * lane + 1) * 16 + h] = d1;
                        ACUM[(size_t)(t0 + 2 * lane) * 16 + h] = pre + c0; ACUM[(size_t)(t0 + 2 * lane + 1) * 16 + h] = pre + c1; }
                    continue; }
                it -= N_B;
                if (it < N_N) { LANEIDS
                    const int hh = tid & 15, t0 = it * 64, b = t0 >> 12; float qm = 0.f, km = 0.f;
#pragma unroll
                    for (int p = 0; p < 2; ++p) { const int t = t0 + p * 32 + (tid >> 4); float qs = 0.f, ks = 0.f;
#pragma unroll
                        for (int c = 0; c < 8; ++c) { float a[8], k8[8]; unpack8(ld16(P1 + (size_t)t * NP1 + C_FQ + hh * 64 + c * 8), a); unpack8(ld16(P1 + (size_t)t * NP1 + C_FK + hh * 64 + c * 8), k8);
#pragma unroll
                            for (int e = 0; e < 8; ++e) { qs += a[e] * a[e]; ks += k8[e] * k8[e]; } }
                        qm = fmaxf(qm, qs); km = fmaxf(km, ks); }
                    qm = fmaxf(qm, __shfl_xor(qm, 16)); qm = fmaxf(qm, __shfl_xor(qm, 32)); km = fmaxf(km, __shfl_xor(km, 16)); km = fmaxf(km, __shfl_xor(km, 32));
                    if (lane < 16) { atomicMax(CTL + 256 + (b * 16 + hh) * 2, __float_as_uint(qm)); atomicMax(CTL + 256 + (b * 16 + hh) * 2 + 1, __float_as_uint(km)); }
                    continue; }
                it -= N_N;
                { LANEIDS
                    const int t = it * 16 + (tid >> 5), j = tid & 31;
                    const float invf = exp2f(-(float)j * 0.41524101186092029f);
                    const float ang = (float)positions[t] * invf;
                    double rev = (double)ang * 0.15915494309189535; rev -= floor(rev + 0.5);
                    const float fr_ = (float)rev; const float c = __builtin_amdgcn_cosf(fr_), s = __builtin_amdgcn_sinf(fr_);
                    CS[(size_t)t * 32 + j] = c; SN[(size_t)t * 32 + j] = s;
                    const float lo = PS[(size_t)t * 128 + 48 + j], hi = PS[(size_t)t * 128 + 80 + j];
                    KROPE[(size_t)t * 64 + j] = (bf16_t)f2bf(lo * c - hi * s); KROPE[(size_t)t * 64 + 32 + j] = (bf16_t)f2bf(lo * s + hi * c);
                    continue; }
            }
        } else if (kph == 2 && (PHMASK >> 2 & 1)) {
            constexpr int N_M = 512, N_X = 1024, N_S = 2048, N_K = 1024, NTOT = N_M + N_X + N_S + N_K;
            for (;;) {
                int it = next_item(ctr, lds); if (it >= NTOT) break;
                if (it < N_M) { const int qb = 15 - (it >> 5), rem = it & 31;
                    attn_unit<192, 128, false, false, MLA_FAST>(lds, rem >> 3, rem & 7, qb, ws); continue; }
                it -= N_M;
                if (it < N_X) { const int qb = 15 - (it >> 6), rem = it & 63;
                    attn_unit<64, 64, true, true, FOX_FAST>(lds, rem >> 4, rem & 15, qb, ws); continue; }
                it -= N_X;
                if (it < N_S) { LANEIDS
                    const int h = it & 15, chunk = it >> 4, t0 = chunk * 128, g = h >> 3;
                    const float alast = ACUM[(size_t)(t0 + 127) * 16 + h];
                    f32x4 acc[4];
#pragma unroll
                    for (int p = 0; p < 4; ++p) acc[p] = (f32x4){0.f, 0.f, 0.f, 0.f};
#pragma unroll
                    for (int ks = 0; ks < 4; ++ks) {
                        float bv[8]; unpack8(ld16(XBCT + ((size_t)chunk * 1280 + 1024 + g * 128 + 16 * wave + r16) * 128 + ks * 32 + fq * 8), bv);
#pragma unroll
                        for (int i = 0; i < 8; ++i) { const int tl = t0 + ks * 32 + fq * 8 + i; bv[i] *= DTV[(size_t)tl * 16 + h] * __expf(alast - ACUM[(size_t)tl * 16 + h]); }
                        const bf16x8 bw = pack8(bv);
#pragma unroll
                        for (int p = 0; p < 4; ++p) acc[p] = MFMA16(bw, ld16(XBCT + ((size_t)chunk * 1280 + h * 64 + 16 * p + r16) * 128 + ks * 32 + fq * 8), acc[p]);
                    }
#pragma unroll
                    for (int p = 0; p < 4; ++p) *(u32x2*)(SST + ((size_t)chunk * 16 + h) * 8192 + (16 * p + r16) * 128 + 16 * wave + 4 * fq) = pack4(acc[p]);
                    continue; }
                it -= N_S;
                { LANEIDS
                    const int gc = it >> 2, h = it & 3, b = gc >> 6, c = gc & 63, bh = b * 4 + h;
                    bf16x8 kf[2];
#pragma unroll
                    for (int ks = 0; ks < 2; ++ks) kf[ks] = ld16(KTT + ((size_t)gc * 512 + h * 128 + 16 * wave + r16) * 64 + ks * 32 + fq * 8);
                    const f32x4 eb = *(const f32x4*)(BLAST + (size_t)gc * 512 + h * 128 + 16 * wave + 4 * fq);
                    const f32x4 ee = {__expf(eb[0]), __expf(eb[1]), __expf(eb[2]), __expf(eb[3])};
#pragma unroll 4
                    for (int et = 0; et < 16; ++et) { f32x4 acc = {0.f, 0.f, 0.f, 0.f};
#pragma unroll
                        for (int ks = 0; ks < 2; ++ks) acc = MFMA16(kf[ks], ld16(VTG + ((size_t)gc * 1024 + h * 256 + 16 * et + r16) * 64 + ks * 32 + fq * 8), acc);
                        *(u32x2*)(GST + (((size_t)bh * 64 + c) * 256 + 16 * et + r16) * 128 + 16 * wave + 4 * fq) = pack4(acc * ee); }
                }
            }
        } else if (kph == 3 && (PHMASK >> 3 & 1)) {
            for (int it = bid; it < 256; it += G) {
                if (it < 128) { const int e8 = (it * 512 + tid) * 8, bh = e8 >> 13, off = e8 & 8191, b = bh >> 4, h = bh & 15;
                    float st[8];
#pragma unroll
                    for (int i = 0; i < 8; ++i) st[i] = 0.f;
                    for (int cg8 = 0; cg8 < 4; ++cg8) { bf16x8 vv[8]; float dec[8];
#pragma unroll
                        for (int q = 0; q < 8; ++q) { const int c = cg8 * 8 + q; vv[q] = *(const bf16x8*)(SST + ((size_t)(b * 32 + c) * 16 + h) * 8192 + off); dec[q] = ACUM[(size_t)(b * S_ + c * 128 + 127) * 16 + h]; }
#pragma unroll
                        for (int q = 0; q < 8; ++q) { const int c = cg8 * 8 + q; float v[8]; unpack8(vv[q], v); const float d = __expf(dec[q]);
                            *(bf16x8*)(SST + ((size_t)(b * 32 + c) * 16 + h) * 8192 + off) = pack8(st);
#pragma unroll
                            for (int i = 0; i < 8; ++i) st[i] = st[i] * d + v[i]; } }
                } else { const int e8 = ((it - 128) * 512 + tid) * 8, bh = e8 >> 15, off = e8 & 32767, d0 = off & 127, b = bh >> 2, h = bh & 3;
                    float st[8];
#pragma unroll
                    for (int i = 0; i < 8; ++i) st[i] = 0.f;
                    for (int cg8 = 0; cg8 < 8; ++cg8) { bf16x8 vv[8]; f32x4 e0[8], e1[8];
#pragma unroll
                        for (int q = 0; q < 8; ++q) { const int c = cg8 * 8 + q; vv[q] = *(const bf16x8*)(GST + ((size_t)bh * 64 + c) * 32768 + off);
                            e0[q] = *(const f32x4*)(BLAST + (size_t)(b * 64 + c) * 512 + h * 128 + d0); e1[q] = *(const f32x4*)(BLAST + (size_t)(b * 64 + c) * 512 + h * 128 + d0 + 4); }
#pragma unroll
                        for (int q = 0; q < 8; ++q) { const int c = cg8 * 8 + q; float v[8]; unpack8(vv[q], v);
                            *(bf16x8*)(GST + ((size_t)bh * 64 + c) * 32768 + off) = pack8(st);
#pragma unroll
                            for (int i = 0; i < 8; ++i) st[i] = st[i] * __expf(i < 4 ? e0[q][i & 3] : e1[q][i & 3]) + v[i]; } }
                }
            }
        } else if (kph == 4 && (PHMASK >> 4 & 1)) {
            constexpr int N_S = 256, N_G = 1024, NTOT = N_S + N_G;
            for (;;) {
                int it = next_item(ctr, lds); if (it >= NTOT) break;
                if (it < N_S) { LANEIDS
                    const int g = it & 1, chunk = it >> 1, t0 = chunk * 128;
                    LAS float* sAc = (LAS float*)lds; LAS float* sDt = sAc + 1024;
                    for (int i = tid; i < 1024; i += 512) { const int hh = i >> 7, s = i & 127; sAc[i] = ACUM[(size_t)(t0 + s) * 16 + g * 8 + hh]; sDt[i] = DTV[(size_t)(t0 + s) * 16 + g * 8 + hh]; }
                    __syncthreads();
                    const int tl = t0 + 16 * wave + r16, lpos = 16 * wave + r16;
                    bf16x8 cf[4];
#pragma unroll
                    for (int ks = 0; ks < 4; ++ks) cf[ks] = ld16(XBC + (size_t)tl * 1536 + 1280 + g * 128 + ks * 32 + fq * 8);
                    f32x4 gacc[8];
#pragma unroll
                    for (int mt = 0; mt < 8; ++mt) { gacc[mt] = (f32x4){0.f, 0.f, 0.f, 0.f};
                        if (mt <= wave) {
#pragma unroll
                            for (int ks = 0; ks < 4; ++ks) gacc[mt] = MFMA16(ld16(XBC + (size_t)(t0 + 16 * mt + r16) * 1536 + 1024 + g * 128 + ks * 32 + fq * 8), cf[ks], gacc[mt]); } }
                    float ssq = 0.f;
#pragma unroll 2
                    for (int hh = 0; hh < 8; ++hh) { const int h = g * 8 + hh;
                        const float al = sAc[hh * 128 + lpos], el = __expf(al);
                        f32x4 acc1[4], acc2[4];
#pragma unroll
                        for (int p = 0; p < 4; ++p) { acc1[p] = (f32x4){0.f, 0.f, 0.f, 0.f}; acc2[p] = (f32x4){0.f, 0.f, 0.f, 0.f}; }
#pragma unroll
                        for (int ss = 0; ss < 4; ++ss) if (2 * ss <= wave) {
                            f32x4 wv[2];
#pragma unroll
                            for (int q = 0; q < 2; ++q) { const int mt = 2 * ss + q; const f32x4 as = *(const LAS f32x4*)(sAc + hh * 128 + 16 * mt + 4 * fq), ds = *(const LAS f32x4*)(sDt + hh * 128 + 16 * mt + 4 * fq);
#pragma unroll
                                for (int j = 0; j < 4; ++j) { const int spos = 16 * mt + 4 * fq + j; wv[q][j] = (spos <= lpos) ? gacc[mt][j] * __expf(fminf(al - as[j], 0.f)) * ds[j] : 0.f; } }
                            const bf16x8 wp = pack44(wv[0], wv[1]);
#pragma unroll
                            for (int p = 0; p < 4; ++p) { const bf16_t* xp = XBCT + ((size_t)chunk * 1280 + h * 64 + 16 * p + r16) * 128 + 32 * ss + 4 * fq;
                                acc1[p] = MFMA16(ld8x2(xp, xp + 16), wp, acc1[p]); }
                        }
#pragma unroll
                        for (int ks = 0; ks < 4; ++ks)
#pragma unroll
                            for (int p = 0; p < 4; ++p) acc2[p] = MFMA16(ld16(SST + ((size_t)chunk * 16 + h) * 8192 + (16 * p + r16) * 128 + ks * 32 + fq * 8), cf[ks], acc2[p]);
                        const float dsk = d_skip[l * 16 + h];
#pragma unroll
                        for (int p = 0; p < 4; ++p) { const int pc = h * 64 + 16 * p + 4 * fq;
                            const f32x4 xv = unpack4(*(const u32x2*)(XBC + (size_t)tl * 1536 + pc)), zv = unpack4(*(const u32x2*)(P1 + (size_t)tl * NP1 + C_MZ + pc));
                            f32x4 y = acc1[p] + acc2[p] * el + xv * dsk;
                            y = (f32x4){y[0] * silu(zv[0]), y[1] * silu(zv[1]), y[2] * silu(zv[2]), y[3] * silu(zv[3])};
                            ssq += y[0] * y[0] + y[1] * y[1] + y[2] * y[2] + y[3] * y[3];
                            *(u32x2*)(OUT + (size_t)tl * 4096 + pc) = pack4(y); }
                    }
                    ssq += __shfl_xor(ssq, 16); ssq += __shfl_xor(ssq, 32);
                    const float rs = rsqrtf(ssq * (1.f / 512.f) + EPS);
                    asm volatile("s_waitcnt vmcnt(0)" ::: "memory");
                    for (int hh = 0; hh < 8; ++hh)
#pragma unroll
                        for (int p = 0; p < 4; ++p) { const int pc = (g * 8 + hh) * 64 + 16 * p + 4 * fq; bf16_t* op = OUT + (size_t)tl * 4096 + pc;
                            const f32x4 nw = *(const f32x4*)(ssm_norm + l * 1024 + pc); *(u32x2*)op = pack4(unpack4(*(const u32x2*)op) * nw * rs); }
                    continue; }
                it -= N_S;
                { LANEIDS
                    const int gc = it >> 2, h = it & 3, b = gc >> 6, c = gc & 63, bh = b * 4 + h, t0 = gc * 64;
                    const int itl = wave & 3, eh = wave >> 2, ti = t0 + 16 * itl + r16, ipos = 16 * itl + r16;
                    LAS float* sSS = (LAS float*)(lds + MISC_OFF + 64);
                    bf16x8 qf[4];
#pragma unroll
                    for (int ks = 0; ks < 4; ++ks) qf[ks] = ld16(P1 + (size_t)ti * NP1 + C_GQ + h * 128 + ks * 32 + fq * 8);
                    f32x4 aacc[4];
#pragma unroll
                    for (int mt = 0; mt < 4; ++mt) { aacc[mt] = (f32x4){0.f, 0.f, 0.f, 0.f};
                        if (mt <= itl) {
#pragma unroll
                            for (int ks = 0; ks < 4; ++ks) aacc[mt] = MFMA16(ld16(P1 + (size_t)(t0 + 16 * mt + r16) * NP1 + C_GK + h * 128 + ks * 32 + fq * 8), qf[ks], aacc[mt]);
#pragma unroll
                            for (int j = 0; j < 4; ++j) if (16 * mt + 4 * fq + j > ipos) aacc[mt][j] = 0.f; } }
                    bf16x8 wp[2]; wp[0] = pack44(aacc[0], aacc[1]); wp[1] = pack44(aacc[2], aacc[3]);
                    f32x4 oacc[8]; float ssq = 0.f;
#pragma unroll
                    for (int et = 0; et < 8; ++et) { const int e = 16 * (8 * eh + et) + r16; f32x4 o = {0.f, 0.f, 0.f, 0.f};
#pragma unroll
                        for (int ss = 0; ss < 2; ++ss) if (2 * ss <= itl) { const bf16_t* vp = VTG + ((size_t)gc * 1024 + h * 256 + e) * 64 + 32 * ss + 4 * fq; o = MFMA16(ld8x2(vp, vp + 16), wp[ss], o); }
#pragma unroll
                        for (int ks = 0; ks < 4; ++ks) o = MFMA16(ld16(GST + (((size_t)bh * 64 + c) * 256 + e) * 128 + ks * 32 + fq * 8), qf[ks], o);
                        oacc[et] = o; ssq += o[0] * o[0] + o[1] * o[1] + o[2] * o[2] + o[3] * o[3]; }
                    ssq += __shfl_xor(ssq, 16); ssq += __shfl_xor(ssq, 32);
                    if (fq == 0) sSS[eh * 64 + ipos] = ssq;
                    __syncthreads();
                    const float rs = rsqrtf((sSS[ipos] + sSS[64 + ipos]) * (1.f / 256.f) + EPS);
#pragma unroll
                    for (int et = 0; et < 8; ++et) { const int e0 = 16 * (8 * eh + et) + 4 * fq;
                        const f32x4 gv = unpack4(*(const u32x2*)(P1 + (size_t)ti * NP1 + C_GG + h * 256 + e0)), nw = *(const f32x4*)(gla_norm + l * 256 + e0);
                        f32x4 o = oacc[et] * nw * rs; o = (f32x4){o[0] * silu(gv[0]), o[1] * silu(gv[1]), o[2] * silu(gv[2]), o[3] * silu(gv[3])};
                        *(u32x2*)(OUT + (size_t)ti * 4096 + 2048 + h * 256 + e0) = pack4(o); }
                }
            }
        } else if (kph == 5 && (PHMASK >> 5 & 1)) {
            pg8::MergeOrder S{(const char*)OUT, (const char*)(WBT + (size_t)l * 8192 * 1024), G, bid};
            pg8::EpiMerge E{PM, MIXF, MIXB};
            pg8::gemm_phase(lds, 1024, 4096, 1024, S, E);
        } else if (kph == 6 && (PHMASK >> 6 & 1)) {
            pg8::PlainOrder S{(const char*)MIXB, (const char*)(WOT + (size_t)l * 2048 * 2048), 64, 8, G, bid, (size_t)256 * 2048 * 2, (size_t)256 * 2048 * 2};
            pg8::EpiOut E{Y};
            pg8::gemm_phase(lds, 2048, 2048, 2048, S, E);
        }
    }
}
__global__ void __launch_bounds__(512, 2) mk_fwd(Args args) {
    extern __shared__ __attribute__((aligned(16))) unsigned char lds_raw[];
    LAS unsigned char* lds = (LAS unsigned char*)lds_raw;
    const int lo = args.ph_lo, hi = args.ph_hi;
#define PH(k) if (lo <= (k) && (k) < hi) { phase_body((k), lds); if ((k) > 0 && (((k) - 1) & 7) == REP_KPH) { cg::this_grid().sync(); phase_body((k), lds, 1); } if ((k) + 1 < hi) cg::this_grid().sync(); }
    PH(0) PH(1) PH(2) PH(3) PH(4) PH(5) PH(6) PH(7) PH(8) PH(9) PH(10) PH(11) PH(12) PH(13) PH(14) PH(15) PH(16)
#undef PH
}

extern "C" void kernel_launch(void* const* d_in, const int* in_sizes, int n_in, void* d_out, int out_size, void* d_ws, size_t ws_size, hipStream_t stream) {
    static int grid = 0;
    if (grid == 0) {
        if (n_in != 21 || ws_size < WS_END) { fprintf(stderr, "kernel_launch: unexpected n_in %d or ws_size %zu (< %zu)\n", n_in, ws_size, (size_t)WS_END); }
        int dev = 0, cus = 0, per_cu = 0;
        hipGetDevice(&dev); hipDeviceGetAttribute(&cus, hipDeviceAttributeMultiprocessorCount, dev);
        hipFuncSetAttribute((const void*)mk_fwd, hipFuncAttributeMaxDynamicSharedMemorySize, LDS_BYTES);
        hipOccupancyMaxActiveBlocksPerMultiprocessor(&per_cu, (const void*)mk_fwd, 512, LDS_BYTES);
        if (per_cu < 1) { fprintf(stderr, "kernel_launch: occupancy query says %d blocks/CU\n", per_cu); per_cu = 1; }
        (void)hipGetLastError();
        grid = cus * 1;
        if (grid <= 0) grid = 256;
    }
    Args a{};
    for (int i = 0; i < 21; ++i) a.in[i] = d_in[i];
    a.out = (float*)d_out; a.ws = (unsigned char*)d_ws;
#if MK_SINGLE
    a.ph_lo = 0; a.ph_hi = NPHASE;
    void* kargs[] = {&a};
    hipError_t e = hipLaunchCooperativeKernel((const void*)mk_fwd, dim3(grid), dim3(512), kargs, LDS_BYTES, stream);
    if (e != hipSuccess) fprintf(stderr, "cooperative launch failed: %s (grid %d)\n", hipGetErrorString(e), grid);
#else
    for (int ph = 0; ph < NPHASE; ++ph) { a.ph_lo = ph; a.ph_hi = ph + 1;
        hipLaunchKernelGGL(mk_fwd, dim3(grid), dim3(512), LDS_BYTES, stream, a); }
#endif
}
```

```cpp
#include <hip/hip_runtime.h>
#include <hip/hip_cooperative_groups.h>
#include <cstdio>
#include <cstdint>
namespace cg = cooperative_groups;

#ifndef PHMASK
#define PHMASK 0x1ff
#endif
#ifndef MLA_FAST
#define MLA_FAST false
#endif
#ifndef FOX_FAST
#define FOX_FAST true
#endif
#ifndef REP_KPH
#define REP_KPH -2
#endif
#ifndef MK_SINGLE
#define MK_SINGLE 1
#endif

#define LAS __attribute__((address_space(3)))
#define DI __device__ __forceinline__
typedef unsigned short bf16_t;
typedef short bf16x8 __attribute__((ext_vector_type(8)));
typedef short s16x4 __attribute__((ext_vector_type(4)));
typedef float f32x4 __attribute__((ext_vector_type(4)));
typedef unsigned u32x4 __attribute__((ext_vector_type(4)));
typedef unsigned u32x2 __attribute__((ext_vector_type(2)));
#define MFMA16(a, b, c) __builtin_amdgcn_mfma_f32_16x16x32_bf16((a), (b), (c), 0, 0, 0)

constexpr int T_ = 16384, S_ = 4096, DM = 2048;
constexpr int NIN = 20080, NP1 = 11776, NPM = 8192, NW1 = 20224;
constexpr int C_MZ = 0, C_XBC = 1024, C_FQ = 2560, C_FK = 3584, C_FV = 4608, C_FG = 5632, C_GQ = 6656, C_GK = 7168, C_GV = 7680,
              C_GG = 8704, C_LCQ = 9728, C_LCKV = 10240, C_LG = 10752;
constexpr float EPS = 1e-6f;
constexpr float LOG2E = 1.4426950408889634f;

constexpr size_t MiB = 1u << 20;
constexpr size_t O_CTL = 0;
constexpr size_t O_SSQ = 1 * MiB;
constexpr size_t O_DT = 2 * MiB;
constexpr size_t O_ACUM = 3 * MiB;
constexpr size_t O_FCUM = 4 * MiB;
constexpr size_t O_CS = 5 * MiB;
constexpr size_t O_SN = 7 * MiB;
constexpr size_t O_KROPE = 9 * MiB;
constexpr size_t O_BLAST = 11 * MiB;
constexpr size_t O_PSMALL = 12 * MiB;
constexpr size_t O_WBT = 20 * MiB;
constexpr size_t O_WOT = 52 * MiB;
constexpr size_t O_WUQT = 68 * MiB;
constexpr size_t O_WUKVT = 71 * MiB;
constexpr size_t O_P1 = 75 * MiB;
constexpr size_t O_PM = 443 * MiB;
constexpr size_t O_OUT = 699 * MiB;
constexpr size_t O_WINT = O_OUT;
constexpr size_t O_H = 827 * MiB;
constexpr size_t O_GST = O_H;
constexpr size_t O_QM = 891 * MiB;
constexpr size_t O_KN = 939 * MiB;
constexpr size_t O_VTM = 971 * MiB;
constexpr size_t O_VTF = 1003 * MiB;
constexpr size_t O_XBC = 1035 * MiB;
constexpr size_t O_XBCT = 1083 * MiB;
constexpr size_t O_SST = 1123 * MiB;
constexpr size_t O_KTT = 1155 * MiB;
constexpr size_t O_VTG = 1171 * MiB;
constexpr size_t WS_END = 1203 * MiB;
constexpr size_t O_MIXF = O_P1;
constexpr size_t O_MIXB = O_P1 + 128 * MiB;
constexpr size_t O_Y = O_P1 + 192 * MiB;

constexpr int LDS_BYTES = 135168;
constexpr int MISC_OFF = 131072;
constexpr int NPHASE = 17;

DI unsigned f2bf(float f) { unsigned u = __float_as_uint(f); return (u + 0x7fffu + ((u >> 16) & 1u)) >> 16; }
typedef float f32x2_t __attribute__((ext_vector_type(2)));
typedef __bf16 bf16x2_t __attribute__((ext_vector_type(2)));
DI unsigned pk2(float lo, float hi) { f32x2_t v = {lo, hi}; bf16x2_t b = __builtin_convertvector(v, bf16x2_t); return __builtin_bit_cast(unsigned, b); }
DI float bflo(unsigned u) { return __uint_as_float(u << 16); }
DI float bfhi(unsigned u) { return __uint_as_float(u & 0xffff0000u); }
DI float bf1(bf16_t b) { return __uint_as_float(((unsigned)b) << 16); }
DI float sigm(float x) { return 1.f / (1.f + __expf(-x)); }
DI float silu(float x) { return x / (1.f + __expf(-x)); }
DI float softplus_(float x) { return fmaxf(x, 0.f) + log1pf(__expf(-fabsf(x))); }
DI float logsig(float x) { return fminf(x, 0.f) - log1pf(__expf(-fabsf(x))); }
DI float xmax_fq(float x) {
    auto a = __builtin_amdgcn_permlane32_swap(__float_as_uint(x), __float_as_uint(x), false, false);
    x = fmaxf(__uint_as_float(a[0]), __uint_as_float(a[1]));
    auto b = __builtin_amdgcn_permlane16_swap(__float_as_uint(x), __float_as_uint(x), false, false);
    return fmaxf(__uint_as_float(b[0]), __uint_as_float(b[1]));
}
DI float wave_sum(float v) {
#pragma unroll
    for (int o = 1; o < 64; o <<= 1) v += __shfl_xor(v, o);
    return v;
}
DI void unpack8(bf16x8 v, float (&f)[8]) {
    u32x4 u = __builtin_bit_cast(u32x4, v);
    f[0] = bflo(u.x); f[1] = bfhi(u.x); f[2] = bflo(u.y); f[3] = bfhi(u.y); f[4] = bflo(u.z); f[5] = bfhi(u.z); f[6] = bflo(u.w); f[7] = bfhi(u.w);
}
DI bf16x8 pack8(const float (&f)[8]) {
    u32x4 u; u.x = pk2(f[0], f[1]); u.y = pk2(f[2], f[3]); u.z = pk2(f[4], f[5]); u.w = pk2(f[6], f[7]);
    return __builtin_bit_cast(bf16x8, u);
}
DI bf16x8 pack44(f32x4 a, f32x4 b) {
    u32x4 u; u.x = pk2(a[0], a[1]); u.y = pk2(a[2], a[3]); u.z = pk2(b[0], b[1]); u.w = pk2(b[2], b[3]);
    return __builtin_bit_cast(bf16x8, u);
}
DI u32x2 pack4(f32x4 a) { u32x2 u; u.x = pk2(a[0], a[1]); u.y = pk2(a[2], a[3]); return u; }
DI f32x4 unpack4(u32x2 u) { return (f32x4){bflo(u.x), bfhi(u.x), bflo(u.y), bfhi(u.y)}; }
DI bf16x8 ld16(const bf16_t* p) { return *(const bf16x8*)p; }
DI bf16x8 ld8x2(const bf16_t* p0, const bf16_t* p1) {
    s16x4 a = *(const s16x4*)p0, b = *(const s16x4*)p1;
    return __builtin_shufflevector(a, b, 0, 1, 2, 3, 4, 5, 6, 7);
}

DI int otid() { int t = threadIdx.x; asm volatile("" : "+v"(t)); return t; }
#define LANEIDS const int tid = otid(), lane = tid & 63, wave = __builtin_amdgcn_readfirstlane(tid >> 6), r16 = lane & 15, fq = lane >> 4; (void)tid; (void)lane; (void)wave; (void)r16; (void)fq;
DI int osg(int v) { asm volatile("" : "+s"(v)); return v; }
struct Args { const void* in[21]; float* out; unsigned char* ws; int ph_lo, ph_hi; };

DI int next_item(unsigned* ctr, LAS unsigned char* lds) {
    volatile LAS int* s = (volatile LAS int*)(lds + MISC_OFF);
    __syncthreads();
    if (threadIdx.x == 0) *s = (int)atomicAdd(ctr, 1u);
    __syncthreads();
    return *s;
}

namespace pg8 {
constexpr int BM = 256, BK = 64, HALF = 128, HTB = HALF * BK * 2, STAGE_BYTES = 8 * HTB, NXCD = 8, WGM = 8;
DI int lds_byte(int r, int c) { const int st = (r >> 4) * 2 + (c >> 5), rr = r & 15, cc = c & 31, ob = rr * 64 + cc * 2; return st * 1024 + (ob ^ (((ob >> 9) & 1) << 5)); }
DI void stage_rc(int b, int& R, int& C) { const int st = b / 1024, sb = b % 1024, swz = sb ^ (((sb >> 9) & 1) << 5); R = (st >> 1) * 16 + swz / 64; C = (st & 1) * 32 + (swz % 64) / 2; }
DI int perm32(int rho) { const int n = rho >> 4, i = rho & 15; return 8 * (i >> 2) + 4 * n + (i & 3); }

struct Unit { int pm, pn, aux; const char* A; const char* B; };

DI void tile_of(int L, int nM, int nN, int& pm, int& pn) {
    const int nwg = nM * nN; int wgid = L;
    { const int q = nwg / NXCD, r = nwg % NXCD, xcd = wgid % NXCD, off = wgid / NXCD; wgid = (xcd < r ? xcd * (q + 1) : r * (q + 1) + (xcd - r) * q) + off; }
    const int nig = WGM * nN, gid = wgid / nig, fm = gid * WGM, gsz = (nM - fm) < WGM ? (nM - fm) : WGM;
    pm = fm + ((wgid % nig) % gsz); pn = (wgid % nig) / gsz;
}
struct PlainOrder {
    const char* A; const char* B; int nM, nN, G, c; size_t tsA, tsB;
    DI bool next(int i, Unit& u) const {
        const long L = (long)i * G + c; if (L >= (long)nM * nN) return false;
        tile_of((int)L, nM, nN, u.pm, u.pn); u.aux = 0; u.A = A + (size_t)u.pm * tsA; u.B = B + (size_t)u.pn * tsB; return true;
    }
};
struct ProjOrder {
    const char* A; const char* B; int G, c;
    DI bool next(int i, Unit& u) const {
        const long L = (long)i * G + c; if (L >= 64 * 79) return false;
        int pm, pn; tile_of((int)L, 64, 79, pm, pn);
        const size_t ts = (size_t)256 * 2048 * 2;
        const bool fv = (pn >= 18 && pn < 22), gv = (pn >= 30 && pn < 34);
        if (fv || gv) { u.pm = pn; u.pn = pm; u.aux = fv ? 1 : 2; u.A = B + (size_t)pn * ts; u.B = A + (size_t)pm * ts; }
        else { u.pm = pm; u.pn = pn; u.aux = 0; u.A = A + (size_t)pm * ts; u.B = B + (size_t)pn * ts; }
        return true;
    }
};
struct MlaOrder {
    const char* P1; const char* Wq; const char* Wkv; int G, c;
    DI bool next(int i, Unit& u) const {
        const long L = (long)i * G + c; if (L >= 64 * 10) return false;
        const int pm = (int)L / 10, rem = (int)L % 10; u.pm = pm; u.aux = rem;
        if (rem < 6) { u.pn = rem; u.A = P1 + ((size_t)pm * 256 * NP1 + C_LCQ) * 2; u.B = Wq + (size_t)rem * 256 * 512 * 2; }
        else { u.pn = rem - 6; u.A = P1 + ((size_t)pm * 256 * NP1 + C_LCKV) * 2; u.B = Wkv + (size_t)(rem - 6) * 256 * 512 * 2; }
        return true;
    }
};
struct MlaVOrder {
    const char* P1; const char* Wv; int G, c;
    DI bool next(int i, Unit& u) const {
        const long L = (long)i * G + c; if (L >= 256) return false;
        u.pm = (int)L & 3; u.pn = (int)L >> 2; u.aux = 0;
        u.A = Wv + (size_t)u.pm * 256 * 512 * 2; u.B = P1 + ((size_t)u.pn * 256 * NP1 + C_LCKV) * 2; return true;
    }
};
struct MergeOrder {
    const char* OUTp; const char* Wb; int G, c;
    DI bool next(int i, Unit& u) const {
        const int j = i >> 2, br = i & 3; const long L = (long)j * G + c; if (L >= 512) return false;
        tile_of((int)L, 64, 8, u.pm, u.pn); u.aux = br;
        u.A = OUTp + ((size_t)br * T_ + (size_t)u.pm * 256) * 1024 * 2; u.B = Wb + ((size_t)br * 2048 + u.pn * 256) * 1024 * 2; return true;
    }
};

template <class Epi, class Sched>
DI void gemm_phase(LAS unsigned char* lds, const int K, const int lda, const int ldb, const Sched& S, const Epi& E) {
    const int tid = otid(), wid = __builtin_amdgcn_readfirstlane(tid >> 6), lane = tid & 63, wr = wid >> 2, wc = wid & 3, fr = lane & 15, fq = lane >> 4;
    const int nt = K / BK;
    unsigned voffA[2], voffB[2];
#pragma unroll
    for (int i = 0; i < 2; ++i) { int R, C; stage_rc(tid * 16 + i * 8192, R, C); const int Rb = (R & ~31) + perm32(R & 31);
        voffA[i] = (unsigned)(R * lda + C) * 2u; voffB[i] = (unsigned)(Rb * ldb + C) * 2u; }
    const size_t kstep = (size_t)(BK * 2);
    const size_t hstepA = (size_t)HALF * lda * 2, hstepB = (size_t)HALF * ldb * 2;
    const unsigned ldsw = (unsigned)wid * 1024u;
    const int aoff = lds_byte(wr * 64 + fr, fq * 8), boff = lds_byte(wc * 32 + fr, fq * 8);
#define PG8_SA(b, h) (((b) * 2 + (h)) * HTB)
#define PG8_SB(b, h) ((4 + (b) * 2 + (h)) * HTB)
#define PG8_STAGE(bufoff, gbase, voff) do { _Pragma("unroll") for (int _i = 0; _i < 2; ++_i) \
        __builtin_amdgcn_global_load_lds((const unsigned*)((const char*)(gbase) + (voff)[_i]), (LAS unsigned*)(lds + (bufoff) + ldsw + _i * 8192), 16, 0, 0); } while (0)
#define PG8_LDA(dst, b, h) do { _Pragma("unroll") for (int m = 0; m < 4; ++m) _Pragma("unroll") for (int k = 0; k < 2; ++k) dst[m][k] = *(const LAS bf16x8*)(lds + PG8_SA(b, h) + aoff + m * 2048 + k * 1024); } while (0)
#define PG8_LDB(dst, b, h) do { _Pragma("unroll") for (int n = 0; n < 2; ++n) _Pragma("unroll") for (int k = 0; k < 2; ++k) dst[n][k] = *(const LAS bf16x8*)(lds + PG8_SB(b, h) + boff + n * 2048 + k * 1024); } while (0)
#define PG8_MMA(ai, bj, At, Bt) do { __builtin_amdgcn_s_setprio(1); _Pragma("unroll") for (int m = 0; m < 4; ++m) _Pragma("unroll") for (int n = 0; n < 2; ++n) _Pragma("unroll") for (int k = 0; k < 2; ++k) \
        acc[ai][bj][m][n] = __builtin_amdgcn_mfma_f32_16x16x32_bf16(Bt[n][k], At[m][k], acc[ai][bj][m][n], 0, 0, 0); __builtin_amdgcn_s_setprio(0); } while (0)
#define PG8_WAIT_V(n) asm volatile("s_waitcnt vmcnt(" #n ")" ::: "memory")
#define PG8_WAIT_L(n) asm volatile("s_waitcnt lgkmcnt(" #n ")" ::: "memory")
#define PG8_BAR __builtin_amdgcn_s_barrier()
#define PG8_SCHED __builtin_amdgcn_sched_barrier(0)
    Unit cur, nxt; int ui = 0;
    if (!S.next(0, cur)) return;
    f32x4 acc[2][2][4][2];
#pragma unroll
    for (int a = 0; a < 2; ++a)
#pragma unroll
        for (int b = 0; b < 2; ++b)
#pragma unroll
            for (int m = 0; m < 4; ++m)
#pragma unroll
                for (int n = 0; n < 2; ++n) acc[a][b][m][n] = (f32x4){0.f, 0.f, 0.f, 0.f};
    bf16x8 At[4][2], B0[2][2], B1[2][2];
    const char* cA = cur.A; const char* cB = cur.B;
    PG8_STAGE(PG8_SB(0, 0), cB, voffB); PG8_STAGE(PG8_SB(0, 1), cB + hstepB, voffB); PG8_STAGE(PG8_SA(0, 0), cA, voffA); PG8_STAGE(PG8_SA(0, 1), cA + hstepA, voffA);
    if (wr == 1) PG8_BAR;
    PG8_WAIT_V(2); PG8_BAR;
    PG8_STAGE(PG8_SB(1, 0), cB + kstep, voffB); PG8_STAGE(PG8_SA(1, 0), cA + kstep, voffA); PG8_STAGE(PG8_SB(1, 1), cB + hstepB + kstep, voffB);
    PG8_WAIT_V(6); PG8_BAR;
    for (;;) {
        const bool has_next = S.next(ui + 1, nxt);
        const char* nA = has_next ? nxt.A : cA; const char* nB = has_next ? nxt.B : cB;
        for (int t = 0; t < nt; t += 2) {
            const bool last = (t == nt - 2);
            const char* a1 = cA + (size_t)(t + 1) * kstep;
            const char* a2 = last ? nA : cA + (size_t)(t + 2) * kstep; const char* b2 = last ? nB : cB + (size_t)(t + 2) * kstep;
            const char* a3 = a2 + kstep; const char* b3 = b2 + kstep;
            PG8_LDB(B0, 0, 0); PG8_LDB(B1, 0, 1); PG8_SCHED; PG8_LDA(At, 0, 0); PG8_STAGE(PG8_SA(1, 1), a1 + hstepA, voffA);
            PG8_WAIT_V(8); PG8_WAIT_L(0); PG8_BAR; PG8_MMA(0, 0, At, B0); PG8_MMA(0, 1, At, B1); PG8_BAR; PG8_SCHED;
            PG8_LDA(At, 0, 1); PG8_STAGE(PG8_SB(0, 0), b2, voffB); PG8_STAGE(PG8_SB(0, 1), b2 + hstepB, voffB); PG8_STAGE(PG8_SA(0, 0), a2, voffA);
            PG8_WAIT_V(8); PG8_WAIT_L(0); PG8_BAR; PG8_MMA(1, 0, At, B0); PG8_MMA(1, 1, At, B1); PG8_BAR; PG8_SCHED;
            PG8_LDB(B0, 1, 0); PG8_LDB(B1, 1, 1); PG8_SCHED; PG8_LDA(At, 1, 0); PG8_STAGE(PG8_SA(0, 1), a2 + hstepA, voffA);
            PG8_WAIT_V(8); PG8_WAIT_L(0); PG8_BAR; PG8_MMA(0, 0, At, B0); PG8_MMA(0, 1, At, B1); PG8_BAR; PG8_SCHED;
            PG8_LDA(At, 1, 1); PG8_STAGE(PG8_SB(1, 0), b3, voffB); PG8_STAGE(PG8_SB(1, 1), b3 + hstepB, voffB); PG8_STAGE(PG8_SA(1, 0), a3, voffA);
            PG8_WAIT_V(8); PG8_WAIT_L(0); PG8_BAR; PG8_MMA(1, 0, At, B0); PG8_MMA(1, 1, At, B1); PG8_BAR; PG8_SCHED;
        }
        if (wr == 0) PG8_BAR;
        E(acc, cur, wr, wc, fr, fq);
        if (!has_next) break;
#pragma unroll
        for (int a = 0; a < 2; ++a)
#pragma unroll
            for (int b = 0; b < 2; ++b)
#pragma unroll
                for (int m = 0; m < 4; ++m)
#pragma unroll
                    for (int n = 0; n < 2; ++n) acc[a][b][m][n] = (f32x4){0.f, 0.f, 0.f, 0.f};
        cur = nxt; cA = nA; cB = nB; ++ui;
        if (wr == 1) PG8_BAR;
    }
    PG8_WAIT_V(0);
    PG8_BAR;
#undef PG8_SA
#undef PG8_SB
#undef PG8_STAGE
#undef PG8_LDA
#undef PG8_LDB
#undef PG8_MMA
#undef PG8_WAIT_V
#undef PG8_WAIT_L
#undef PG8_BAR
#undef PG8_SCHED
}

#define EPI_LOOP_BEGIN _Pragma("unroll") for (int ai = 0; ai < 2; ++ai) _Pragma("unroll") for (int m = 0; m < 4; ++m) { const int row = u.pm * 256 + ai * 128 + wr * 64 + m * 16 + fr;
#define EPI_BJ_BEGIN _Pragma("unroll") for (int bj = 0; bj < 2; ++bj) { const int lc = bj * 128 + wc * 32 + 8 * fq; const f32x4 v0 = acc[ai][bj][m][0], v1 = acc[ai][bj][m][1];
#define EPI_END __builtin_amdgcn_sched_barrier(0); } }

struct EpiProj {
    bf16_t* P1; bf16_t* PM; float* PS; float* SSQ; bf16_t* VTF; bf16_t* VTG;
    DI void operator()(const f32x4 (&acc)[2][2][4][2], const Unit& u, int wr, int wc, int fr, int fq) const {
        const int pn = u.pn;
        if (u.aux != 0) {
            EPI_LOOP_BEGIN
                EPI_BJ_BEGIN
                    const int tok = u.pn * 256 + lc;
                    if (u.aux == 1) *(bf16x8*)(VTF + ((size_t)(tok >> 12) * 1024 + (row - C_FV)) * 4096 + (tok & 4095)) = pack44(v0, v1);
                    else *(bf16x8*)(VTG + ((size_t)(tok >> 6) * 1024 + (row - C_GV)) * 64 + (tok & 63)) = pack44(v0, v1);
            EPI_END
        } else if (pn < 46) {
            const bool stat = (pn >= 38 && pn < 42);
            EPI_LOOP_BEGIN
                float ss = 0.f;
                EPI_BJ_BEGIN
                    *(bf16x8*)(P1 + (size_t)row * NP1 + pn * 256 + lc) = pack44(v0, v1);
                    ss += v0[0] * v0[0] + v0[1] * v0[1] + v0[2] * v0[2] + v0[3] * v0[3] + v1[0] * v1[0] + v1[1] * v1[1] + v1[2] * v1[2] + v1[3] * v1[3];
                    __builtin_amdgcn_sched_barrier(0);
                }
                if (stat && SSQ) { ss += __shfl_xor(ss, 16); ss += __shfl_xor(ss, 32); if (fq == 0) SSQ[(row * 2 + (pn >= 40 ? 1 : 0)) * 8 + (pn & 1) * 4 + wc] = ss; }
            }
        } else if (pn < 78) {
            EPI_LOOP_BEGIN
                EPI_BJ_BEGIN
                    f32x4 a = {sigm(v0[0]), sigm(v0[1]), sigm(v0[2]), sigm(v0[3])}, b = {sigm(v1[0]), sigm(v1[1]), sigm(v1[2]), sigm(v1[3])};
                    *(bf16x8*)(PM + (size_t)row * NPM + (pn - 46) * 256 + lc) = pack44(a, b);
            EPI_END
        } else {
            EPI_LOOP_BEGIN
                EPI_BJ_BEGIN
                    if (lc < 128) { *(f32x4*)(PS + (size_t)row * 128 + lc) = v0; *(f32x4*)(PS + (size_t)row * 128 + lc + 4) = v1; }
            EPI_END
        }
    }
};
struct EpiMla {
    const float* SSQ; bf16_t* QM; bf16_t* KN;
    DI void operator()(const f32x4 (&acc)[2][2][4][2], const Unit& u, int wr, int wc, int fr, int fq) const {
        const bool isq = u.aux < 6;
        bf16_t* dst = isq ? QM : KN; const int ld = isq ? 1536 : 1024;
#pragma unroll
        for (int ai = 0; ai < 2; ++ai) {
            f32x4 sa[4], sb[4];
#pragma unroll
            for (int m = 0; m < 4; ++m) { const int row = u.pm * 256 + ai * 128 + wr * 64 + m * 16 + fr;
                sa[m] = *(const f32x4*)(SSQ + (row * 2 + (isq ? 0 : 1)) * 8); sb[m] = *(const f32x4*)(SSQ + (row * 2 + (isq ? 0 : 1)) * 8 + 4); }
#pragma unroll
            for (int m = 0; m < 4; ++m) { const int row = u.pm * 256 + ai * 128 + wr * 64 + m * 16 + fr;
                const float rs = rsqrtf((((sa[m][0] + sa[m][1]) + (sa[m][2] + sa[m][3])) + ((sb[m][0] + sb[m][1]) + (sb[m][2] + sb[m][3]))) * (1.f / 512.f) + EPS);
#pragma unroll
                for (int bj = 0; bj < 2; ++bj) { const int lc = bj * 128 + wc * 32 + 8 * fq;
                    *(bf16x8*)(dst + (size_t)row * ld + u.pn * 256 + lc) = pack44(acc[ai][bj][m][0] * rs, acc[ai][bj][m][1] * rs); __builtin_amdgcn_sched_barrier(0); } }
        }
    }
};
struct EpiMlaV {
    const float* SSQ; bf16_t* VTM;
    DI void operator()(const f32x4 (&acc)[2][2][4][2], const Unit& u, int wr, int wc, int fr, int fq) const {
#pragma unroll
        for (int bj = 0; bj < 2; ++bj) { const int tok = u.pn * 256 + bj * 128 + wc * 32 + 8 * fq; const int bb = tok >> 12, s = tok & 4095;
            float rs[8];
#pragma unroll
            for (int e = 0; e < 8; ++e) { const f32x4 sa = *(const f32x4*)(SSQ + ((tok + e) * 2 + 1) * 8), sb = *(const f32x4*)(SSQ + ((tok + e) * 2 + 1) * 8 + 4);
                rs[e] = rsqrtf((((sa[0] + sa[1]) + (sa[2] + sa[3])) + ((sb[0] + sb[1]) + (sb[2] + sb[3]))) * (1.f / 512.f) + EPS); }
#pragma unroll
            for (int ai = 0; ai < 2; ++ai)
#pragma unroll
                for (int m = 0; m < 4; ++m) { const int row = u.pm * 256 + ai * 128 + wr * 64 + m * 16 + fr;
                    const f32x4 v0 = acc[ai][bj][m][0], v1 = acc[ai][bj][m][1];
                    const f32x4 a = {v0[0] * rs[0], v0[1] * rs[1], v0[2] * rs[2], v0[3] * rs[3]}, b = {v1[0] * rs[4], v1[1] * rs[5], v1[2] * rs[6], v1[3] * rs[7]};
                    *(bf16x8*)(VTM + ((size_t)bb * 1024 + row) * 4096 + s) = pack44(a, b); __builtin_amdgcn_sched_barrier(0); } }
    }
};
struct EpiMerge {
    const bf16_t* PM; float* MIXF; bf16_t* MIXB;
    DI void operator()(const f32x4 (&acc)[2][2][4][2], const Unit& u, int wr, int wc, int fr, int fq) const {
        const int br = u.aux;
#pragma unroll
        for (int ai = 0; ai < 2; ++ai) {
            bf16x8 gt[4][2], pv[4][2];
#pragma unroll
            for (int m = 0; m < 4; ++m)
#pragma unroll
                for (int bj = 0; bj < 2; ++bj) { const int row = u.pm * 256 + ai * 128 + wr * 64 + m * 16 + fr, gc = u.pn * 256 + bj * 128 + wc * 32 + 8 * fq;
                    gt[m][bj] = *(const bf16x8*)(PM + (size_t)row * NPM + br * 2048 + gc);
                    if (br != 0) pv[m][bj] = *(const bf16x8*)(MIXB + (size_t)row * 2048 + gc); }
#pragma unroll
            for (int m = 0; m < 4; ++m)
#pragma unroll
                for (int bj = 0; bj < 2; ++bj) { const int row = u.pm * 256 + ai * 128 + wr * 64 + m * 16 + fr, gc = u.pn * 256 + bj * 128 + wc * 32 + 8 * fq;
                    const f32x4 v0 = acc[ai][bj][m][0], v1 = acc[ai][bj][m][1]; float g[8]; unpack8(gt[m][bj], g);
                    f32x4 a = {v0[0] * g[0], v0[1] * g[1], v0[2] * g[2], v0[3] * g[3]}, b = {v1[0] * g[4], v1[1] * g[5], v1[2] * g[6], v1[3] * g[7]};
                    if (br != 0) { float p[8]; unpack8(pv[m][bj], p); a += (f32x4){p[0], p[1], p[2], p[3]}; b += (f32x4){p[4], p[5], p[6], p[7]}; }
                    *(bf16x8*)(MIXB + (size_t)row * 2048 + gc) = pack44(a, b); }
            __builtin_amdgcn_sched_barrier(0);
        }
    }
};
struct EpiOut {
    float* Y;
    DI void operator()(const f32x4 (&acc)[2][2][4][2], const Unit& u, int wr, int wc, int fr, int fq) const {
        EPI_LOOP_BEGIN
            EPI_BJ_BEGIN
                float* yp = Y + (size_t)row * 2048 + u.pn * 256 + lc; *(f32x4*)yp = v0; *(f32x4*)(yp + 4) = v1;
        EPI_END
    }
};
}

DI int win_src(int n) {
    if (n < 2560) return n;
    if (n < 5632) return n + 16;
    if (n < 8704) return n + 32;
    if (n < 10752) return n + 48;
    if (n < 19968) return n + 112;
    const int r = n - 19968;
    if (r < 16) return 2560 + r;
    if (r < 32) return 5648 + (r - 16);
    if (r < 48) return 8736 + (r - 32);
    if (r < 112) return 10800 + (r - 48);
    return -1;
}
struct WtDesc { const float* src; bf16_t* dst; const float* ks; int ld, K, k0, n0, mode; };
DI void wt_load(const WtDesc& d, int tid, f32x4 (&v)[2]) {
    const int kk = tid >> 4, c4 = (tid & 15) * 4;
    int sc = d.n0 + c4; if (d.mode == 1) sc = win_src(sc);
    if (d.mode == 2) sc = ((sc >> 7) & 7) * 256 + (sc >> 10) * 128 + (sc & 127);
#pragma unroll
    for (int p = 0; p < 2; ++p) { const int k = kk + 32 * p;
        v[p] = (f32x4){0.f, 0.f, 0.f, 0.f}; if (sc >= 0) v[p] = *(const f32x4*)(d.src + (size_t)(d.k0 + k) * d.ld + sc);
        if (d.ks) v[p] = v[p] * d.ks[d.k0 + k]; }
}
DI void wt_to_lds(int tid, const f32x4 (&v)[2], LAS float* scr) {
    const int kk = tid >> 4, c4 = (tid & 15) * 4;
#pragma unroll
    for (int p = 0; p < 2; ++p) { const int k = kk + 32 * p;
        scr[k * 65 + c4] = v[p][0]; scr[k * 65 + c4 + 1] = v[p][1]; scr[k * 65 + c4 + 2] = v[p][2]; scr[k * 65 + c4 + 3] = v[p][3]; }
}
DI void wt_write(const WtDesc& d, int tid, LAS float* scr) {
    const int n = tid >> 3, c = tid & 7; const LAS float* s = scr + (8 * c) * 65 + n;
    u32x4 o; o.x = pk2(s[0], s[65]); o.y = pk2(s[2 * 65], s[3 * 65]); o.z = pk2(s[4 * 65], s[5 * 65]); o.w = pk2(s[6 * 65], s[7 * 65]);
    *(u32x4*)(d.dst + (size_t)(d.n0 + n) * d.K + d.k0 + 8 * c) = o;
}
DI void bt_item(const bf16_t* src, bf16_t* dst, size_t rowbase, int rowlen, int pos0, LAS bf16_t* scr) {
    const int tid = otid(), a = tid >> 3, c8 = (tid & 7) * 8;
    *(LAS bf16x8*)(scr + a * 72 + c8) = *(const bf16x8*)(src + (size_t)a * NP1 + c8);
    __syncthreads();
    { u32x4 o; const LAS bf16_t* s = scr + c8 * 72 + a;
      o.x = (unsigned)s[0] | ((unsigned)s[72] << 16); o.y = (unsigned)s[2 * 72] | ((unsigned)s[3 * 72] << 16);
      o.z = (unsigned)s[4 * 72] | ((unsigned)s[5 * 72] << 16); o.w = (unsigned)s[6 * 72] | ((unsigned)s[7 * 72] << 16);
      *(u32x4*)(dst + (rowbase + a) * (size_t)rowlen + pos0 + c8) = o; }
    __syncthreads();
}
DI void rms_row_to_bf16(const float* xr, const float* w, bf16_t* o, int lane) {
    f32x4 v[8]; float s = 0.f;
#pragma unroll
    for (int j = 0; j < 8; ++j) { v[j] = ((const f32x4*)xr)[lane + 64 * j]; s += v[j][0] * v[j][0] + v[j][1] * v[j][1] + v[j][2] * v[j][2] + v[j][3] * v[j][3]; }
    const float r = rsqrtf(wave_sum(s) * (1.f / 2048.f) + EPS);
#pragma unroll
    for (int j = 0; j < 8; ++j) { const f32x4 ww = ((const f32x4*)w)[lane + 64 * j]; *(u32x2*)(o + (size_t)(lane + 64 * j) * 4) = pack4(v[j] * ww * r); }
}

template <int DQK, int DV, bool FOX, bool PIPE, bool FASTSM>
DI void attn_unit(LAS unsigned char* lds, int b, int h, int qb, const unsigned char* ws) {
    constexpr int KS = DQK / 32, DT = DV / 16, NH = FOX ? 16 : 8;
    constexpr int KROWB = DQK * 2, CPR = DQK / 8, KB = 64 * KROWB, VB = DV * 128, FB = FOX ? 2048 : 0, SLOT = KB + VB + FB;
    constexpr int NS = FOX ? 4 : 3, NKI = KB / 8192, NVI = VB / 8192, PER = NKI + NVI + (FOX ? 1 : 0);
    static_assert(NS * SLOT <= MISC_OFF, "attention LDS");
    const bf16_t* P1 = (const bf16_t*)(ws + O_P1); const bf16_t* QM = (const bf16_t*)(ws + O_QM); const float* FCUM = (const float*)(ws + O_FCUM);
    const float* CS = (const float*)(ws + O_CS); const float* SN = (const float*)(ws + O_SN); bf16_t* OUT = (bf16_t*)(ws + O_OUT);
    const int tid = otid(), wave = __builtin_amdgcn_readfirstlane(tid >> 6), lane = tid & 63, r16 = lane & 15, fq = lane >> 4;
    const float sc2 = (FOX ? 0.125f : 0.07216878364870322f) * LOG2E;
    const int tq0 = b * S_ + qb * 256 + wave * 32;
    const int q0 = qb * 256 + wave * 32;
    bf16x8 qf[KS][2]; float Fq2[2] = {0.f, 0.f};
#pragma unroll
    for (int nq = 0; nq < 2; ++nq) {
        const int t = tq0 + nq * 16 + r16;
        if constexpr (FOX) {
#pragma unroll
            for (int ks = 0; ks < KS; ++ks) qf[ks][nq] = ld16(P1 + (size_t)t * NP1 + C_FQ + h * 64 + ks * 32 + fq * 8);
            Fq2[nq] = FCUM[(size_t)(b * 16 + h) * S_ + q0 + nq * 16 + r16];
        } else {
#pragma unroll
            for (int ks = 0; ks < KS; ++ks) qf[ks][nq] = ld16(QM + (size_t)t * 1536 + h * 192 + ks * 32 + fq * 8);
            float r4[8], r5[8], o4[8], o5[8]; unpack8(qf[4][nq], r4); unpack8(qf[5][nq], r5);
            const f32x4 c0 = *(const f32x4*)(CS + (size_t)t * 32 + fq * 8), c1 = *(const f32x4*)(CS + (size_t)t * 32 + fq * 8 + 4);
            const f32x4 s0 = *(const f32x4*)(SN + (size_t)t * 32 + fq * 8), s1 = *(const f32x4*)(SN + (size_t)t * 32 + fq * 8 + 4);
#pragma unroll
            for (int j = 0; j < 8; ++j) { const float c = j < 4 ? c0[j & 3] : c1[j & 3], s = j < 4 ? s0[j & 3] : s1[j & 3];
                o4[j] = r4[j] * c - r5[j] * s; o5[j] = r4[j] * s + r5[j] * c; }
            qf[4][nq] = pack8(o4); qf[5][nq] = pack8(o5);
        }
    }
    f32x4 oacc[DT][2];
#pragma unroll
    for (int d = 0; d < DT; ++d) { oacc[d][0] = (f32x4){0.f, 0.f, 0.f, 0.f}; oacc[d][1] = (f32x4){0.f, 0.f, 0.f, 0.f}; }
    float mrow[2] = {-INFINITY, -INFINITY}, lsum[2] = {0.f, 0.f};
    const int ntiles = 4 * qb + 4;
    int kt0 = 0;
    if constexpr (FOX) {
        const unsigned* nm = (const unsigned*)(ws + O_CTL) + 256 + (b * 16 + h) * 2;
        const float smax2 = sqrtf(__uint_as_float(nm[0]) * __uint_as_float(nm[1])) * sc2, thr = -(2.f * smax2 + 40.f);
        const float f0 = FCUM[(size_t)(b * 16 + h) * S_ + qb * 256];
        const bool skip = (lane < 4 * qb) && (f0 - FCUM[(size_t)(b * 16 + h) * S_ + lane * 64 + 63] < thr);
        const unsigned long long mk = __ballot(skip);
        kt0 = __builtin_amdgcn_readfirstlane((int)__builtin_ctzll(~mk));
    }
    unsigned kof[NKI], kst[NKI], vof[NVI];
#pragma unroll
    for (int i = 0; i < NKI; ++i) { const int L = (wave + 8 * i) * 64 + lane, r = L / CPR, pos = L % CPR, c = (pos & ~7) | ((pos ^ (r >> 1)) & 7);
        if constexpr (FOX) { kof[i] = (unsigned)(O_P1 + ((size_t)(b * S_ + r) * NP1 + C_FK + h * 64 + c * 8) * 2); kst[i] = 64u * NP1 * 2u; }
        else if (c < 16) { kof[i] = (unsigned)(O_KN + ((size_t)(b * S_ + r) * 1024 + h * 128 + c * 8) * 2); kst[i] = 64u * 1024u * 2u; }
        else { kof[i] = (unsigned)(O_KROPE + ((size_t)(b * S_ + r) * 64 + (c - 16) * 8) * 2); kst[i] = 64u * 64u * 2u; } }
#pragma unroll
    for (int i = 0; i < NVI; ++i) { const int L = (wave + 8 * i) * 64 + lane, dv = L >> 3, pos = L & 7, c = pos ^ ((dv >> 1) & 7);
        vof[i] = (unsigned)((FOX ? O_VTF : O_VTM) + (((size_t)(b * NH + h) * DV + dv) * S_ + c * 8) * 2); }
    const unsigned fof = (unsigned)(O_FCUM + ((size_t)(b * 16 + h) * S_ + lane) * 4);
    int klo[2], vlo[2][2];
#pragma unroll
    for (int p = 0; p < 2; ++p) klo[p] = r16 * KROWB + (((p * 4 + fq) ^ ((r16 >> 1) & 7)) * 16);
#pragma unroll
    for (int ss = 0; ss < 2; ++ss)
#pragma unroll
        for (int q = 0; q < 2; ++q) vlo[ss][q] = KB + r16 * 128 + (((4 * ss + (fq >> 1) + 2 * q) ^ ((r16 >> 1) & 7)) * 16) + 8 * (fq & 1);
#define ATT_ISSUE(kt) do { LAS unsigned char* sp = lds + ((kt) % NS) * SLOT; \
        _Pragma("unroll") for (int i = 0; i < NKI; ++i) __builtin_amdgcn_global_load_lds((const unsigned*)(ws + (kof[i] + (unsigned)(kt) * kst[i])), (LAS unsigned*)(sp + (wave + 8 * i) * 1024), 16, 0, 0); \
        _Pragma("unroll") for (int i = 0; i < NVI; ++i) __builtin_amdgcn_global_load_lds((const unsigned*)(ws + (vof[i] + (unsigned)(kt) * 128u)), (LAS unsigned*)(sp + KB + (wave + 8 * i) * 1024), 16, 0, 0); \
        if constexpr (FOX) __builtin_amdgcn_global_load_lds((const unsigned*)(ws + (fof + (unsigned)(kt) * 256u)), (LAS unsigned*)(sp + KB + VB + wave * 256), 4, 0, 0); } while (0)
#define ATT_S(kt_, SA) do { const LAS unsigned char* bp = lds + ((kt_) % NS) * SLOT; \
        _Pragma("unroll") for (int mt = 0; mt < 4; ++mt) { SA[mt][0] = (f32x4){0.f, 0.f, 0.f, 0.f}; SA[mt][1] = (f32x4){0.f, 0.f, 0.f, 0.f}; } \
        bf16x8 kf[2][4]; \
        _Pragma("unroll") for (int mt = 0; mt < 4; ++mt) kf[0][mt] = *(const LAS bf16x8*)(bp + klo[0] + (mt * 16 * KROWB)); \
        _Pragma("unroll") for (int ks = 0; ks < KS; ++ks) { \
            if (ks + 1 < KS) { _Pragma("unroll") for (int mt = 0; mt < 4; ++mt) kf[(ks + 1) & 1][mt] = *(const LAS bf16x8*)(bp + klo[(ks + 1) & 1] + (mt * 16 * KROWB + ((ks + 1) >> 1) * 128)); } \
            _Pragma("unroll") for (int mt = 0; mt < 4; ++mt) { SA[mt][0] = MFMA16(kf[ks & 1][mt], qf[ks][0], SA[mt][0]); SA[mt][1] = MFMA16(kf[ks & 1][mt], qf[ks][1], SA[mt][1]); } \
            if (!PIPE) __builtin_amdgcn_sched_barrier(0); } } while (0)
#define ATT_SOFTMAX_(kt_, SA, MASKED) do { const LAS unsigned char* bp = lds + ((kt_) % NS) * SLOT; \
        _Pragma("unroll") for (int nq = 0; nq < 2; ++nq) { \
            const int qpos = q0 + nq * 16 + r16; float mx = -INFINITY; \
            _Pragma("unroll") for (int mt = 0; mt < 4; ++mt) { f32x4 fk = {0.f, 0.f, 0.f, 0.f}; if constexpr (FOX) fk = *(const LAS f32x4*)(bp + KB + VB + wave * 256 + (mt * 16 + fq * 4) * 4); \
                _Pragma("unroll") for (int j = 0; j < 4; ++j) { float x = FOX ? SA[mt][nq][j] * sc2 + (Fq2[nq] - fk[j]) : SA[mt][nq][j] * sc2; \
                    if (MASKED) { const int kpos = (kt_) * 64 + mt * 16 + fq * 4 + j; x = (kpos <= qpos) ? x : -INFINITY; } \
                    SA[mt][nq][j] = x; mx = fmaxf(mx, x); } } \
            mx = xmax_fq(mx); \
            const float mnew = fmaxf(mrow[nq], mx), alpha = __builtin_amdgcn_exp2f(mrow[nq] - mnew); mrow[nq] = mnew; \
            float ps = 0.f; \
            _Pragma("unroll") for (int mt = 0; mt < 4; ++mt) _Pragma("unroll") for (int j = 0; j < 4; ++j) { const float p = __builtin_amdgcn_exp2f(SA[mt][nq][j] - mnew); SA[mt][nq][j] = p; ps += p; } \
            lsum[nq] = lsum[nq] * alpha + ps; \
            _Pragma("unroll") for (int d = 0; d < DT; ++d) oacc[d][nq] = oacc[d][nq] * alpha; \
            pb[0][nq] = pack44(SA[0][nq], SA[1][nq]); pb[1][nq] = pack44(SA[2][nq], SA[3][nq]); } } while (0)
#define ATT_SOFTMAX_F(kt_, SA) do { const LAS unsigned char* bp = lds + ((kt_) % NS) * SLOT; float dlt[2], rmx[2]; \
        _Pragma("unroll") for (int nq = 0; nq < 2; ++nq) { float mx = -INFINITY; \
            _Pragma("unroll") for (int mt = 0; mt < 4; ++mt) { \
                if constexpr (FOX) { const f32x4 fk = *(const LAS f32x4*)(bp + KB + VB + wave * 256 + (mt * 16 + fq * 4) * 4); \
                    _Pragma("unroll") for (int j = 0; j < 4; ++j) SA[mt][nq][j] = SA[mt][nq][j] * sc2 - fk[j]; } \
                _Pragma("unroll") for (int j = 0; j < 4; ++j) mx = fmaxf(mx, SA[mt][nq][j]); } \
            mx = xmax_fq(mx); \
            rmx[nq] = FOX ? mx + Fq2[nq] : mx * sc2; dlt[nq] = rmx[nq] - mrow[nq]; } \
        const bool fast = __all((dlt[0] <= 8.f) && (dlt[1] <= 8.f)); \
        _Pragma("unroll") for (int nq = 0; nq < 2; ++nq) { \
            const float mnew = fast ? mrow[nq] : fmaxf(mrow[nq], rmx[nq]); \
            const float alpha = __builtin_amdgcn_exp2f(mrow[nq] - mnew); \
            const float cc = FOX ? Fq2[nq] - mnew : -mnew; mrow[nq] = mnew; float ps = 0.f; \
            _Pragma("unroll") for (int mt = 0; mt < 4; ++mt) _Pragma("unroll") for (int j = 0; j < 4; ++j) { \
                const float p = __builtin_amdgcn_exp2f(FOX ? SA[mt][nq][j] + cc : SA[mt][nq][j] * sc2 + cc); SA[mt][nq][j] = p; ps += p; } \
            lsum[nq] = lsum[nq] * alpha + ps; \
            pb[0][nq] = pack44(SA[0][nq], SA[1][nq]); pb[1][nq] = pack44(SA[2][nq], SA[3][nq]); \
            if (!fast) { _Pragma("unroll") for (int d = 0; d < DT; ++d) oacc[d][nq] = oacc[d][nq] * alpha; } } \
        } while (0)
#define ATT_SOFTMAX(kt_, SA) do { if ((kt_) * 64 + 63 > q0) ATT_SOFTMAX_(kt_, SA, true); else if constexpr (FASTSM) ATT_SOFTMAX_F(kt_, SA); else ATT_SOFTMAX_(kt_, SA, false); } while (0)
#define ATT_PV(kt_) do { const LAS unsigned char* bp = lds + ((kt_) % NS) * SLOT; constexpr int NG = 2 * DT / 4; \
        s16x4 vl[2][4], vh[2][4]; \
        _Pragma("unroll") for (int q = 0; q < 4; ++q) { vl[0][q] = *(const LAS s16x4*)(bp + vlo[0][0] + q * 2048); vh[0][q] = *(const LAS s16x4*)(bp + vlo[0][1] + q * 2048); } \
        _Pragma("unroll") for (int g = 0; g < NG; ++g) { \
            if (g + 1 < NG) { const int ss1 = ((g + 1) * 4) / DT, d1 = ((g + 1) * 4) % DT; \
                _Pragma("unroll") for (int q = 0; q < 4; ++q) { vl[(g + 1) & 1][q] = *(const LAS s16x4*)(bp + vlo[ss1][0] + (d1 + q) * 2048); vh[(g + 1) & 1][q] = *(const LAS s16x4*)(bp + vlo[ss1][1] + (d1 + q) * 2048); } } \
            const int ss = (g * 4) / DT, d0 = (g * 4) % DT; \
            _Pragma("unroll") for (int q = 0; q < 4; ++q) { const bf16x8 vf = __builtin_shufflevector(vl[g & 1][q], vh[g & 1][q], 0, 1, 2, 3, 4, 5, 6, 7); \
                oacc[d0 + q][0] = MFMA16(vf, pb[ss][0], oacc[d0 + q][0]); oacc[d0 + q][1] = MFMA16(vf, pb[ss][1], oacc[d0 + q][1]); } \
            __builtin_amdgcn_sched_barrier(0); } } while (0)
#define ATT_BAR() do { asm volatile("s_waitcnt lgkmcnt(0)" ::: "memory"); __builtin_amdgcn_s_barrier(); asm volatile("" ::: "memory"); } while (0)
#pragma unroll
    for (int p = 0; p < NS - 1; ++p) ATT_ISSUE(kt0 + p);
    bf16x8 pb[2][2];
    if constexpr (PIPE) {
        static_assert(!PIPE || NS == 4, "pipelined form needs a 4-slot ring");
        asm volatile("s_waitcnt vmcnt(%0)" :: "n"(2 * PER) : "memory");
        ATT_BAR();
        f32x4 sA[4][2];
        ATT_S(kt0, sA);
        for (int kt = kt0; kt < ntiles; ++kt) {
            if (kt + 2 < ntiles) asm volatile("s_waitcnt vmcnt(%0)" :: "n"(PER) : "memory");
            else asm volatile("s_waitcnt vmcnt(0)" ::: "memory");
            ATT_BAR();
            if (kt + 3 < ntiles) ATT_ISSUE(kt + 3);
            const bool a0 = (kt * 64 <= q0 + 31), a1 = (kt + 1 < ntiles) && ((kt + 1) * 64 <= q0 + 31);
            if (a1) {
                f32x4 sB[4][2];
                if (kt * 64 + 63 > q0) { ATT_S(kt + 1, sB); ATT_SOFTMAX_(kt, sA, true); }
                else { ATT_S(kt + 1, sB); if constexpr (FASTSM) ATT_SOFTMAX_F(kt, sA); else ATT_SOFTMAX_(kt, sA, false); }
                ATT_PV(kt);
#pragma unroll
                for (int mt = 0; mt < 4; ++mt) { sA[mt][0] = sB[mt][0]; sA[mt][1] = sB[mt][1]; }
            } else if (a0) {
                ATT_SOFTMAX(kt, sA);
                ATT_PV(kt);
            }
        }
    } else {
        for (int kt = 0; kt < ntiles; ++kt) {
            if (kt + NS - 2 < ntiles) asm volatile("s_waitcnt vmcnt(%0)" :: "n"((NS - 2) * PER) : "memory");
            else asm volatile("s_waitcnt vmcnt(0)" ::: "memory");
            ATT_BAR();
            if (kt + NS - 1 < ntiles) ATT_ISSUE(kt + NS - 1);
            if (kt * 64 <= q0 + 31) {
                f32x4 sA[4][2];
                ATT_S(kt, sA);
                ATT_SOFTMAX(kt, sA);
                ATT_PV(kt);
            }
        }
    }
#undef ATT_S
#undef ATT_SOFTMAX
#undef ATT_SOFTMAX_
#undef ATT_SOFTMAX_F
#undef ATT_PV
#undef ATT_BAR
#undef ATT_ISSUE
#pragma unroll
    for (int nq = 0; nq < 2; ++nq) {
        float l = lsum[nq]; l += __shfl_xor(l, 16); l += __shfl_xor(l, 32); const float inv = 1.f / l;
        const int t = tq0 + nq * 16 + r16;
#pragma unroll
        for (int d = 0; d < DT; ++d) { const int dv0 = d * 16 + fq * 4;
            const f32x4 g = unpack4(*(const u32x2*)(P1 + (size_t)t * NP1 + (FOX ? C_FG : C_LG) + h * DV + dv0));
            f32x4 o = oacc[d][nq] * inv; o = (f32x4){o[0] * silu(g[0]), o[1] * silu(g[1]), o[2] * silu(g[2]), o[3] * silu(g[3])};
            *(u32x2*)(OUT + ((size_t)(FOX ? 1 : 3) * T_ + t) * 1024 + h * DV + dv0) = pack4(o); }
    }
}

#define XB_TMO      128
#define XB_XCNT(j)  (256  + 64 * (j))
#define XB_XSUB(j)  (1280 + 64 * (j))
#define XB_XGEN(j)  (2304 + 64 * (j))
#define XB_TOP      3328
#define XB_TOPGEN   3392
#define XCD_BAR_WORDS 3456
#define XB_SPIN_CAP (1u << 18)

DI unsigned xb_ld(unsigned* p)              { return __hip_atomic_load(p, __ATOMIC_RELAXED, __HIP_MEMORY_SCOPE_AGENT); }
DI unsigned xb_add(unsigned* p, unsigned v) { return __hip_atomic_fetch_add(p, v, __ATOMIC_RELAXED, __HIP_MEMORY_SCOPE_AGENT); }
DI unsigned xb_xcc_id() { return (unsigned)__builtin_amdgcn_s_getreg((3 << 11) | 20) & 0xFu; }
#define XB_SPIN(cond, bar) do { unsigned _sp = 0; while (cond) { __builtin_amdgcn_s_sleep(1); \
    if ((++_sp & 255u) == 0u) { if (xb_ld(&(bar)[XB_TMO])) break; if (_sp > XB_SPIN_CAP) { atomicAdd(&(bar)[XB_TMO], 1u); break; } } } } while (0)

struct XcdBarrier {
    unsigned* bar; unsigned x;
    volatile LAS unsigned* st;
};

DI XcdBarrier xcd_barrier_post(unsigned* bar, volatile LAS unsigned* st) {
    XcdBarrier b; b.bar = bar; b.x = xb_xcc_id(); b.st = st;
    if (threadIdx.x == 0) (void)xb_add(&bar[XB_XCNT(b.x)], 1u);
    return b;
}
DI void xcd_barrier_complete(unsigned* bar, unsigned x, unsigned& nloc, unsigned& nx) {
    const unsigned G = gridDim.x * gridDim.y * gridDim.z;
    unsigned sum, cnt, mine, sp = 0u;
    for (;;) {
        sum = 0u; cnt = 0u; mine = 0u;
#pragma unroll
        for (unsigned j = 0; j < 16; ++j) { const unsigned c = xb_ld(&bar[XB_XCNT(j)]); sum += c; cnt += (c > 0u) ? 1u : 0u; mine = (j == x) ? c : mine; }
        if (sum == G) break;
        __builtin_amdgcn_s_sleep(1);
        if ((++sp & 255u) == 0u) { if (xb_ld(&bar[XB_TMO])) break; if (sp > XB_SPIN_CAP) { atomicAdd(&bar[XB_TMO], 1u); break; } }
    }
    nloc = mine > 0u ? mine : 1u; nx = cnt > 0u ? cnt : 1u;
}

DI void xcd_barrier(const XcdBarrier& b) {
    asm volatile("s_waitcnt vmcnt(0)" ::: "memory");
    __syncthreads();
    if (threadIdx.x == 0) {
        unsigned* bar = b.bar;
        __builtin_amdgcn_s_waitcnt(0);
        unsigned nloc = b.st[0], nx = b.st[1];
        if (nloc == 0u) { xcd_barrier_complete(bar, b.x, nloc, nx); b.st[0] = nloc; b.st[1] = nx; }
        const unsigned old = xb_add(&bar[XB_XSUB(b.x)], 1u);
        const unsigned gen = old / nloc;
        if (old + 1u == (gen + 1u) * nloc) {
            __builtin_amdgcn_fence(__ATOMIC_RELEASE, "agent");
            asm volatile("s_waitcnt vmcnt(0)" ::: "memory");
            const unsigned og = xb_add(&bar[XB_TOP], 1u);
            const unsigned tg = og / nx;
            if (og + 1u == (tg + 1u) * nx) xb_add(&bar[XB_TOPGEN], 1u);
            else XB_SPIN(xb_ld(&bar[XB_TOPGEN]) == tg, bar);
            __builtin_amdgcn_fence(__ATOMIC_ACQUIRE, "agent");
            xb_add(&bar[XB_XGEN(b.x)], 1u);
            asm volatile("s_waitcnt vmcnt(0)" ::: "memory");
        } else {
            XB_SPIN(xb_ld(&bar[XB_XGEN(b.x)]) == gen, bar);
            __builtin_amdgcn_fence(__ATOMIC_ACQUIRE, "agent");
            asm volatile("s_waitcnt vmcnt(0)" ::: "memory");
        }
    }
    __syncthreads();
}


typedef const __attribute__((address_space(4))) unsigned char* kaptr_t;
DI const void* kaload(int off) { kaptr_t ka = (kaptr_t)__builtin_amdgcn_kernarg_segment_ptr(); asm volatile("" : "+s"(ka)); typedef const void* cvp_t; return *(const __attribute__((address_space(4))) cvp_t*)(ka + off); }
#define INP(k) ((const float*)kaload(8 * (k)))
#define x_in INP(0)
#define positions ((const int*)kaload(8))
#define pre_norm INP(2)
#define post_norm INP(3)
#define w_in INP(4)
#define conv_w INP(5)
#define conv_b INP(6)
#define dt_bias INP(7)
#define a_log INP(8)
#define d_skip INP(9)
#define ssm_norm INP(10)
#define fgate_b INP(11)
#define gla_w2 INP(12)
#define gla_b INP(13)
#define gla_norm INP(14)
#define q_norm INP(15)
#define kv_norm INP(16)
#define w_uq INP(17)
#define w_ukv INP(18)
#define w_branch INP(19)
#define w_out INP(20)
#define CTL ((unsigned*)(ws + O_CTL))
#define SSQ ((float*)(ws + O_SSQ))
#define DTV ((float*)(ws + O_DT))
#define ACUM ((float*)(ws + O_ACUM))
#define FCUM ((float*)(ws + O_FCUM))
#define CS ((float*)(ws + O_CS))
#define SN ((float*)(ws + O_SN))
#define KROPE ((bf16_t*)(ws + O_KROPE))
#define BLAST ((float*)(ws + O_BLAST))
#define PS ((float*)(ws + O_PSMALL))
#define WBT ((bf16_t*)(ws + O_WBT))
#define WOT ((bf16_t*)(ws + O_WOT))
#define WUQT ((bf16_t*)(ws + O_WUQT))
#define WUKVT ((bf16_t*)(ws + O_WUKVT))
#define P1 ((bf16_t*)(ws + O_P1))
#define PM ((bf16_t*)(ws + O_PM))
#define OUT ((bf16_t*)(ws + O_OUT))
#define WINT ((bf16_t*)(ws + O_WINT))
#define H ((bf16_t*)(ws + O_H))
#define GST ((bf16_t*)(ws + O_GST))
#define QM ((bf16_t*)(ws + O_QM))
#define KN ((bf16_t*)(ws + O_KN))
#define VTM ((bf16_t*)(ws + O_VTM))
#define VTF ((bf16_t*)(ws + O_VTF))
#define XBC ((bf16_t*)(ws + O_XBC))
#define XBCT ((bf16_t*)(ws + O_XBCT))
#define SST ((bf16_t*)(ws + O_SST))
#define KTT ((bf16_t*)(ws + O_KTT))
#define VTG ((bf16_t*)(ws + O_VTG))
#define MIXF ((float*)(ws + O_MIXF))
#define MIXB ((bf16_t*)(ws + O_MIXB))
#define Y ((float*)(ws + O_Y))
DI void phase_body(const int ph, LAS unsigned char* lds, const int rep = 0) {
    LAS float* scrf = (LAS float*)lds; LAS bf16_t* scrb = (LAS bf16_t*)lds;
    {
        const int l = ph == 0 ? 0 : (ph - 1) >> 3, kph = ph == 0 ? -1 : (ph - 1) & 7;
        unsigned char* ws = (unsigned char*)kaload(176);
        float* const outp = (float*)kaload(168);
        const int tid = otid(), lane = tid & 63, wave = __builtin_amdgcn_readfirstlane(tid >> 6), r16 = lane & 15, fq = lane >> 4;
        const int G = osg(gridDim.x), bid = osg(blockIdx.x);
        unsigned* ctr = CTL + 16 + ph + 32 * rep;
        if ((kph == -1 || kph == 7) && (PHMASK & 0x100)) {
            const int lw = (kph == -1) ? 0 : l + 1;
            if (kph == -1) {
                if (bid == 0 && tid < 128) CTL[tid] = 0u;
                const int NI = 2 * (2048 + 1024 + 192 + 256);
#define WT_DECODE(it_, d_) do { const int ll = (it_) / 3520; int r = (it_) % 3520; \
                    if (r < 2048) { const int br = r / 512, q = r % 512; d_ = WtDesc{w_branch + (size_t)(ll * 4 + br) * 1024 * 2048, WBT + ((size_t)ll * 8192 + br * 2048) * 1024, nullptr, 2048, 1024, (q % 16) * 64, (q / 16) * 64, 0}; } \
                    else if (r < 3072) { r -= 2048; d_ = WtDesc{w_out + (size_t)ll * 2048 * 2048, WOT + (size_t)ll * 2048 * 2048, nullptr, 2048, 2048, (r % 32) * 64, (r / 32) * 64, 0}; } \
                    else if (r < 3264) { r -= 3072; d_ = WtDesc{w_uq + (size_t)ll * 512 * 1536, WUQT + (size_t)ll * 1536 * 512, q_norm + ll * 512, 1536, 512, (r % 8) * 64, (r / 8) * 64, 0}; } \
                    else { r -= 3264; d_ = WtDesc{w_ukv + (size_t)ll * 512 * 2048, WUKVT + (size_t)ll * 2048 * 512, kv_norm + ll * 512, 2048, 512, (r % 8) * 64, (r / 8) * 64, 2}; } } while (0)
                { int it = bid; WtDesc d{}; f32x4 v[2];
                  if (it < NI) { WT_DECODE(it, d); wt_load(d, tid, v); }
                  while (it < NI) {
                      wt_to_lds(tid, v, scrf); __syncthreads();
                      const int nx = it + G; WtDesc dn{}; if (nx < NI) { WT_DECODE(nx, dn); wt_load(dn, tid, v); }
                      wt_write(d, tid, scrf); __syncthreads();
                      d = dn; it = nx; } }
#undef WT_DECODE
                for (int row = bid * 8 + wave; row < T_; row += G * 8) rms_row_to_bf16(x_in + (size_t)row * DM, pre_norm, H + (size_t)row * DM, lane);
            } else {
                const float* xsrc = (l == 0) ? x_in : outp;
                for (int row = bid * 8 + wave; row < T_; row += G * 8) {
                    f32x4 v[8]; float s = 0.f;
#pragma unroll
                    for (int j = 0; j < 8; ++j) { v[j] = ((const f32x4*)(Y + (size_t)row * DM))[lane + 64 * j]; s += v[j][0] * v[j][0] + v[j][1] * v[j][1] + v[j][2] * v[j][2] + v[j][3] * v[j][3]; }
                    const float r = rsqrtf(wave_sum(s) * (1.f / 2048.f) + EPS); float s2 = 0.f;
#pragma unroll
                    for (int j = 0; j < 8; ++j) { const f32x4 pw = ((const f32x4*)(post_norm + l * DM))[lane + 64 * j]; const f32x4 xv = ((const f32x4*)(xsrc + (size_t)row * DM))[lane + 64 * j];
                        v[j] = xv + v[j] * pw * r; ((f32x4*)(outp + (size_t)row * DM))[lane + 64 * j] = v[j]; s2 += v[j][0] * v[j][0] + v[j][1] * v[j][1] + v[j][2] * v[j][2] + v[j][3] * v[j][3]; }
                    if (l == 0) { const float r2 = rsqrtf(wave_sum(s2) * (1.f / 2048.f) + EPS);
#pragma unroll
                        for (int j = 0; j < 8; ++j) { const f32x4 ww = ((const f32x4*)(pre_norm + DM))[lane + 64 * j]; *(u32x2*)(H + (size_t)row * DM + (size_t)(lane + 64 * j) * 4) = pack4(v[j] * ww * r2); } }
                }
            }
            if (lw < 2) {
                if (bid == 0 && tid < 128) CTL[256 + tid] = 0u;
                { int it = bid; const int NI = 316 * 32; const float* wsrc = w_in + (size_t)lw * 2048 * NIN; bf16_t* wdst = WINT; WtDesc d{}; f32x4 v[2];
                  if (it < NI) { d = WtDesc{wsrc, wdst, nullptr, NIN, 2048, (it % 32) * 64, (it / 32) * 64, 1}; wt_load(d, tid, v); }
                  while (it < NI) {
                      wt_to_lds(tid, v, scrf); __syncthreads();
                      const int nx = it + G; WtDesc dn{}; if (nx < NI) { dn = WtDesc{wsrc, wdst, nullptr, NIN, 2048, (nx % 32) * 64, (nx / 32) * 64, 1}; wt_load(dn, tid, v); }
                      wt_write(d, tid, scrf); __syncthreads();
                      d = dn; it = nx; } }
            }
        } else if (kph == 0 && (PHMASK >> 0 & 1)) {
            pg8::ProjOrder S{(const char*)H, (const char*)WINT, G, bid};
            pg8::EpiProj E{P1, PM, PS, rep ? nullptr : SSQ, VTF, VTG};
            pg8::gemm_phase(lds, 2048, 2048, 2048, S, E);
        } else if (kph == 1 && (PHMASK >> 1 & 1)) {
#ifndef NO_M1GEMM
            { pg8::MlaOrder S{(const char*)P1, (const char*)(WUQT + (size_t)l * 1536 * 512), (const char*)(WUKVT + (size_t)l * 2048 * 512), G, bid};
              pg8::EpiMla E{SSQ, QM, KN};
              pg8::gemm_phase(lds, 512, NP1, 512, S, E); }
            { pg8::MlaVOrder S{(const char*)P1, (const char*)(WUKVT + ((size_t)l * 2048 + 1024) * 512), G, bid};
              pg8::EpiMlaV E{SSQ, VTM};
              pg8::gemm_phase(lds, 512, 512, NP1, S, E); }
#endif
            constexpr int N_C = 8, N_A = 384, N_E = 256, N_B = 128, N_N = 256, N_D = 1024;
            constexpr int NTOT = N_C + N_A + N_E + N_B + N_N + N_D;
            for (;;) {
                int it = next_item(ctr, lds); if (it >= NTOT) break;
                if (it < N_C) { LANEIDS
                    const int b = it >> 1, h = (it & 1) * 8 + wave; const float fb = fgate_b[l * 16 + h]; float carry = 0.f;
                    for (int j = 0; j < 64; ++j) { const int s = j * 64 + lane;
                        float v = logsig(PS[(size_t)(b * S_ + s) * 128 + 16 + h] + fb);
#pragma unroll
                        for (int o = 1; o < 64; o <<= 1) { const float y = __shfl_up(v, o); if (lane >= o) v += y; }
                        v += carry; FCUM[(size_t)(b * 16 + h) * S_ + s] = v * LOG2E; carry = __shfl(v, 63); }
                    continue; }
                it -= N_C;
                if (it < N_A) { LANEIDS
                    const int cgp = it % 3, bc = it / 3, ch = cgp * 512 + tid, t0 = bc * 128; const bool first = (bc & 31) == 0;
                    const float w0 = conv_w[(size_t)l * 4 * 1536 + ch], w1 = conv_w[(size_t)l * 4 * 1536 + 1536 + ch], w2 = conv_w[(size_t)l * 4 * 1536 + 2 * 1536 + ch], w3 = conv_w[(size_t)l * 4 * 1536 + 3 * 1536 + ch];
                    const float cb = conv_b[l * 1536 + ch];
                    float xm3 = 0.f, xm2 = 0.f, xm1 = 0.f;
                    if (!first) { xm3 = bf1(P1[(size_t)(t0 - 3) * NP1 + C_XBC + ch]); xm2 = bf1(P1[(size_t)(t0 - 2) * NP1 + C_XBC + ch]); xm1 = bf1(P1[(size_t)(t0 - 1) * NP1 + C_XBC + ch]); }
                    for (int l8 = 0; l8 < 16; ++l8) { float o8[8];
#pragma unroll
                        for (int i = 0; i < 8; ++i) { const int t = t0 + l8 * 8 + i; const float xin = bf1(P1[(size_t)t * NP1 + C_XBC + ch]);
                            const float y = cb + w0 * xm3 + w1 * xm2 + w2 * xm1 + w3 * xin; const float a = silu(y); o8[i] = a;
                            XBC[(size_t)t * 1536 + ch] = (bf16_t)f2bf(a); xm3 = xm2; xm2 = xm1; xm1 = xin; }
                        if (ch < 1280) *(bf16x8*)(XBCT + ((size_t)bc * 1280 + ch) * 128 + l8 * 8) = pack8(o8); }
                    continue; }
                it -= N_A;
                if (it < N_E) { LANEIDS
                    const int col = tid, t0 = it * 64; float w2r[16];
#pragma unroll
                    for (int r = 0; r < 16; ++r) w2r[r] = gla_w2[(size_t)l * 16 * 512 + r * 512 + col];
                    const float gb = gla_b[l * 512 + col]; float cum = 0.f;
                    for (int j8 = 0; j8 < 8; ++j8) { float k8[8];
#pragma unroll
                        for (int i = 0; i < 8; ++i) { const int t = t0 + j8 * 8 + i; float z = gb;
#pragma unroll
                            for (int r = 0; r < 16; ++r) z += PS[(size_t)t * 128 + 32 + r] * w2r[r];
                            cum += logsig(z) * (1.f / 16.f);
                            bf16_t* qp = P1 + (size_t)t * NP1 + C_GQ + col; bf16_t* kp = P1 + (size_t)t * NP1 + C_GK + col;
                            const float qt = bf1(*qp) * 0.08838834764831845f * __expf(cum), kt = bf1(*kp) * __expf(-cum);
                            *qp = (bf16_t)f2bf(qt); *kp = (bf16_t)f2bf(kt); k8[i] = kt; }
                        *(bf16x8*)(KTT + ((size_t)it * 512 + col) * 64 + j8 * 8) = pack8(k8); }
                    BLAST[(size_t)it * 512 + col] = cum;
                    continue; }
                it -= N_E;
                if (it < N_B) { LANEIDS
                    const int t0 = it * 128;
#pragma unroll
                    for (int hh = 0; hh < 2; ++hh) { const int h = wave * 2 + hh; const float a = -__expf(a_log[l * 16 + h]), db = dt_bias[l * 16 + h];
                        const float d0 = softplus_(PS[(size_t)(t0 + 2 * lane) * 128 + h] + db), d1 = softplus_(PS[(size_t)(t0 + 2 * lane + 1) * 128 + h] + db);
                        const float c0 = d0 * a, c1 = c0 + d1 * a; float v = c1;
#pragma unroll
                        for (int o = 1; o < 64; o <<= 1) { const float y = __shfl_up(v, o); if (lane >= o) v += y; }
                        const float pre = v - c1;
                        DTV[(size_t)(t0 + 2 * lane) * 16 + h] = d0; DTV[(size_t)(t0 + 2 * lane + 1) * 16 + h] = d1;
                        ACUM[(size_t)(t0 + 2 * lane) * 16 + h] = pre + c0; ACUM[(size_t)(t0 + 2 * lane + 1) * 16 + h] = pre + c1; }
                    continue; }
                it -= N_B;
                if (it < N_N) { LANEIDS
                    const int hh = tid & 15, t0 = it * 64, b = t0 >> 12; float qm = 0.f, km = 0.f;
#pragma unroll
                    for (int p = 0; p < 2; ++p) { const int t = t0 + p * 32 + (tid >> 4); float qs = 0.f, ks = 0.f;
#pragma unroll
                        for (int c = 0; c < 8; ++c) { float a[8], k8[8]; unpack8(ld16(P1 + (size_t)t * NP1 + C_FQ + hh * 64 + c * 8), a); unpack8(ld16(P1 + (size_t)t * NP1 + C_FK + hh * 64 + c * 8), k8);
#pragma unroll
                            for (int e = 0; e < 8; ++e) { qs += a[e] * a[e]; ks += k8[e] * k8[e]; } }
                        qm = fmaxf(qm, qs); km = fmaxf(km, ks); }
                    qm = fmaxf(qm, __shfl_xor(qm, 16)); qm = fmaxf(qm, __shfl_xor(qm, 32)); km = fmaxf(km, __shfl_xor(km, 16)); km = fmaxf(km, __shfl_xor(km, 32));
                    if (lane < 16) { atomicMax(CTL + 256 + (b * 16 + hh) * 2, __float_as_uint(qm)); atomicMax(CTL + 256 + (b * 16 + hh) * 2 + 1, __float_as_uint(km)); }
                    continue; }
                it -= N_N;
                { LANEIDS
                    const int t = it * 16 + (tid >> 5), j = tid & 31;
                    const float invf = exp2f(-(float)j * 0.41524101186092029f);
                    const float ang = (float)positions[t] * invf;
                    double rev = (double)ang * 0.15915494309189535; rev -= floor(rev + 0.5);
                    const float fr_ = (float)rev; const float c = __builtin_amdgcn_cosf(fr_), s = __builtin_amdgcn_sinf(fr_);
                    CS[(size_t)t * 32 + j] = c; SN[(size_t)t * 32 + j] = s;
                    const float lo = PS[(size_t)t * 128 + 48 + j], hi = PS[(size_t)t * 128 + 80 + j];
                    KROPE[(size_t)t * 64 + j] = (bf16_t)f2bf(lo * c - hi * s); KROPE[(size_t)t * 64 + 32 + j] = (bf16_t)f2bf(lo * s + hi * c);
                    continue; }
            }
        } else if (kph == 2 && (PHMASK >> 2 & 1)) {
            constexpr int N_M = 512, N_X = 1024, N_S = 2048, N_K = 1024, NTOT = N_M + N_X + N_S + N_K;
            for (;;) {
                int it = next_item(ctr, lds); if (it >= NTOT) break;
                if (it < N_M) { const int qb = 15 - (it >> 5), rem = it & 31;
                    attn_unit<192, 128, false, false, MLA_FAST>(lds, rem >> 3, rem & 7, qb, ws); continue; }
                it -= N_M;
                if (it < N_X) { const int qb = 15 - (it >> 6), rem = it & 63;
                    attn_unit<64, 64, true, true, FOX_FAST>(lds, rem >> 4, rem & 15, qb, ws); continue; }
                it -= N_X;
                if (it < N_S) { LANEIDS
                    const int h = it & 15, chunk = it >> 4, t0 = chunk * 128, g = h >> 3;
                    const float alast = ACUM[(size_t)(t0 + 127) * 16 + h];
                    f32x4 acc[4];
#pragma unroll
                    for (int p = 0; p < 4; ++p) acc[p] = (f32x4){0.f, 0.f, 0.f, 0.f};
#pragma unroll
                    for (int ks = 0; ks < 4; ++ks) {
                        float bv[8]; unpack8(ld16(XBCT + ((size_t)chunk * 1280 + 1024 + g * 128 + 16 * wave + r16) * 128 + ks * 32 + fq * 8), bv);
#pragma unroll
                        for (int i = 0; i < 8; ++i) { const int tl = t0 + ks * 32 + fq * 8 + i; bv[i] *= DTV[(size_t)tl * 16 + h] * __expf(alast - ACUM[(size_t)tl * 16 + h]); }
                        const bf16x8 bw = pack8(bv);
#pragma unroll
                        for (int p = 0; p < 4; ++p) acc[p] = MFMA16(bw, ld16(XBCT + ((size_t)chunk * 1280 + h * 64 + 16 * p + r16) * 128 + ks * 32 + fq * 8), acc[p]);
                    }
#pragma unroll
                    for (int p = 0; p < 4; ++p) *(u32x2*)(SST + ((size_t)chunk * 16 + h) * 8192 + (16 * p + r16) * 128 + 16 * wave + 4 * fq) = pack4(acc[p]);
                    continue; }
                it -= N_S;
                { LANEIDS
                    const int gc = it >> 2, h = it & 3, b = gc >> 6, c = gc & 63, bh = b * 4 + h;
                    bf16x8 kf[2];
#pragma unroll
                    for (int ks = 0; ks < 2; ++ks) kf[ks] = ld16(KTT + ((size_t)gc * 512 + h * 128 + 16 * wave + r16) * 64 + ks * 32 + fq * 8);
                    const f32x4 eb = *(const f32x4*)(BLAST + (size_t)gc * 512 + h * 128 + 16 * wave + 4 * fq);
                    const f32x4 ee = {__expf(eb[0]), __expf(eb[1]), __expf(eb[2]), __expf(eb[3])};
#pragma unroll 4
                    for (int et = 0; et < 16; ++et) { f32x4 acc = {0.f, 0.f, 0.f, 0.f};
#pragma unroll
                        for (int ks = 0; ks < 2; ++ks) acc = MFMA16(kf[ks], ld16(VTG + ((size_t)gc * 1024 + h * 256 + 16 * et + r16) * 64 + ks * 32 + fq * 8), acc);
                        *(u32x2*)(GST + (((size_t)bh * 64 + c) * 256 + 16 * et + r16) * 128 + 16 * wave + 4 * fq) = pack4(acc * ee); }
                }
            }
        } else if (kph == 3 && (PHMASK >> 3 & 1)) {
            for (int it = bid; it < 256; it += G) {
                if (it < 128) { const int e8 = (it * 512 + tid) * 8, bh = e8 >> 13, off = e8 & 8191, b = bh >> 4, h = bh & 15;
                    float st[8];
#pragma unroll
                    for (int i = 0; i < 8; ++i) st[i] = 0.f;
                    for (int cg8 = 0; cg8 < 4; ++cg8) { bf16x8 vv[8]; float dec[8];
#pragma unroll
                        for (int q = 0; q < 8; ++q) { const int c = cg8 * 8 + q; vv[q] = *(const bf16x8*)(SST + ((size_t)(b * 32 + c) * 16 + h) * 8192 + off); dec[q] = ACUM[(size_t)(b * S_ + c * 128 + 127) * 16 + h]; }
#pragma unroll
                        for (int q = 0; q < 8; ++q) { const int c = cg8 * 8 + q; float v[8]; unpack8(vv[q], v); const float d = __expf(dec[q]);
                            *(bf16x8*)(SST + ((size_t)(b * 32 + c) * 16 + h) * 8192 + off) = pack8(st);
#pragma unroll
                            for (int i = 0; i < 8; ++i) st[i] = st[i] * d + v[i]; } }
                } else { const int e8 = ((it - 128) * 512 + tid) * 8, bh = e8 >> 15, off = e8 & 32767, d0 = off & 127, b = bh >> 2, h = bh & 3;
                    float st[8];
#pragma unroll
                    for (int i = 0; i < 8; ++i) st[i] = 0.f;
                    for (int cg8 = 0; cg8 < 8; ++cg8) { bf16x8 vv[8]; f32x4 e0[8], e1[8];
#pragma unroll
                        for (int q = 0; q < 8; ++q) { const int c = cg8 * 8 + q; vv[q] = *(const bf16x8*)(GST + ((size_t)bh * 64 + c) * 32768 + off);
                            e0[q] = *(const f32x4*)(BLAST + (size_t)(b * 64 + c) * 512 + h * 128 + d0); e1[q] = *(const f32x4*)(BLAST + (size_t)(b * 64 + c) * 512 + h * 128 + d0 + 4); }
#pragma unroll
                        for (int q = 0; q < 8; ++q) { const int c = cg8 * 8 + q; float v[8]; unpack8(vv[q], v);
                            *(bf16x8*)(GST + ((size_t)bh * 64 + c) * 32768 + off) = pack8(st);
#pragma unroll
                            for (int i = 0; i < 8; ++i) st[i] = st[i] * __expf(i < 4 ? e0[q][i & 3] : e1[q][i & 3]) + v[i]; } }
                }
            }
        } else if (kph == 4 && (PHMASK >> 4 & 1)) {
            constexpr int N_S = 256, N_G = 1024, NTOT = N_S + N_G;
            for (;;) {
                int it = next_item(ctr, lds); if (it >= NTOT) break;
                if (it < N_S) { LANEIDS
                    const int g = it & 1, chunk = it >> 1, t0 = chunk * 128;
                    LAS float* sAc = (LAS float*)lds; LAS float* sDt = sAc + 1024;
                    for (int i = tid; i < 1024; i += 512) { const int hh = i >> 7, s = i & 127; sAc[i] = ACUM[(size_t)(t0 + s) * 16 + g * 8 + hh]; sDt[i] = DTV[(size_t)(t0 + s) * 16 + g * 8 + hh]; }
                    __syncthreads();
                    const int tl = t0 + 16 * wave + r16, lpos = 16 * wave + r16;
                    bf16x8 cf[4];
#pragma unroll
                    for (int ks = 0; ks < 4; ++ks) cf[ks] = ld16(XBC + (size_t)tl * 1536 + 1280 + g * 128 + ks * 32 + fq * 8);
                    f32x4 gacc[8];
#pragma unroll
                    for (int mt = 0; mt < 8; ++mt) { gacc[mt] = (f32x4){0.f, 0.f, 0.f, 0.f};
                        if (mt <= wave) {
#pragma unroll
                            for (int ks = 0; ks < 4; ++ks) gacc[mt] = MFMA16(ld16(XBC + (size_t)(t0 + 16 * mt + r16) * 1536 + 1024 + g * 128 + ks * 32 + fq * 8), cf[ks], gacc[mt]); } }
                    float ssq = 0.f;
#pragma unroll 2
                    for (int hh = 0; hh < 8; ++hh) { const int h = g * 8 + hh;
                        const float al = sAc[hh * 128 + lpos], el = __expf(al);
                        f32x4 acc1[4], acc2[4];
#pragma unroll
                        for (int p = 0; p < 4; ++p) { acc1[p] = (f32x4){0.f, 0.f, 0.f, 0.f}; acc2[p] = (f32x4){0.f, 0.f, 0.f, 0.f}; }
#pragma unroll
                        for (int ss = 0; ss < 4; ++ss) if (2 * ss <= wave) {
                            f32x4 wv[2];
#pragma unroll
                            for (int q = 0; q < 2; ++q) { const int mt = 2 * ss + q; const f32x4 as = *(const LAS f32x4*)(sAc + hh * 128 + 16 * mt + 4 * fq), ds = *(const LAS f32x4*)(sDt + hh * 128 + 16 * mt + 4 * fq);
#pragma unroll
                                for (int j = 0; j < 4; ++j) { const int spos = 16 * mt + 4 * fq + j; wv[q][j] = (spos <= lpos) ? gacc[mt][j] * __expf(fminf(al - as[j], 0.f)) * ds[j] : 0.f; } }
                            const bf16x8 wp = pack44(wv[0], wv[1]);
#pragma unroll
                            for (int p = 0; p < 4; ++p) { const bf16_t* xp = XBCT + ((size_t)chunk * 1280 + h * 64 + 16 * p + r16) * 128 + 32 * ss + 4 * fq;
                                acc1[p] = MFMA16(ld8x2(xp, xp + 16), wp, acc1[p]); }
                        }
#pragma unroll
                        for (int ks = 0; ks < 4; ++ks)
#pragma unroll
                            for (int p = 0; p < 4; ++p) acc2[p] = MFMA16(ld16(SST + ((size_t)chunk * 16 + h) * 8192 + (16 * p + r16) * 128 + ks * 32 + fq * 8), cf[ks], acc2[p]);
                        const float dsk = d_skip[l * 16 + h];
#pragma unroll
                        for (int p = 0; p < 4; ++p) { const int pc = h * 64 + 16 * p + 4 * fq;
                            const f32x4 xv = unpack4(*(const u32x2*)(XBC + (size_t)tl * 1536 + pc)), zv = unpack4(*(const u32x2*)(P1 + (size_t)tl * NP1 + C_MZ + pc));
                            f32x4 y = acc1[p] + acc2[p] * el + xv * dsk;
                            y = (f32x4){y[0] * silu(zv[0]), y[1] * silu(zv[1]), y[2] * silu(zv[2]), y[3] * silu(zv[3])};
                            ssq += y[0] * y[0] + y[1] * y[1] + y[2] * y[2] + y[3] * y[3];
                            *(u32x2*)(OUT + (size_t)tl * 1024 + pc) = pack4(y); }
                    }
                    ssq += __shfl_xor(ssq, 16); ssq += __shfl_xor(ssq, 32);
                    const float rs = rsqrtf(ssq * (1.f / 512.f) + EPS);
                    asm volatile("s_waitcnt vmcnt(0)" ::: "memory");
                    for (int hh = 0; hh < 8; ++hh)
#pragma unroll
                        for (int p = 0; p < 4; ++p) { const int pc = (g * 8 + hh) * 64 + 16 * p + 4 * fq; bf16_t* op = OUT + (size_t)tl * 1024 + pc;
                            const f32x4 nw = *(const f32x4*)(ssm_norm + l * 1024 + pc); *(u32x2*)op = pack4(unpack4(*(const u32x2*)op) * nw * rs); }
                    continue; }
                it -= N_S;
                { LANEIDS
                    const int gc = it >> 2, h = it & 3, b = gc >> 6, c = gc & 63, bh = b * 4 + h, t0 = gc * 64;
                    const int itl = wave & 3, eh = wave >> 2, ti = t0 + 16 * itl + r16, ipos = 16 * itl + r16;
                    LAS float* sSS = (LAS float*)(lds + MISC_OFF + 64);
                    bf16x8 qf[4];
#pragma unroll
                    for (int ks = 0; ks < 4; ++ks) qf[ks] = ld16(P1 + (size_t)ti * NP1 + C_GQ + h * 128 + ks * 32 + fq * 8);
                    f32x4 aacc[4];
#pragma unroll
                    for (int mt = 0; mt < 4; ++mt) { aacc[mt] = (f32x4){0.f, 0.f, 0.f, 0.f};
                        if (mt <= itl) {
#pragma unroll
                            for (int ks = 0; ks < 4; ++ks) aacc[mt] = MFMA16(ld16(P1 + (size_t)(t0 + 16 * mt + r16) * NP1 + C_GK + h * 128 + ks * 32 + fq * 8), qf[ks], aacc[mt]);
#pragma unroll
                            for (int j = 0; j < 4; ++j) if (16 * mt + 4 * fq + j > ipos) aacc[mt][j] = 0.f; } }
                    bf16x8 wp[2]; wp[0] = pack44(aacc[0], aacc[1]); wp[1] = pack44(aacc[2], aacc[3]);
                    f32x4 oacc[8]; float ssq = 0.f;
#pragma unroll
                    for (int et = 0; et < 8; ++et) { const int e = 16 * (8 * eh + et) + r16; f32x4 o = {0.f, 0.f, 0.f, 0.f};
#pragma unroll
                        for (int ss = 0; ss < 2; ++ss) if (2 * ss <= itl) { const bf16_t* vp = VTG + ((size_t)gc * 1024 + h * 256 + e) * 64 + 32 * ss + 4 * fq; o = MFMA16(ld8x2(vp, vp + 16), wp[ss], o); }
#pragma unroll
                        for (int ks = 0; ks < 4; ++ks) o = MFMA16(ld16(GST + (((size_t)bh * 64 + c) * 256 + e) * 128 + ks * 32 + fq * 8), qf[ks], o);
                        oacc[et] = o; ssq += o[0] * o[0] + o[1] * o[1] + o[2] * o[2] + o[3] * o[3]; }
                    ssq += __shfl_xor(ssq, 16); ssq += __shfl_xor(ssq, 32);
                    if (fq == 0) sSS[eh * 64 + ipos] = ssq;
                    __syncthreads();
                    const float rs = rsqrtf((sSS[ipos] + sSS[64 + ipos]) * (1.f / 256.f) + EPS);
#pragma unroll
                    for (int et = 0; et < 8; ++et) { const int e0 = 16 * (8 * eh + et) + 4 * fq;
                        const f32x4 gv = unpack4(*(const u32x2*)(P1 + (size_t)ti * NP1 + C_GG + h * 256 + e0)), nw = *(const f32x4*)(gla_norm + l * 256 + e0);
                        f32x4 o = oacc[et] * nw * rs; o = (f32x4){o[0] * silu(gv[0]), o[1] * silu(gv[1]), o[2] * silu(gv[2]), o[3] * silu(gv[3])};
                        *(u32x2*)(OUT + ((size_t)2 * T_ + ti) * 1024 + h * 256 + e0) = pack4(o); }
                }
            }
        } else if (kph == 5 && (PHMASK >> 5 & 1)) {
            pg8::MergeOrder S{(const char*)OUT, (const char*)(WBT + (size_t)l * 8192 * 1024), G, bid};
            pg8::EpiMerge E{PM, MIXF, MIXB};
            pg8::gemm_phase(lds, 1024, 1024, 1024, S, E);
        } else if (kph == 6 && (PHMASK >> 6 & 1)) {
            pg8::PlainOrder S{(const char*)MIXB, (const char*)(WOT + (size_t)l * 2048 * 2048), 64, 8, G, bid, (size_t)256 * 2048 * 2, (size_t)256 * 2048 * 2};
            pg8::EpiOut E{Y};
            pg8::gemm_phase(lds, 2048, 2048, 2048, S, E);
        }
    }
}
__global__ void __launch_bounds__(512, 2) mk_fwd(Args args) {
    extern __shared__ __attribute__((aligned(16))) unsigned char lds_raw[];
    LAS unsigned char* lds = (LAS unsigned char*)lds_raw;
    const int lo = args.ph_lo, hi = args.ph_hi;
    volatile LAS unsigned* xst = (volatile LAS unsigned*)(lds + MISC_OFF + 16);
    if (threadIdx.x == 0) { xst[0] = 0u; xst[1] = 0u; }
    __syncthreads();
    XcdBarrier xb; xb.bar = (unsigned*)(args.ws + O_CTL) + 4096; xb.x = 0; xb.st = xst;
    if (hi - lo > 1) xb = xcd_barrier_post((unsigned*)(args.ws + O_CTL) + 4096, xst);
#define SEAM(k) do { if ((k) == 0) cg::this_grid().sync(); else xcd_barrier(xb); } while (0)
#define PH(k) if (lo <= (k) && (k) < hi) { phase_body((k), lds); if ((k) > 0 && (((k) - 1) & 7) == REP_KPH) { cg::this_grid().sync(); phase_body((k), lds, 1); } if ((k) + 1 < hi) SEAM(k); }
    PH(0) PH(1) PH(2) PH(3) PH(4) PH(5) PH(6) PH(7) PH(8) PH(9) PH(10) PH(11) PH(12) PH(13) PH(14) PH(15) PH(16)
#undef PH
#undef SEAM
}

extern "C" void kernel_launch(void* const* d_in, const int* in_sizes, int n_in, void* d_out, int out_size, void* d_ws, size_t ws_size, hipStream_t stream) {
    static int grid = 0;
    if (grid == 0) {
        if (n_in != 21 || ws_size < WS_END) { fprintf(stderr, "kernel_launch: unexpected n_in %d or ws_size %zu (< %zu)\n", n_in, ws_size, (size_t)WS_END); }
        int dev = 0, cus = 0, per_cu = 0;
        hipGetDevice(&dev); hipDeviceGetAttribute(&cus, hipDeviceAttributeMultiprocessorCount, dev);
        hipFuncSetAttribute((const void*)mk_fwd, hipFuncAttributeMaxDynamicSharedMemorySize, LDS_BYTES);
        hipOccupancyMaxActiveBlocksPerMultiprocessor(&per_cu, (const void*)mk_fwd, 512, LDS_BYTES);
        if (per_cu < 1) { fprintf(stderr, "kernel_launch: occupancy query says %d blocks/CU\n", per_cu); per_cu = 1; }
        (void)hipGetLastError();
        grid = cus * 1;
        if (grid <= 0) grid = 256;
    }
    Args a{};
    for (int i = 0; i < 21; ++i) a.in[i] = d_in[i];
    a.out = (float*)d_out; a.ws = (unsigned char*)d_ws;
#if MK_SINGLE
    a.ph_lo = 0; a.ph_hi = NPHASE;
    (void)hipMemsetAsync((char*)d_ws + O_CTL + 4096 * 4, 0, XCD_BAR_WORDS * 4, stream);
    void* kargs[] = {&a};
    hipError_t e = hipLaunchCooperativeKernel((const void*)mk_fwd, dim3(grid), dim3(512), kargs, LDS_BYTES, stream);
    if (e != hipSuccess) fprintf(stderr, "cooperative launch failed: %s (grid %d)\n", hipGetErrorString(e), grid);
#else
    for (int ph = 0; ph < NPHASE; ++ph) { a.ph_lo = ph; a.ph_hi = ph + 1;
        hipLaunchKernelGGL(mk_fwd, dim3(grid), dim3(512), LDS_BYTES, stream, a); }
#endif
}
```

```cpp
#include <hip/hip_runtime.h>
#include <hip/hip_cooperative_groups.h>
#include <cstdio>
#include <cstdint>
namespace cg = cooperative_groups;

#ifndef PHMASK
#define PHMASK 0x1ff
#endif
#ifndef MLA_FAST
#define MLA_FAST false
#endif
#ifndef FOX_FAST
#define FOX_FAST true
#endif
#ifndef REP_KPH
#define REP_KPH -2
#endif
#ifndef MK_SINGLE
#define MK_SINGLE 1
#endif

#define LAS __attribute__((address_space(3)))
#define DI __device__ __forceinline__
typedef unsigned short bf16_t;
typedef short bf16x8 __attribute__((ext_vector_type(8)));
typedef short s16x4 __attribute__((ext_vector_type(4)));
typedef float f32x4 __attribute__((ext_vector_type(4)));
typedef unsigned u32x4 __attribute__((ext_vector_type(4)));
typedef unsigned u32x2 __attribute__((ext_vector_type(2)));
#define MFMA16(a, b, c) __builtin_amdgcn_mfma_f32_16x16x32_bf16((a), (b), (c), 0, 0, 0)

constexpr int T_ = 16384, S_ = 4096, DM = 2048;
constexpr int NIN = 20080, NP1 = 11776, NPM = 8192, NW1 = 20224;
constexpr int C_MZ = 0, C_XBC = 1024, C_FQ = 2560, C_FK = 3584, C_FV = 4608, C_FG = 5632, C_GQ = 6656, C_GK = 7168, C_GV = 7680,
              C_GG = 8704, C_LCQ = 9728, C_LCKV = 10240, C_LG = 10752;
constexpr float EPS = 1e-6f;
constexpr float LOG2E = 1.4426950408889634f;

constexpr size_t MiB = 1u << 20;
constexpr size_t O_CTL = 0;
constexpr size_t O_SSQ = 1 * MiB;
constexpr size_t O_DT = 2 * MiB;
constexpr size_t O_ACUM = 3 * MiB;
constexpr size_t O_FCUM = 4 * MiB;
constexpr size_t O_CS = 5 * MiB;
constexpr size_t O_SN = 7 * MiB;
constexpr size_t O_KROPE = 9 * MiB;
constexpr size_t O_BLAST = 11 * MiB;
constexpr size_t O_PSMALL = 12 * MiB;
constexpr size_t O_WBT = 20 * MiB;
constexpr size_t O_WOT = 52 * MiB;
constexpr size_t O_WUQT = 68 * MiB;
constexpr size_t O_WUKVT = 71 * MiB;
constexpr size_t O_P1 = 75 * MiB;
constexpr size_t O_PM = 443 * MiB;
constexpr size_t O_OUT = 699 * MiB;
constexpr size_t O_WINT = O_OUT;
constexpr size_t O_H = 827 * MiB;
constexpr size_t O_GST = O_H;
constexpr size_t O_QM = 891 * MiB;
constexpr size_t O_KN = 939 * MiB;
constexpr size_t O_VTM = 971 * MiB;
constexpr size_t O_VTF = 1003 * MiB;
constexpr size_t O_XBC = 1035 * MiB;
constexpr size_t O_XBCT = 1083 * MiB;
constexpr size_t O_SST = 1123 * MiB;
constexpr size_t O_KTT = 1155 * MiB;
constexpr size_t O_VTG = 1171 * MiB;
constexpr size_t WS_END = 1203 * MiB;
constexpr size_t O_MIXF = O_P1;
constexpr size_t O_MIXB = O_P1 + 128 * MiB;
constexpr size_t O_Y = O_P1 + 192 * MiB;

constexpr int LDS_BYTES = 135168;
constexpr int MISC_OFF = 131072;
constexpr int NPHASE = 17;

DI unsigned f2bf(float f) { unsigned u = __float_as_uint(f); return (u + 0x7fffu + ((u >> 16) & 1u)) >> 16; }
typedef float f32x2_t __attribute__((ext_vector_type(2)));
typedef __bf16 bf16x2_t __attribute__((ext_vector_type(2)));
DI unsigned pk2(float lo, float hi) { f32x2_t v = {lo, hi}; bf16x2_t b = __builtin_convertvector(v, bf16x2_t); return __builtin_bit_cast(unsigned, b); }
DI float bflo(unsigned u) { return __uint_as_float(u << 16); }
DI float bfhi(unsigned u) { return __uint_as_float(u & 0xffff0000u); }
DI float bf1(bf16_t b) { return __uint_as_float(((unsigned)b) << 16); }
DI float sigm(float x) { return __builtin_amdgcn_rcpf(1.f + __expf(-x)); }
DI float silu(float x) { return x * __builtin_amdgcn_rcpf(1.f + __expf(-x)); }
DI float softplus_(float x) { return fmaxf(x, 0.f) + log1pf(__expf(-fabsf(x))); }
DI float logsig(float x) { return fminf(x, 0.f) - log1pf(__expf(-fabsf(x))); }
DI float xmax_fq(float x) {
    auto a = __builtin_amdgcn_permlane32_swap(__float_as_uint(x), __float_as_uint(x), false, false);
    x = fmaxf(__uint_as_float(a[0]), __uint_as_float(a[1]));
    auto b = __builtin_amdgcn_permlane16_swap(__float_as_uint(x), __float_as_uint(x), false, false);
    return fmaxf(__uint_as_float(b[0]), __uint_as_float(b[1]));
}
DI float wave_sum(float v) {
#pragma unroll
    for (int o = 1; o < 64; o <<= 1) v += __shfl_xor(v, o);
    return v;
}
DI void unpack8(bf16x8 v, float (&f)[8]) {
    u32x4 u = __builtin_bit_cast(u32x4, v);
    f[0] = bflo(u.x); f[1] = bfhi(u.x); f[2] = bflo(u.y); f[3] = bfhi(u.y); f[4] = bflo(u.z); f[5] = bfhi(u.z); f[6] = bflo(u.w); f[7] = bfhi(u.w);
}
DI bf16x8 pack8(const float (&f)[8]) {
    u32x4 u; u.x = pk2(f[0], f[1]); u.y = pk2(f[2], f[3]); u.z = pk2(f[4], f[5]); u.w = pk2(f[6], f[7]);
    return __builtin_bit_cast(bf16x8, u);
}
DI bf16x8 pack44(f32x4 a, f32x4 b) {
    u32x4 u; u.x = pk2(a[0], a[1]); u.y = pk2(a[2], a[3]); u.z = pk2(b[0], b[1]); u.w = pk2(b[2], b[3]);
    return __builtin_bit_cast(bf16x8, u);
}
DI u32x2 pack4(f32x4 a) { u32x2 u; u.x = pk2(a[0], a[1]); u.y = pk2(a[2], a[3]); return u; }
DI f32x4 unpack4(u32x2 u) { return (f32x4){bflo(u.x), bfhi(u.x), bflo(u.y), bfhi(u.y)}; }
DI bf16x8 ld16(const bf16_t* p) { return *(const bf16x8*)p; }
DI bf16x8 ld8x2(const bf16_t* p0, const bf16_t* p1) {
    s16x4 a = *(const s16x4*)p0, b = *(const s16x4*)p1;
    return __builtin_shufflevector(a, b, 0, 1, 2, 3, 4, 5, 6, 7);
}

DI int otid() { int t = threadIdx.x; asm volatile("" : "+v"(t)); return t; }
#define LANEIDS const int tid = otid(), lane = tid & 63, wave = __builtin_amdgcn_readfirstlane(tid >> 6), r16 = lane & 15, fq = lane >> 4; (void)tid; (void)lane; (void)wave; (void)r16; (void)fq;
DI int osg(int v) { asm volatile("" : "+s"(v)); return v; }
struct Args { const void* in[21]; float* out; unsigned char* ws; int ph_lo, ph_hi; };

DI int next_item(unsigned* ctr, LAS unsigned char* lds) {
    volatile LAS int* s = (volatile LAS int*)(lds + MISC_OFF);
    __syncthreads();
    if (threadIdx.x == 0) *s = (int)atomicAdd(ctr, 1u);
    __syncthreads();
    return *s;
}

namespace pg8 {
constexpr int BM = 256, BK = 64, HALF = 128, HTB = HALF * BK * 2, STAGE_BYTES = 8 * HTB, NXCD = 8, WGM = 8;
DI int lds_byte(int r, int c) { const int st = (r >> 4) * 2 + (c >> 5), rr = r & 15, cc = c & 31, ob = rr * 64 + cc * 2; return st * 1024 + (ob ^ (((ob >> 9) & 1) << 5)); }
DI void stage_rc(int b, int& R, int& C) { const int st = b / 1024, sb = b % 1024, swz = sb ^ (((sb >> 9) & 1) << 5); R = (st >> 1) * 16 + swz / 64; C = (st & 1) * 32 + (swz % 64) / 2; }
DI int perm32(int rho) { const int n = rho >> 4, i = rho & 15; return 8 * (i >> 2) + 4 * n + (i & 3); }

struct Unit { int pm, pn, aux; const char* A; const char* B; };

DI void tile_of(int L, int nM, int nN, int& pm, int& pn) {
    const int nwg = nM * nN; int wgid = L;
    { const int q = nwg / NXCD, r = nwg % NXCD, xcd = wgid % NXCD, off = wgid / NXCD; wgid = (xcd < r ? xcd * (q + 1) : r * (q + 1) + (xcd - r) * q) + off; }
    const int nig = WGM * nN, gid = wgid / nig, fm = gid * WGM, gsz = (nM - fm) < WGM ? (nM - fm) : WGM;
    pm = fm + ((wgid % nig) % gsz); pn = (wgid % nig) / gsz;
}
struct PlainOrder {
    const char* A; const char* B; int nM, nN, G, c; size_t tsA, tsB;
    DI bool next(int i, Unit& u) const {
        const long L = (long)i * G + c; if (L >= (long)nM * nN) return false;
        tile_of((int)L, nM, nN, u.pm, u.pn); u.aux = 0; u.A = A + (size_t)u.pm * tsA; u.B = B + (size_t)u.pn * tsB; return true;
    }
};
struct ProjOrder {
    const char* A; const char* B; int G, c;
    DI bool next(int i, Unit& u) const {
        const long L = (long)i * G + c; if (L >= 64 * 79) return false;
        int pm, pn; tile_of((int)L, 64, 79, pm, pn);
        const size_t ts = (size_t)256 * 2048 * 2;
        const bool fv = (pn >= 18 && pn < 22), gv = (pn >= 30 && pn < 34);
        if (fv || gv) { u.pm = pn; u.pn = pm; u.aux = fv ? 1 : 2; u.A = B + (size_t)pn * ts; u.B = A + (size_t)pm * ts; }
        else { u.pm = pm; u.pn = pn; u.aux = 0; u.A = A + (size_t)pm * ts; u.B = B + (size_t)pn * ts; }
        return true;
    }
};
struct MlaOrder {
    const char* P1; const char* Wq; const char* Wkv; int G, c;
    DI bool next(int i, Unit& u) const {
        const long L = (long)i * G + c; if (L >= 64 * 10) return false;
        const int pm = (int)L / 10, rem = (int)L % 10; u.pm = pm; u.aux = rem;
        if (rem < 6) { u.pn = rem; u.A = P1 + ((size_t)pm * 256 * NP1 + C_LCQ) * 2; u.B = Wq + (size_t)rem * 256 * 512 * 2; }
        else { u.pn = rem - 6; u.A = P1 + ((size_t)pm * 256 * NP1 + C_LCKV) * 2; u.B = Wkv + (size_t)(rem - 6) * 256 * 512 * 2; }
        return true;
    }
};
struct MlaVOrder {
    const char* P1; const char* Wv; int G, c;
    DI bool next(int i, Unit& u) const {
        const long L = (long)i * G + c; if (L >= 256) return false;
        u.pm = (int)L & 3; u.pn = (int)L >> 2; u.aux = 0;
        u.A = Wv + (size_t)u.pm * 256 * 512 * 2; u.B = P1 + ((size_t)u.pn * 256 * NP1 + C_LCKV) * 2; return true;
    }
};
struct MergeOrder {
    const char* OUTp; const char* Wb; int G, c;
    DI bool next(int i, Unit& u) const {
        const int j = i >> 2, br = i & 3; const long L = (long)j * G + c; if (L >= 512) return false;
        tile_of((int)L, 64, 8, u.pm, u.pn); u.aux = br;
        u.A = OUTp + ((size_t)br * T_ + (size_t)u.pm * 256) * 1024 * 2; u.B = Wb + ((size_t)br * 2048 + u.pn * 256) * 1024 * 2; return true;
    }
};

template <class Epi, class Sched>
DI void gemm_phase(LAS unsigned char* lds, const int K, const int lda, const int ldb, const Sched& S, const Epi& E) {
    const int tid = otid(), wid = __builtin_amdgcn_readfirstlane(tid >> 6), lane = tid & 63, wr = wid >> 2, wc = wid & 3, fr = lane & 15, fq = lane >> 4;
    const int nt = K / BK;
    unsigned voffA[2], voffB[2];
#pragma unroll
    for (int i = 0; i < 2; ++i) { int R, C; stage_rc(tid * 16 + i * 8192, R, C); const int Rb = (R & ~31) + perm32(R & 31);
        voffA[i] = (unsigned)(R * lda + C) * 2u; voffB[i] = (unsigned)(Rb * ldb + C) * 2u; }
    const size_t kstep = (size_t)(BK * 2);
    const size_t hstepA = (size_t)HALF * lda * 2, hstepB = (size_t)HALF * ldb * 2;
    const unsigned ldsw = (unsigned)wid * 1024u;
    const int aoff = lds_byte(wr * 64 + fr, fq * 8), boff = lds_byte(wc * 32 + fr, fq * 8);
#define PG8_SA(b, h) (((b) * 2 + (h)) * HTB)
#define PG8_SB(b, h) ((4 + (b) * 2 + (h)) * HTB)
#define PG8_STAGE(bufoff, gbase, voff) do { _Pragma("unroll") for (int _i = 0; _i < 2; ++_i) \
        __builtin_amdgcn_global_load_lds((const unsigned*)((const char*)(gbase) + (voff)[_i]), (LAS unsigned*)(lds + (bufoff) + ldsw + _i * 8192), 16, 0, 0); } while (0)
#define PG8_LDA(dst, b, h) do { _Pragma("unroll") for (int m = 0; m < 4; ++m) _Pragma("unroll") for (int k = 0; k < 2; ++k) dst[m][k] = *(const LAS bf16x8*)(lds + PG8_SA(b, h) + aoff + m * 2048 + k * 1024); } while (0)
#define PG8_LDB(dst, b, h) do { _Pragma("unroll") for (int n = 0; n < 2; ++n) _Pragma("unroll") for (int k = 0; k < 2; ++k) dst[n][k] = *(const LAS bf16x8*)(lds + PG8_SB(b, h) + boff + n * 2048 + k * 1024); } while (0)
#define PG8_MMA(ai, bj, At, Bt) do { __builtin_amdgcn_s_setprio(1); _Pragma("unroll") for (int m = 0; m < 4; ++m) _Pragma("unroll") for (int n = 0; n < 2; ++n) _Pragma("unroll") for (int k = 0; k < 2; ++k) \
        acc[ai][bj][m][n] = __builtin_amdgcn_mfma_f32_16x16x32_bf16(Bt[n][k], At[m][k], acc[ai][bj][m][n], 0, 0, 0); __builtin_amdgcn_s_setprio(0); } while (0)
#define PG8_WAIT_V(n) asm volatile("s_waitcnt vmcnt(" #n ")" ::: "memory")
#define PG8_WAIT_L(n) asm volatile("s_waitcnt lgkmcnt(" #n ")" ::: "memory")
#define PG8_BAR __builtin_amdgcn_s_barrier()
#define PG8_SCHED __builtin_amdgcn_sched_barrier(0)
    Unit cur, nxt; int ui = 0;
    if (!S.next(0, cur)) return;
    f32x4 acc[2][2][4][2];
#pragma unroll
    for (int a = 0; a < 2; ++a)
#pragma unroll
        for (int b = 0; b < 2; ++b)
#pragma unroll
            for (int m = 0; m < 4; ++m)
#pragma unroll
                for (int n = 0; n < 2; ++n) acc[a][b][m][n] = (f32x4){0.f, 0.f, 0.f, 0.f};
    bf16x8 At[4][2], B0[2][2], B1[2][2];
    const char* cA = cur.A; const char* cB = cur.B;
    PG8_STAGE(PG8_SB(0, 0), cB, voffB); PG8_STAGE(PG8_SB(0, 1), cB + hstepB, voffB); PG8_STAGE(PG8_SA(0, 0), cA, voffA); PG8_STAGE(PG8_SA(0, 1), cA + hstepA, voffA);
    if (wr == 1) PG8_BAR;
    PG8_WAIT_V(2); PG8_BAR;
    PG8_STAGE(PG8_SB(1, 0), cB + kstep, voffB); PG8_STAGE(PG8_SA(1, 0), cA + kstep, voffA); PG8_STAGE(PG8_SB(1, 1), cB + hstepB + kstep, voffB);
    PG8_WAIT_V(6); PG8_BAR;
    for (;;) {
        const bool has_next = S.next(ui + 1, nxt);
        const char* nA = has_next ? nxt.A : cA; const char* nB = has_next ? nxt.B : cB;
        for (int t = 0; t < nt; t += 2) {
            const bool last = (t == nt - 2);
            const char* a1 = cA + (size_t)(t + 1) * kstep;
            const char* a2 = last ? nA : cA + (size_t)(t + 2) * kstep; const char* b2 = last ? nB : cB + (size_t)(t + 2) * kstep;
            const char* a3 = a2 + kstep; const char* b3 = b2 + kstep;
            PG8_LDB(B0, 0, 0); PG8_LDB(B1, 0, 1); PG8_SCHED; PG8_LDA(At, 0, 0); PG8_STAGE(PG8_SA(1, 1), a1 + hstepA, voffA);
            PG8_WAIT_V(8); PG8_WAIT_L(0); PG8_BAR; PG8_MMA(0, 0, At, B0); PG8_MMA(0, 1, At, B1); PG8_BAR; PG8_SCHED;
            PG8_LDA(At, 0, 1); PG8_STAGE(PG8_SB(0, 0), b2, voffB); PG8_STAGE(PG8_SB(0, 1), b2 + hstepB, voffB); PG8_STAGE(PG8_SA(0, 0), a2, voffA);
            PG8_WAIT_V(8); PG8_WAIT_L(0); PG8_BAR; PG8_MMA(1, 0, At, B0); PG8_MMA(1, 1, At, B1); PG8_BAR; PG8_SCHED;
            PG8_LDB(B0, 1, 0); PG8_LDB(B1, 1, 1); PG8_SCHED; PG8_LDA(At, 1, 0); PG8_STAGE(PG8_SA(0, 1), a2 + hstepA, voffA);
            PG8_WAIT_V(8); PG8_WAIT_L(0); PG8_BAR; PG8_MMA(0, 0, At, B0); PG8_MMA(0, 1, At, B1); PG8_BAR; PG8_SCHED;
            PG8_LDA(At, 1, 1); PG8_STAGE(PG8_SB(1, 0), b3, voffB); PG8_STAGE(PG8_SB(1, 1), b3 + hstepB, voffB); PG8_STAGE(PG8_SA(1, 0), a3, voffA);
            PG8_WAIT_V(8); PG8_WAIT_L(0); PG8_BAR; PG8_MMA(1, 0, At, B0); PG8_MMA(1, 1, At, B1); PG8_BAR; PG8_SCHED;
        }
        if (wr == 0) PG8_BAR;
        E(acc, cur, wr, wc, fr, fq);
        if (!has_next) break;
#pragma unroll
        for (int a = 0; a < 2; ++a)
#pragma unroll
            for (int b = 0; b < 2; ++b)
#pragma unroll
                for (int m = 0; m < 4; ++m)
#pragma unroll
                    for (int n = 0; n < 2; ++n) acc[a][b][m][n] = (f32x4){0.f, 0.f, 0.f, 0.f};
        cur = nxt; cA = nA; cB = nB; ++ui;
        if (wr == 1) PG8_BAR;
    }
    PG8_WAIT_V(0);
    PG8_BAR;
#undef PG8_SA
#undef PG8_SB
#undef PG8_STAGE
#undef PG8_LDA
#undef PG8_LDB
#undef PG8_MMA
#undef PG8_WAIT_V
#undef PG8_WAIT_L
#undef PG8_BAR
#undef PG8_SCHED
}

#define EPI_LOOP_BEGIN _Pragma("unroll") for (int ai = 0; ai < 2; ++ai) _Pragma("unroll") for (int m = 0; m < 4; ++m) { const int row = u.pm * 256 + ai * 128 + wr * 64 + m * 16 + fr;
#define EPI_BJ_BEGIN _Pragma("unroll") for (int bj = 0; bj < 2; ++bj) { const int lc = bj * 128 + wc * 32 + 8 * fq; const f32x4 v0 = acc[ai][bj][m][0], v1 = acc[ai][bj][m][1];
#define EPI_END __builtin_amdgcn_sched_barrier(0); } }

struct EpiProj {
    bf16_t* P1; bf16_t* PM; float* PS; float* SSQ; bf16_t* VTF; bf16_t* VTG;
    DI void operator()(const f32x4 (&acc)[2][2][4][2], const Unit& u, int wr, int wc, int fr, int fq) const {
        const int pn = u.pn;
        if (u.aux != 0) {
            EPI_LOOP_BEGIN
                EPI_BJ_BEGIN
                    const int tok = u.pn * 256 + lc;
                    if (u.aux == 1) *(bf16x8*)(VTF + ((size_t)(tok >> 12) * 1024 + (row - C_FV)) * 4096 + (tok & 4095)) = pack44(v0, v1);
                    else *(bf16x8*)(VTG + ((size_t)(tok >> 6) * 1024 + (row - C_GV)) * 64 + (tok & 63)) = pack44(v0, v1);
            EPI_END
        } else if (pn < 46) {
            const bool stat = (pn >= 38 && pn < 42);
            EPI_LOOP_BEGIN
                float ss = 0.f;
                EPI_BJ_BEGIN
                    *(bf16x8*)(P1 + (size_t)row * NP1 + pn * 256 + lc) = pack44(v0, v1);
                    ss += v0[0] * v0[0] + v0[1] * v0[1] + v0[2] * v0[2] + v0[3] * v0[3] + v1[0] * v1[0] + v1[1] * v1[1] + v1[2] * v1[2] + v1[3] * v1[3];
                    __builtin_amdgcn_sched_barrier(0);
                }
                if (stat && SSQ) { ss += __shfl_xor(ss, 16); ss += __shfl_xor(ss, 32); if (fq == 0) SSQ[(row * 2 + (pn >= 40 ? 1 : 0)) * 8 + (pn & 1) * 4 + wc] = ss; }
            }
        } else if (pn < 78) {
            EPI_LOOP_BEGIN
                EPI_BJ_BEGIN
                    f32x4 a = {sigm(v0[0]), sigm(v0[1]), sigm(v0[2]), sigm(v0[3])}, b = {sigm(v1[0]), sigm(v1[1]), sigm(v1[2]), sigm(v1[3])};
                    *(bf16x8*)(PM + (size_t)row * NPM + (pn - 46) * 256 + lc) = pack44(a, b);
            EPI_END
        } else {
            EPI_LOOP_BEGIN
                EPI_BJ_BEGIN
                    if (lc < 128) { *(f32x4*)(PS + (size_t)row * 128 + lc) = v0; *(f32x4*)(PS + (size_t)row * 128 + lc + 4) = v1; }
            EPI_END
        }
    }
};
struct EpiMla {
    const float* SSQ; bf16_t* QM; bf16_t* KN;
    DI void operator()(const f32x4 (&acc)[2][2][4][2], const Unit& u, int wr, int wc, int fr, int fq) const {
        const bool isq = u.aux < 6;
        bf16_t* dst = isq ? QM : KN; const int ld = isq ? 1536 : 1024;
#pragma unroll
        for (int ai = 0; ai < 2; ++ai) {
            f32x4 sa[4], sb[4];
#pragma unroll
            for (int m = 0; m < 4; ++m) { const int row = u.pm * 256 + ai * 128 + wr * 64 + m * 16 + fr;
                sa[m] = *(const f32x4*)(SSQ + (row * 2 + (isq ? 0 : 1)) * 8); sb[m] = *(const f32x4*)(SSQ + (row * 2 + (isq ? 0 : 1)) * 8 + 4); }
#pragma unroll
            for (int m = 0; m < 4; ++m) { const int row = u.pm * 256 + ai * 128 + wr * 64 + m * 16 + fr;
                const float rs = rsqrtf((((sa[m][0] + sa[m][1]) + (sa[m][2] + sa[m][3])) + ((sb[m][0] + sb[m][1]) + (sb[m][2] + sb[m][3]))) * (1.f / 512.f) + EPS);
#pragma unroll
                for (int bj = 0; bj < 2; ++bj) { const int lc = bj * 128 + wc * 32 + 8 * fq;
                    *(bf16x8*)(dst + (size_t)row * ld + u.pn * 256 + lc) = pack44(acc[ai][bj][m][0] * rs, acc[ai][bj][m][1] * rs); __builtin_amdgcn_sched_barrier(0); } }
        }
    }
};
struct EpiMlaV {
    const float* SSQ; bf16_t* VTM;
    DI void operator()(const f32x4 (&acc)[2][2][4][2], const Unit& u, int wr, int wc, int fr, int fq) const {
#pragma unroll
        for (int bj = 0; bj < 2; ++bj) { const int tok = u.pn * 256 + bj * 128 + wc * 32 + 8 * fq; const int bb = tok >> 12, s = tok & 4095;
            float rs[8];
#pragma unroll
            for (int e = 0; e < 8; ++e) { const f32x4 sa = *(const f32x4*)(SSQ + ((tok + e) * 2 + 1) * 8), sb = *(const f32x4*)(SSQ + ((tok + e) * 2 + 1) * 8 + 4);
                rs[e] = rsqrtf((((sa[0] + sa[1]) + (sa[2] + sa[3])) + ((sb[0] + sb[1]) + (sb[2] + sb[3]))) * (1.f / 512.f) + EPS); }
#pragma unroll
            for (int ai = 0; ai < 2; ++ai)
#pragma unroll
                for (int m = 0; m < 4; ++m) { const int row = u.pm * 256 + ai * 128 + wr * 64 + m * 16 + fr;
                    const f32x4 v0 = acc[ai][bj][m][0], v1 = acc[ai][bj][m][1];
                    const f32x4 a = {v0[0] * rs[0], v0[1] * rs[1], v0[2] * rs[2], v0[3] * rs[3]}, b = {v1[0] * rs[4], v1[1] * rs[5], v1[2] * rs[6], v1[3] * rs[7]};
                    *(bf16x8*)(VTM + ((size_t)bb * 1024 + row) * 4096 + s) = pack44(a, b); __builtin_amdgcn_sched_barrier(0); } }
    }
};
struct EpiMerge {
    const bf16_t* PM; float* MIXF; bf16_t* MIXB;
    DI void operator()(const f32x4 (&acc)[2][2][4][2], const Unit& u, int wr, int wc, int fr, int fq) const {
        const int br = u.aux;
#pragma unroll
        for (int ai = 0; ai < 2; ++ai) {
            bf16x8 gt[4][2], pv[4][2];
#pragma unroll
            for (int m = 0; m < 4; ++m)
#pragma unroll
                for (int bj = 0; bj < 2; ++bj) { const int row = u.pm * 256 + ai * 128 + wr * 64 + m * 16 + fr, gc = u.pn * 256 + bj * 128 + wc * 32 + 8 * fq;
                    gt[m][bj] = *(const bf16x8*)(PM + (size_t)row * NPM + br * 2048 + gc);
                    if (br != 0) pv[m][bj] = *(const bf16x8*)(MIXB + (size_t)row * 2048 + gc); }
#pragma unroll
            for (int m = 0; m < 4; ++m)
#pragma unroll
                for (int bj = 0; bj < 2; ++bj) { const int row = u.pm * 256 + ai * 128 + wr * 64 + m * 16 + fr, gc = u.pn * 256 + bj * 128 + wc * 32 + 8 * fq;
                    const f32x4 v0 = acc[ai][bj][m][0], v1 = acc[ai][bj][m][1]; float g[8]; unpack8(gt[m][bj], g);
                    f32x4 a = {v0[0] * g[0], v0[1] * g[1], v0[2] * g[2], v0[3] * g[3]}, b = {v1[0] * g[4], v1[1] * g[5], v1[2] * g[6], v1[3] * g[7]};
                    if (br != 0) { float p[8]; unpack8(pv[m][bj], p); a += (f32x4){p[0], p[1], p[2], p[3]}; b += (f32x4){p[4], p[5], p[6], p[7]}; }
                    *(bf16x8*)(MIXB + (size_t)row * 2048 + gc) = pack44(a, b); }
            __builtin_amdgcn_sched_barrier(0);
        }
    }
};
struct EpiOut {
    float* Y;
    DI void operator()(const f32x4 (&acc)[2][2][4][2], const Unit& u, int wr, int wc, int fr, int fq) const {
        EPI_LOOP_BEGIN
            EPI_BJ_BEGIN
                float* yp = Y + (size_t)row * 2048 + u.pn * 256 + lc; *(f32x4*)yp = v0; *(f32x4*)(yp + 4) = v1;
        EPI_END
    }
};
}

DI int win_src(int n) {
    if (n < 2560) return n;
    if (n < 5632) return n + 16;
    if (n < 8704) return n + 32;
    if (n < 10752) return n + 48;
    if (n < 19968) return n + 112;
    const int r = n - 19968;
    if (r < 16) return 2560 + r;
    if (r < 32) return 5648 + (r - 16);
    if (r < 48) return 8736 + (r - 32);
    if (r < 112) return 10800 + (r - 48);
    return -1;
}
struct WtDesc { const float* src; bf16_t* dst; const float* ks; int ld, K, k0, n0, mode; };
DI void wt_load(const WtDesc& d, int tid, f32x4 (&v)[2]) {
    const int kk = tid >> 4, c4 = (tid & 15) * 4;
    int sc = d.n0 + c4; if (d.mode == 1) sc = win_src(sc);
    if (d.mode == 2) sc = ((sc >> 7) & 7) * 256 + (sc >> 10) * 128 + (sc & 127);
#pragma unroll
    for (int p = 0; p < 2; ++p) { const int k = kk + 32 * p;
        v[p] = (f32x4){0.f, 0.f, 0.f, 0.f}; if (sc >= 0) v[p] = *(const f32x4*)(d.src + (size_t)(d.k0 + k) * d.ld + sc);
        if (d.ks) v[p] = v[p] * d.ks[d.k0 + k]; }
}
DI void wt_to_lds(int tid, const f32x4 (&v)[2], LAS float* scr) {
    const int kk = tid >> 4, c4 = (tid & 15) * 4;
#pragma unroll
    for (int p = 0; p < 2; ++p) { const int k = kk + 32 * p;
        scr[k * 65 + c4] = v[p][0]; scr[k * 65 + c4 + 1] = v[p][1]; scr[k * 65 + c4 + 2] = v[p][2]; scr[k * 65 + c4 + 3] = v[p][3]; }
}
DI void wt_write(const WtDesc& d, int tid, LAS float* scr) {
    const int n = tid >> 3, c = tid & 7; const LAS float* s = scr + (8 * c) * 65 + n;
    u32x4 o; o.x = pk2(s[0], s[65]); o.y = pk2(s[2 * 65], s[3 * 65]); o.z = pk2(s[4 * 65], s[5 * 65]); o.w = pk2(s[6 * 65], s[7 * 65]);
    *(u32x4*)(d.dst + (size_t)(d.n0 + n) * d.K + d.k0 + 8 * c) = o;
}
DI void bt_item(const bf16_t* src, bf16_t* dst, size_t rowbase, int rowlen, int pos0, LAS bf16_t* scr) {
    const int tid = otid(), a = tid >> 3, c8 = (tid & 7) * 8;
    *(LAS bf16x8*)(scr + a * 72 + c8) = *(const bf16x8*)(src + (size_t)a * NP1 + c8);
    __syncthreads();
    { u32x4 o; const LAS bf16_t* s = scr + c8 * 72 + a;
      o.x = (unsigned)s[0] | ((unsigned)s[72] << 16); o.y = (unsigned)s[2 * 72] | ((unsigned)s[3 * 72] << 16);
      o.z = (unsigned)s[4 * 72] | ((unsigned)s[5 * 72] << 16); o.w = (unsigned)s[6 * 72] | ((unsigned)s[7 * 72] << 16);
      *(u32x4*)(dst + (rowbase + a) * (size_t)rowlen + pos0 + c8) = o; }
    __syncthreads();
}
DI void rms_row_to_bf16(const float* xr, const float* w, bf16_t* o, int lane) {
    f32x4 v[8]; float s = 0.f;
#pragma unroll
    for (int j = 0; j < 8; ++j) { v[j] = ((const f32x4*)xr)[lane + 64 * j]; s += v[j][0] * v[j][0] + v[j][1] * v[j][1] + v[j][2] * v[j][2] + v[j][3] * v[j][3]; }
    const float r = rsqrtf(wave_sum(s) * (1.f / 2048.f) + EPS);
#pragma unroll
    for (int j = 0; j < 8; ++j) { const f32x4 ww = ((const f32x4*)w)[lane + 64 * j]; *(u32x2*)(o + (size_t)(lane + 64 * j) * 4) = pack4(v[j] * ww * r); }
}

template <int DQK, int DV, bool FOX, bool PIPE, bool FASTSM>
DI void attn_unit(LAS unsigned char* lds, int b, int h, int qb, const unsigned char* ws) {
    constexpr int KS = DQK / 32, DT = DV / 16, NH = FOX ? 16 : 8;
    constexpr int KROWB = DQK * 2, CPR = DQK / 8, KB = 64 * KROWB, VB = DV * 128, FB = FOX ? 2048 : 0, SLOT = KB + VB + FB;
    constexpr int NS = FOX ? 4 : 3, NKI = KB / 8192, NVI = VB / 8192, PER = NKI + NVI + (FOX ? 1 : 0);
    static_assert(NS * SLOT <= MISC_OFF, "attention LDS");
    const bf16_t* P1 = (const bf16_t*)(ws + O_P1); const bf16_t* QM = (const bf16_t*)(ws + O_QM); const float* FCUM = (const float*)(ws + O_FCUM);
    const float* CS = (const float*)(ws + O_CS); const float* SN = (const float*)(ws + O_SN); bf16_t* OUT = (bf16_t*)(ws + O_OUT);
    const int tid = otid(), wave = __builtin_amdgcn_readfirstlane(tid >> 6), lane = tid & 63, r16 = lane & 15, fq = lane >> 4;
    const float sc2 = (FOX ? 0.125f : 0.07216878364870322f) * LOG2E;
    const int tq0 = b * S_ + qb * 256 + wave * 32;
    const int q0 = qb * 256 + wave * 32;
    bf16x8 qf[KS][2]; float Fq2[2] = {0.f, 0.f};
#pragma unroll
    for (int nq = 0; nq < 2; ++nq) {
        const int t = tq0 + nq * 16 + r16;
        if constexpr (FOX) {
#pragma unroll
            for (int ks = 0; ks < KS; ++ks) qf[ks][nq] = ld16(P1 + (size_t)t * NP1 + C_FQ + h * 64 + ks * 32 + fq * 8);
            Fq2[nq] = FCUM[(size_t)(b * 16 + h) * S_ + q0 + nq * 16 + r16];
        } else {
#pragma unroll
            for (int ks = 0; ks < KS; ++ks) qf[ks][nq] = ld16(QM + (size_t)t * 1536 + h * 192 + ks * 32 + fq * 8);
            float r4[8], r5[8], o4[8], o5[8]; unpack8(qf[4][nq], r4); unpack8(qf[5][nq], r5);
            const f32x4 c0 = *(const f32x4*)(CS + (size_t)t * 32 + fq * 8), c1 = *(const f32x4*)(CS + (size_t)t * 32 + fq * 8 + 4);
            const f32x4 s0 = *(const f32x4*)(SN + (size_t)t * 32 + fq * 8), s1 = *(const f32x4*)(SN + (size_t)t * 32 + fq * 8 + 4);
#pragma unroll
            for (int j = 0; j < 8; ++j) { const float c = j < 4 ? c0[j & 3] : c1[j & 3], s = j < 4 ? s0[j & 3] : s1[j & 3];
                o4[j] = r4[j] * c - r5[j] * s; o5[j] = r4[j] * s + r5[j] * c; }
            qf[4][nq] = pack8(o4); qf[5][nq] = pack8(o5);
        }
    }
    f32x4 oacc[DT][2];
#pragma unroll
    for (int d = 0; d < DT; ++d) { oacc[d][0] = (f32x4){0.f, 0.f, 0.f, 0.f}; oacc[d][1] = (f32x4){0.f, 0.f, 0.f, 0.f}; }
    float mrow[2] = {-INFINITY, -INFINITY}, lsum[2] = {0.f, 0.f};
    const int ntiles = 4 * qb + 4;
    int kt0 = 0;
    if constexpr (FOX) {
        const unsigned* nm = (const unsigned*)(ws + O_CTL) + 256 + (b * 16 + h) * 2;
        const float smax2 = sqrtf(__uint_as_float(nm[0]) * __uint_as_float(nm[1])) * sc2, thr = -(2.f * smax2 + 40.f);
        const float f0 = FCUM[(size_t)(b * 16 + h) * S_ + qb * 256];
        const bool skip = (lane < 4 * qb) && (f0 - FCUM[(size_t)(b * 16 + h) * S_ + lane * 64 + 63] < thr);
        const unsigned long long mk = __ballot(skip);
        kt0 = __builtin_amdgcn_readfirstlane((int)__builtin_ctzll(~mk));
    }
    unsigned kof[NKI], kst[NKI], vof[NVI];
#pragma unroll
    for (int i = 0; i < NKI; ++i) { const int L = (wave + 8 * i) * 64 + lane, r = L / CPR, pos = L % CPR, c = (pos & ~7) | ((pos ^ (r >> 1)) & 7);
        if constexpr (FOX) { kof[i] = (unsigned)(O_P1 + ((size_t)(b * S_ + r) * NP1 + C_FK + h * 64 + c * 8) * 2); kst[i] = 64u * NP1 * 2u; }
        else if (c < 16) { kof[i] = (unsigned)(O_KN + ((size_t)(b * S_ + r) * 1024 + h * 128 + c * 8) * 2); kst[i] = 64u * 1024u * 2u; }
        else { kof[i] = (unsigned)(O_KROPE + ((size_t)(b * S_ + r) * 64 + (c - 16) * 8) * 2); kst[i] = 64u * 64u * 2u; } }
#pragma unroll
    for (int i = 0; i < NVI; ++i) { const int L = (wave + 8 * i) * 64 + lane, dv = L >> 3, pos = L & 7, c = pos ^ ((dv >> 1) & 7);
        vof[i] = (unsigned)((FOX ? O_VTF : O_VTM) + (((size_t)(b * NH + h) * DV + dv) * S_ + c * 8) * 2); }
    const unsigned fof = (unsigned)(O_FCUM + ((size_t)(b * 16 + h) * S_ + lane) * 4);
    int klo[2], vlo[2][2];
#pragma unroll
    for (int p = 0; p < 2; ++p) klo[p] = r16 * KROWB + (((p * 4 + fq) ^ ((r16 >> 1) & 7)) * 16);
#pragma unroll
    for (int ss = 0; ss < 2; ++ss)
#pragma unroll
        for (int q = 0; q < 2; ++q) vlo[ss][q] = KB + r16 * 128 + (((4 * ss + (fq >> 1) + 2 * q) ^ ((r16 >> 1) & 7)) * 16) + 8 * (fq & 1);
#define ATT_ISSUE(kt) do { LAS unsigned char* sp = lds + ((kt) % NS) * SLOT; \
        _Pragma("unroll") for (int i = 0; i < NKI; ++i) __builtin_amdgcn_global_load_lds((const unsigned*)(ws + (kof[i] + (unsigned)(kt) * kst[i])), (LAS unsigned*)(sp + (wave + 8 * i) * 1024), 16, 0, 0); \
        _Pragma("unroll") for (int i = 0; i < NVI; ++i) __builtin_amdgcn_global_load_lds((const unsigned*)(ws + (vof[i] + (unsigned)(kt) * 128u)), (LAS unsigned*)(sp + KB + (wave + 8 * i) * 1024), 16, 0, 0); \
        if constexpr (FOX) __builtin_amdgcn_global_load_lds((const unsigned*)(ws + (fof + (unsigned)(kt) * 256u)), (LAS unsigned*)(sp + KB + VB + wave * 256), 4, 0, 0); } while (0)
#define ATT_S(kt_, SA) do { const LAS unsigned char* bp = lds + ((kt_) % NS) * SLOT; \
        _Pragma("unroll") for (int mt = 0; mt < 4; ++mt) { SA[mt][0] = (f32x4){0.f, 0.f, 0.f, 0.f}; SA[mt][1] = (f32x4){0.f, 0.f, 0.f, 0.f}; } \
        bf16x8 kf[2][4]; \
        _Pragma("unroll") for (int mt = 0; mt < 4; ++mt) kf[0][mt] = *(const LAS bf16x8*)(bp + klo[0] + (mt * 16 * KROWB)); \
        _Pragma("unroll") for (int ks = 0; ks < KS; ++ks) { \
            if (ks + 1 < KS) { _Pragma("unroll") for (int mt = 0; mt < 4; ++mt) kf[(ks + 1) & 1][mt] = *(const LAS bf16x8*)(bp + klo[(ks + 1) & 1] + (mt * 16 * KROWB + ((ks + 1) >> 1) * 128)); } \
            _Pragma("unroll") for (int mt = 0; mt < 4; ++mt) { SA[mt][0] = MFMA16(kf[ks & 1][mt], qf[ks][0], SA[mt][0]); SA[mt][1] = MFMA16(kf[ks & 1][mt], qf[ks][1], SA[mt][1]); } \
            if (!PIPE) __builtin_amdgcn_sched_barrier(0); } } while (0)
#define ATT_SOFTMAX_(kt_, SA, MASKED) do { const LAS unsigned char* bp = lds + ((kt_) % NS) * SLOT; \
        _Pragma("unroll") for (int nq = 0; nq < 2; ++nq) { \
            const int qpos = q0 + nq * 16 + r16; float mx = -INFINITY; \
            _Pragma("unroll") for (int mt = 0; mt < 4; ++mt) { f32x4 fk = {0.f, 0.f, 0.f, 0.f}; if constexpr (FOX) fk = *(const LAS f32x4*)(bp + KB + VB + wave * 256 + (mt * 16 + fq * 4) * 4); \
                _Pragma("unroll") for (int j = 0; j < 4; ++j) { float x = FOX ? SA[mt][nq][j] * sc2 + (Fq2[nq] - fk[j]) : SA[mt][nq][j] * sc2; \
                    if (MASKED) { const int kpos = (kt_) * 64 + mt * 16 + fq * 4 + j; x = (kpos <= qpos) ? x : -INFINITY; } \
                    SA[mt][nq][j] = x; mx = fmaxf(mx, x); } } \
            mx = xmax_fq(mx); \
            const float mnew = fmaxf(mrow[nq], mx), alpha = __builtin_amdgcn_exp2f(mrow[nq] - mnew); mrow[nq] = mnew; \
            float ps = 0.f; \
            _Pragma("unroll") for (int mt = 0; mt < 4; ++mt) _Pragma("unroll") for (int j = 0; j < 4; ++j) { const float p = __builtin_amdgcn_exp2f(SA[mt][nq][j] - mnew); SA[mt][nq][j] = p; ps += p; } \
            lsum[nq] = lsum[nq] * alpha + ps; \
            _Pragma("unroll") for (int d = 0; d < DT; ++d) oacc[d][nq] = oacc[d][nq] * alpha; \
            pb[0][nq] = pack44(SA[0][nq], SA[1][nq]); pb[1][nq] = pack44(SA[2][nq], SA[3][nq]); } } while (0)
#define ATT_SOFTMAX_F(kt_, SA) do { const LAS unsigned char* bp = lds + ((kt_) % NS) * SLOT; float dlt[2], rmx[2]; \
        _Pragma("unroll") for (int nq = 0; nq < 2; ++nq) { float mx = -INFINITY; \
            _Pragma("unroll") for (int mt = 0; mt < 4; ++mt) { \
                if constexpr (FOX) { const f32x4 fk = *(const LAS f32x4*)(bp + KB + VB + wave * 256 + (mt * 16 + fq * 4) * 4); \
                    _Pragma("unroll") for (int j = 0; j < 4; ++j) SA[mt][nq][j] = SA[mt][nq][j] * sc2 - fk[j]; } \
                _Pragma("unroll") for (int j = 0; j < 4; ++j) mx = fmaxf(mx, SA[mt][nq][j]); } \
            mx = xmax_fq(mx); \
            rmx[nq] = FOX ? mx + Fq2[nq] : mx * sc2; dlt[nq] = rmx[nq] - mrow[nq]; } \
        const bool fast = __all((dlt[0] <= 8.f) && (dlt[1] <= 8.f)); \
        _Pragma("unroll") for (int nq = 0; nq < 2; ++nq) { \
            const float mnew = fast ? mrow[nq] : fmaxf(mrow[nq], rmx[nq]); \
            const float alpha = __builtin_amdgcn_exp2f(mrow[nq] - mnew); \
            const float cc = FOX ? Fq2[nq] - mnew : -mnew; mrow[nq] = mnew; float ps = 0.f; \
            _Pragma("unroll") for (int mt = 0; mt < 4; ++mt) _Pragma("unroll") for (int j = 0; j < 4; ++j) { \
                const float p = __builtin_amdgcn_exp2f(FOX ? SA[mt][nq][j] + cc : SA[mt][nq][j] * sc2 + cc); SA[mt][nq][j] = p; ps += p; } \
            lsum[nq] = lsum[nq] * alpha + ps; \
            pb[0][nq] = pack44(SA[0][nq], SA[1][nq]); pb[1][nq] = pack44(SA[2][nq], SA[3][nq]); \
            if (!fast) { _Pragma("unroll") for (int d = 0; d < DT; ++d) oacc[d][nq] = oacc[d][nq] * alpha; } } \
        } while (0)
#define ATT_SOFTMAX(kt_, SA) do { if ((kt_) * 64 + 63 > q0) ATT_SOFTMAX_(kt_, SA, true); else if constexpr (FASTSM) ATT_SOFTMAX_F(kt_, SA); else ATT_SOFTMAX_(kt_, SA, false); } while (0)
#define ATT_PV(kt_) do { const LAS unsigned char* bp = lds + ((kt_) % NS) * SLOT; constexpr int NG = 2 * DT / 4; \
        s16x4 vl[2][4], vh[2][4]; \
        _Pragma("unroll") for (int q = 0; q < 4; ++q) { vl[0][q] = *(const LAS s16x4*)(bp + vlo[0][0] + q * 2048); vh[0][q] = *(const LAS s16x4*)(bp + vlo[0][1] + q * 2048); } \
        _Pragma("unroll") for (int g = 0; g < NG; ++g) { \
            if (g + 1 < NG) { const int ss1 = ((g + 1) * 4) / DT, d1 = ((g + 1) * 4) % DT; \
                _Pragma("unroll") for (int q = 0; q < 4; ++q) { vl[(g + 1) & 1][q] = *(const LAS s16x4*)(bp + vlo[ss1][0] + (d1 + q) * 2048); vh[(g + 1) & 1][q] = *(const LAS s16x4*)(bp + vlo[ss1][1] + (d1 + q) * 2048); } } \
            const int ss = (g * 4) / DT, d0 = (g * 4) % DT; \
            _Pragma("unroll") for (int q = 0; q < 4; ++q) { const bf16x8 vf = __builtin_shufflevector(vl[g & 1][q], vh[g & 1][q], 0, 1, 2, 3, 4, 5, 6, 7); \
                oacc[d0 + q][0] = MFMA16(vf, pb[ss][0], oacc[d0 + q][0]); oacc[d0 + q][1] = MFMA16(vf, pb[ss][1], oacc[d0 + q][1]); } \
            __builtin_amdgcn_sched_barrier(0); } } while (0)
#define ATT_BAR() do { asm volatile("s_waitcnt lgkmcnt(0)" ::: "memory"); __builtin_amdgcn_s_barrier(); asm volatile("" ::: "memory"); } while (0)
#pragma unroll
    for (int p = 0; p < NS - 1; ++p) ATT_ISSUE(kt0 + p);
    bf16x8 pb[2][2];
    if constexpr (PIPE) {
        static_assert(!PIPE || NS == 4, "pipelined form needs a 4-slot ring");
        asm volatile("s_waitcnt vmcnt(%0)" :: "n"(2 * PER) : "memory");
        ATT_BAR();
        f32x4 sA[4][2];
        ATT_S(kt0, sA);
        for (int kt = kt0; kt < ntiles; ++kt) {
            if (kt + 2 < ntiles) asm volatile("s_waitcnt vmcnt(%0)" :: "n"(PER) : "memory");
            else asm volatile("s_waitcnt vmcnt(0)" ::: "memory");
            ATT_BAR();
            if (kt + 3 < ntiles) ATT_ISSUE(kt + 3);
            const bool a0 = (kt * 64 <= q0 + 31), a1 = (kt + 1 < ntiles) && ((kt + 1) * 64 <= q0 + 31);
            if (a1) {
                f32x4 sB[4][2];
                if (kt * 64 + 63 > q0) { ATT_S(kt + 1, sB); ATT_SOFTMAX_(kt, sA, true); }
                else { ATT_S(kt + 1, sB); if constexpr (FASTSM) ATT_SOFTMAX_F(kt, sA); else ATT_SOFTMAX_(kt, sA, false); }
                ATT_PV(kt);
#pragma unroll
                for (int mt = 0; mt < 4; ++mt) { sA[mt][0] = sB[mt][0]; sA[mt][1] = sB[mt][1]; }
            } else if (a0) {
                ATT_SOFTMAX(kt, sA);
                ATT_PV(kt);
            }
        }
    } else {
        for (int kt = 0; kt < ntiles; ++kt) {
            if (kt + NS - 2 < ntiles) asm volatile("s_waitcnt vmcnt(%0)" :: "n"((NS - 2) * PER) : "memory");
            else asm volatile("s_waitcnt vmcnt(0)" ::: "memory");
            ATT_BAR();
            if (kt + NS - 1 < ntiles) ATT_ISSUE(kt + NS - 1);
            if (kt * 64 <= q0 + 31) {
                f32x4 sA[4][2];
                ATT_S(kt, sA);
                ATT_SOFTMAX(kt, sA);
                ATT_PV(kt);
            }
        }
    }
#undef ATT_S
#undef ATT_SOFTMAX
#undef ATT_SOFTMAX_
#undef ATT_SOFTMAX_F
#undef ATT_PV
#undef ATT_BAR
#undef ATT_ISSUE
#pragma unroll
    for (int nq = 0; nq < 2; ++nq) {
        float l = lsum[nq]; l += __shfl_xor(l, 16); l += __shfl_xor(l, 32); const float inv = 1.f / l;
        const int t = tq0 + nq * 16 + r16;
#pragma unroll
        for (int d = 0; d < DT; ++d) { const int dv0 = d * 16 + fq * 4;
            const f32x4 g = unpack4(*(const u32x2*)(P1 + (size_t)t * NP1 + (FOX ? C_FG : C_LG) + h * DV + dv0));
            f32x4 o = oacc[d][nq] * inv; o = (f32x4){o[0] * silu(g[0]), o[1] * silu(g[1]), o[2] * silu(g[2]), o[3] * silu(g[3])};
            *(u32x2*)(OUT + ((size_t)(FOX ? 1 : 3) * T_ + t) * 1024 + h * DV + dv0) = pack4(o); }
    }
}

#define XB_TMO      128
#define XB_XCNT(j)  (256  + 64 * (j))
#define XB_XSUB(j)  (1280 + 64 * (j))
#define XB_XGEN(j)  (2304 + 64 * (j))
#define XB_TOP      3328
#define XB_TOPGEN   3392
#define XCD_BAR_WORDS 3456
#define XB_SPIN_CAP (1u << 18)

DI unsigned xb_ld(unsigned* p)              { return __hip_atomic_load(p, __ATOMIC_RELAXED, __HIP_MEMORY_SCOPE_AGENT); }
DI unsigned xb_add(unsigned* p, unsigned v) { return __hip_atomic_fetch_add(p, v, __ATOMIC_RELAXED, __HIP_MEMORY_SCOPE_AGENT); }
DI unsigned xb_xcc_id() { return (unsigned)__builtin_amdgcn_s_getreg((3 << 11) | 20) & 0xFu; }
#define XB_SPIN(cond, bar) do { unsigned _sp = 0; while (cond) { __builtin_amdgcn_s_sleep(1); \
    if ((++_sp & 255u) == 0u) { if (xb_ld(&(bar)[XB_TMO])) break; if (_sp > XB_SPIN_CAP) { atomicAdd(&(bar)[XB_TMO], 1u); break; } } } } while (0)

struct XcdBarrier {
    unsigned* bar; unsigned x;
    volatile LAS unsigned* st;
};

DI XcdBarrier xcd_barrier_post(unsigned* bar, volatile LAS unsigned* st) {
    XcdBarrier b; b.bar = bar; b.x = xb_xcc_id(); b.st = st;
    if (threadIdx.x == 0) (void)xb_add(&bar[XB_XCNT(b.x)], 1u);
    return b;
}
DI void xcd_barrier_complete(unsigned* bar, unsigned x, unsigned& nloc, unsigned& nx) {
    const unsigned G = gridDim.x * gridDim.y * gridDim.z;
    unsigned sum, cnt, mine, sp = 0u;
    for (;;) {
        sum = 0u; cnt = 0u; mine = 0u;
#pragma unroll
        for (unsigned j = 0; j < 16; ++j) { const unsigned c = xb_ld(&bar[XB_XCNT(j)]); sum += c; cnt += (c > 0u) ? 1u : 0u; mine = (j == x) ? c : mine; }
        if (sum == G) break;
        __builtin_amdgcn_s_sleep(1);
        if ((++sp & 255u) == 0u) { if (xb_ld(&bar[XB_TMO])) break; if (sp > XB_SPIN_CAP) { atomicAdd(&bar[XB_TMO], 1u); break; } }
    }
    nloc = mine > 0u ? mine : 1u; nx = cnt > 0u ? cnt : 1u;
}

DI void xcd_barrier(const XcdBarrier& b) {
    asm volatile("s_waitcnt vmcnt(0)" ::: "memory");
    __syncthreads();
    if (threadIdx.x == 0) {
        unsigned* bar = b.bar;
        __builtin_amdgcn_s_waitcnt(0);
        unsigned nloc = b.st[0], nx = b.st[1];
        if (nloc == 0u) { xcd_barrier_complete(bar, b.x, nloc, nx); b.st[0] = nloc; b.st[1] = nx; }
        const unsigned old = xb_add(&bar[XB_XSUB(b.x)], 1u);
        const unsigned gen = old / nloc;
        if (old + 1u == (gen + 1u) * nloc) {
            __builtin_amdgcn_fence(__ATOMIC_RELEASE, "agent");
            asm volatile("s_waitcnt vmcnt(0)" ::: "memory");
            const unsigned og = xb_add(&bar[XB_TOP], 1u);
            const unsigned tg = og / nx;
            if (og + 1u == (tg + 1u) * nx) xb_add(&bar[XB_TOPGEN], 1u);
            else XB_SPIN(xb_ld(&bar[XB_TOPGEN]) == tg, bar);
            __builtin_amdgcn_fence(__ATOMIC_ACQUIRE, "agent");
            xb_add(&bar[XB_XGEN(b.x)], 1u);
            asm volatile("s_waitcnt vmcnt(0)" ::: "memory");
        } else {
            XB_SPIN(xb_ld(&bar[XB_XGEN(b.x)]) == gen, bar);
            __builtin_amdgcn_fence(__ATOMIC_ACQUIRE, "agent");
            asm volatile("s_waitcnt vmcnt(0)" ::: "memory");
        }
    }
    __syncthreads();
}


typedef const __attribute__((address_space(4))) unsigned char* kaptr_t;
DI const void* kaload(int off) { kaptr_t ka = (kaptr_t)__builtin_amdgcn_kernarg_segment_ptr(); asm volatile("" : "+s"(ka)); typedef const void* cvp_t; return *(const __attribute__((address_space(4))) cvp_t*)(ka + off); }
#define INP(k) ((const float*)kaload(8 * (k)))
#define x_in INP(0)
#define positions ((const int*)kaload(8))
#define pre_norm INP(2)
#define post_norm INP(3)
#define w_in INP(4)
#define conv_w INP(5)
#define conv_b INP(6)
#define dt_bias INP(7)
#define a_log INP(8)
#define d_skip INP(9)
#define ssm_norm INP(10)
#define fgate_b INP(11)
#define gla_w2 INP(12)
#define gla_b INP(13)
#define gla_norm INP(14)
#define q_norm INP(15)
#define kv_norm INP(16)
#define w_uq INP(17)
#define w_ukv INP(18)
#define w_branch INP(19)
#define w_out INP(20)
#define CTL ((unsigned*)(ws + O_CTL))
#define SSQ ((float*)(ws + O_SSQ))
#define DTV ((float*)(ws + O_DT))
#define ACUM ((float*)(ws + O_ACUM))
#define FCUM ((float*)(ws + O_FCUM))
#define CS ((float*)(ws + O_CS))
#define SN ((float*)(ws + O_SN))
#define KROPE ((bf16_t*)(ws + O_KROPE))
#define BLAST ((float*)(ws + O_BLAST))
#define PS ((float*)(ws + O_PSMALL))
#define WBT ((bf16_t*)(ws + O_WBT))
#define WOT ((bf16_t*)(ws + O_WOT))
#define WUQT ((bf16_t*)(ws + O_WUQT))
#define WUKVT ((bf16_t*)(ws + O_WUKVT))
#define P1 ((bf16_t*)(ws + O_P1))
#define PM ((bf16_t*)(ws + O_PM))
#define OUT ((bf16_t*)(ws + O_OUT))
#define WINT ((bf16_t*)(ws + O_WINT))
#define H ((bf16_t*)(ws + O_H))
#define GST ((bf16_t*)(ws + O_GST))
#define QM ((bf16_t*)(ws + O_QM))
#define KN ((bf16_t*)(ws + O_KN))
#define VTM ((bf16_t*)(ws + O_VTM))
#define VTF ((bf16_t*)(ws + O_VTF))
#define XBC ((bf16_t*)(ws + O_XBC))
#define XBCT ((bf16_t*)(ws + O_XBCT))
#define SST ((bf16_t*)(ws + O_SST))
#define KTT ((bf16_t*)(ws + O_KTT))
#define VTG ((bf16_t*)(ws + O_VTG))
#define MIXF ((float*)(ws + O_MIXF))
#define MIXB ((bf16_t*)(ws + O_MIXB))
#define Y ((float*)(ws + O_Y))
DI void phase_body(const int ph, LAS unsigned char* lds, const int rep = 0) {
    LAS float* scrf = (LAS float*)lds; LAS bf16_t* scrb = (LAS bf16_t*)lds;
    {
        const int l = ph == 0 ? 0 : (ph - 1) >> 3, kph = ph == 0 ? -1 : (ph - 1) & 7;
        unsigned char* ws = (unsigned char*)kaload(176);
        float* const outp = (float*)kaload(168);
        const int tid = otid(), lane = tid & 63, wave = __builtin_amdgcn_readfirstlane(tid >> 6), r16 = lane & 15, fq = lane >> 4;
        const int G = osg(gridDim.x), bid = osg(blockIdx.x);
        unsigned* ctr = CTL + 16 + ph + 32 * rep;
        if ((kph == -1 || kph == 7) && (PHMASK & 0x100)) {
            const int lw = (kph == -1) ? 0 : l + 1;
            if (kph == -1) {
                if (bid == 0 && tid < 128) CTL[tid] = 0u;
                const int NI = 2 * (2048 + 1024 + 192 + 256);
#define WT_DECODE(it_, d_) do { const int ll = (it_) / 3520; int r = (it_) % 3520; \
                    if (r < 2048) { const int br = r / 512, q = r % 512; d_ = WtDesc{w_branch + (size_t)(ll * 4 + br) * 1024 * 2048, WBT + ((size_t)ll * 8192 + br * 2048) * 1024, nullptr, 2048, 1024, (q % 16) * 64, (q / 16) * 64, 0}; } \
                    else if (r < 3072) { r -= 2048; d_ = WtDesc{w_out + (size_t)ll * 2048 * 2048, WOT + (size_t)ll * 2048 * 2048, nullptr, 2048, 2048, (r % 32) * 64, (r / 32) * 64, 0}; } \
                    else if (r < 3264) { r -= 3072; d_ = WtDesc{w_uq + (size_t)ll * 512 * 1536, WUQT + (size_t)ll * 1536 * 512, q_norm + ll * 512, 1536, 512, (r % 8) * 64, (r / 8) * 64, 0}; } \
                    else { r -= 3264; d_ = WtDesc{w_ukv + (size_t)ll * 512 * 2048, WUKVT + (size_t)ll * 2048 * 512, kv_norm + ll * 512, 2048, 512, (r % 8) * 64, (r / 8) * 64, 2}; } } while (0)
                { int it = bid; WtDesc d{}; f32x4 v[2];
                  if (it < NI) { WT_DECODE(it, d); wt_load(d, tid, v); }
                  while (it < NI) {
                      wt_to_lds(tid, v, scrf); __syncthreads();
                      const int nx = it + G; WtDesc dn{}; if (nx < NI) { WT_DECODE(nx, dn); wt_load(dn, tid, v); }
                      wt_write(d, tid, scrf); __syncthreads();
                      d = dn; it = nx; } }
#undef WT_DECODE
                for (int row = bid * 8 + wave; row < T_; row += G * 8) rms_row_to_bf16(x_in + (size_t)row * DM, pre_norm, H + (size_t)row * DM, lane);
            } else {
                const float* xsrc = (l == 0) ? x_in : outp;
                for (int row = bid * 8 + wave; row < T_; row += G * 8) {
                    f32x4 v[8]; float s = 0.f;
#pragma unroll
                    for (int j = 0; j < 8; ++j) { v[j] = ((const f32x4*)(Y + (size_t)row * DM))[lane + 64 * j]; s += v[j][0] * v[j][0] + v[j][1] * v[j][1] + v[j][2] * v[j][2] + v[j][3] * v[j][3]; }
                    const float r = rsqrtf(wave_sum(s) * (1.f / 2048.f) + EPS); float s2 = 0.f;
#pragma unroll
                    for (int j = 0; j < 8; ++j) { const f32x4 pw = ((const f32x4*)(post_norm + l * DM))[lane + 64 * j]; const f32x4 xv = ((const f32x4*)(xsrc + (size_t)row * DM))[lane + 64 * j];
                        v[j] = xv + v[j] * pw * r; ((f32x4*)(outp + (size_t)row * DM))[lane + 64 * j] = v[j]; s2 += v[j][0] * v[j][0] + v[j][1] * v[j][1] + v[j][2] * v[j][2] + v[j][3] * v[j][3]; }
                    if (l == 0) { const float r2 = rsqrtf(wave_sum(s2) * (1.f / 2048.f) + EPS);
#pragma unroll
                        for (int j = 0; j < 8; ++j) { const f32x4 ww = ((const f32x4*)(pre_norm + DM))[lane + 64 * j]; *(u32x2*)(H + (size_t)row * DM + (size_t)(lane + 64 * j) * 4) = pack4(v[j] * ww * r2); } }
                }
            }
            if (lw < 2) {
                if (bid == 0 && tid < 128) CTL[256 + tid] = 0u;
                { int it = bid; const int NI = 316 * 32; const float* wsrc = w_in + (size_t)lw * 2048 * NIN; bf16_t* wdst = WINT; WtDesc d{}; f32x4 v[2];
                  if (it < NI) { d = WtDesc{wsrc, wdst, nullptr, NIN, 2048, (it % 32) * 64, (it / 32) * 64, 1}; wt_load(d, tid, v); }
                  while (it < NI) {
                      wt_to_lds(tid, v, scrf); __syncthreads();
                      const int nx = it + G; WtDesc dn{}; if (nx < NI) { dn = WtDesc{wsrc, wdst, nullptr, NIN, 2048, (nx % 32) * 64, (nx / 32) * 64, 1}; wt_load(dn, tid, v); }
                      wt_write(d, tid, scrf); __syncthreads();
                      d = dn; it = nx; } }
            }
        } else if (kph == 0 && (PHMASK >> 0 & 1)) {
            pg8::ProjOrder S{(const char*)H, (const char*)WINT, G, bid};
            pg8::EpiProj E{P1, PM, PS, rep ? nullptr : SSQ, VTF, VTG};
            pg8::gemm_phase(lds, 2048, 2048, 2048, S, E);
        } else if (kph == 1 && (PHMASK >> 1 & 1)) {
#ifndef NO_M1GEMM
            { pg8::MlaOrder S{(const char*)P1, (const char*)(WUQT + (size_t)l * 1536 * 512), (const char*)(WUKVT + (size_t)l * 2048 * 512), G, bid};
              pg8::EpiMla E{SSQ, QM, KN};
              pg8::gemm_phase(lds, 512, NP1, 512, S, E); }
            { pg8::MlaVOrder S{(const char*)P1, (const char*)(WUKVT + ((size_t)l * 2048 + 1024) * 512), G, bid};
              pg8::EpiMlaV E{SSQ, VTM};
              pg8::gemm_phase(lds, 512, 512, NP1, S, E); }
#endif
            constexpr int N_C = 8, N_A = 384, N_E = 256, N_B = 128, N_N = 256, N_D = 1024;
            constexpr int NTOT = N_C + N_A + N_E + N_B + N_N + N_D;
            for (;;) {
                int it = next_item(ctr, lds); if (it >= NTOT) break;
                if (it < N_C) { LANEIDS
                    const int b = it >> 1, h = (it & 1) * 8 + wave; const float fb = fgate_b[l * 16 + h];
                    float v[64];
#pragma unroll
                    for (int j = 0; j < 64; ++j) v[j] = PS[(size_t)(b * S_ + 64 * lane + j) * 128 + 16 + h];
#pragma unroll
                    for (int j = 0; j < 64; ++j) { v[j] = logsig(v[j] + fb); if (j) v[j] += v[j - 1]; }
                    float tot = v[63];
#pragma unroll
                    for (int o = 1; o < 64; o <<= 1) { const float y = __shfl_up(tot, o); if (lane >= o) tot += y; }
                    const float off = tot - v[63];
#pragma unroll
                    for (int j = 0; j < 64; j += 4) *(f32x4*)(FCUM + (size_t)(b * 16 + h) * S_ + 64 * lane + j) = (f32x4){(v[j] + off) * LOG2E, (v[j + 1] + off) * LOG2E, (v[j + 2] + off) * LOG2E, (v[j + 3] + off) * LOG2E};
                    continue; }
                it -= N_C;
                if (it < N_A) { LANEIDS
                    const int cgp = it % 3, bc = it / 3, ch = cgp * 512 + tid, t0 = bc * 128; const bool first = (bc & 31) == 0;
                    const float w0 = conv_w[(size_t)l * 4 * 1536 + ch], w1 = conv_w[(size_t)l * 4 * 1536 + 1536 + ch], w2 = conv_w[(size_t)l * 4 * 1536 + 2 * 1536 + ch], w3 = conv_w[(size_t)l * 4 * 1536 + 3 * 1536 + ch];
                    const float cb = conv_b[l * 1536 + ch];
                    float xm3 = 0.f, xm2 = 0.f, xm1 = 0.f;
                    if (!first) { xm3 = bf1(P1[(size_t)(t0 - 3) * NP1 + C_XBC + ch]); xm2 = bf1(P1[(size_t)(t0 - 2) * NP1 + C_XBC + ch]); xm1 = bf1(P1[(size_t)(t0 - 1) * NP1 + C_XBC + ch]); }
                    for (int l8 = 0; l8 < 16; ++l8) { float o8[8];
#pragma unroll
                        for (int i = 0; i < 8; ++i) { const int t = t0 + l8 * 8 + i; const float xin = bf1(P1[(size_t)t * NP1 + C_XBC + ch]);
                            const float y = cb + w0 * xm3 + w1 * xm2 + w2 * xm1 + w3 * xin; const float a = silu(y); o8[i] = a;
                            XBC[(size_t)t * 1536 + ch] = (bf16_t)f2bf(a); xm3 = xm2; xm2 = xm1; xm1 = xin; }
                        if (ch < 1280) *(bf16x8*)(XBCT + ((size_t)bc * 1280 + ch) * 128 + l8 * 8) = pack8(o8); }
                    continue; }
                it -= N_A;
                if (it < N_E) { LANEIDS
                    const int col = tid, t0 = it * 64; float w2r[16];
#pragma unroll
                    for (int r = 0; r < 16; ++r) w2r[r] = gla_w2[(size_t)l * 16 * 512 + r * 512 + col];
                    const float gb = gla_b[l * 512 + col]; float cum = 0.f;
                    for (int j8 = 0; j8 < 8; ++j8) { float k8[8];
#pragma unroll
                        for (int i = 0; i < 8; ++i) { const int t = t0 + j8 * 8 + i; float z = gb;
#pragma unroll
                            for (int r = 0; r < 16; ++r) z += PS[(size_t)t * 128 + 32 + r] * w2r[r];
                            cum += logsig(z) * (1.f / 16.f);
                            bf16_t* qp = P1 + (size_t)t * NP1 + C_GQ + col; bf16_t* kp = P1 + (size_t)t * NP1 + C_GK + col;
                            const float qt = bf1(*qp) * 0.08838834764831845f * __expf(cum), kt = bf1(*kp) * __expf(-cum);
                            *qp = (bf16_t)f2bf(qt); *kp = (bf16_t)f2bf(kt); k8[i] = kt; }
                        *(bf16x8*)(KTT + ((size_t)it * 512 + col) * 64 + j8 * 8) = pack8(k8); }
                    BLAST[(size_t)it * 512 + col] = cum;
                    continue; }
                it -= N_E;
                if (it < N_B) { LANEIDS
                    const int t0 = it * 128;
#pragma unroll
                    for (int hh = 0; hh < 2; ++hh) { const int h = wave * 2 + hh; const float a = -__expf(a_log[l * 16 + h]), db = dt_bias[l * 16 + h];
                        const float d0 = softplus_(PS[(size_t)(t0 + 2 * lane) * 128 + h] + db), d1 = softplus_(PS[(size_t)(t0 + 2 * lane + 1) * 128 + h] + db);
                        const float c0 = d0 * a, c1 = c0 + d1 * a; float v = c1;
#pragma unroll
                        for (int o = 1; o < 64; o <<= 1) { const float y = __shfl_up(v, o); if (lane >= o) v += y; }
                        const float pre = v - c1;
                        DTV[(size_t)(t0 + 2 * lane) * 16 + h] = d0; DTV[(size_t)(t0 + 2 * lane + 1) * 16 + h] = d1;
                        ACUM[(size_t)(t0 + 2 * lane) * 16 + h] = pre + c0; ACUM[(size_t)(t0 + 2 * lane + 1) * 16 + h] = pre + c1; }
                    continue; }
                it -= N_B;
                if (it < N_N) { LANEIDS
                    const int hh = tid & 15, t0 = it * 64, b = t0 >> 12; float qm = 0.f, km = 0.f;
#pragma unroll
                    for (int p = 0; p < 2; ++p) { const int t = t0 + p * 32 + (tid >> 4); float qs = 0.f, ks = 0.f;
#pragma unroll
                        for (int c = 0; c < 8; ++c) { float a[8], k8[8]; unpack8(ld16(P1 + (size_t)t * NP1 + C_FQ + hh * 64 + c * 8), a); unpack8(ld16(P1 + (size_t)t * NP1 + C_FK + hh * 64 + c * 8), k8);
#pragma unroll
                            for (int e = 0; e < 8; ++e) { qs += a[e] * a[e]; ks += k8[e] * k8[e]; } }
                        qm = fmaxf(qm, qs); km = fmaxf(km, ks); }
                    qm = fmaxf(qm, __shfl_xor(qm, 16)); qm = fmaxf(qm, __shfl_xor(qm, 32)); km = fmaxf(km, __shfl_xor(km, 16)); km = fmaxf(km, __shfl_xor(km, 32));
                    if (lane < 16) { atomicMax(CTL + 256 + (b * 16 + hh) * 2, __float_as_uint(qm)); atomicMax(CTL + 256 + (b * 16 + hh) * 2 + 1, __float_as_uint(km)); }
                    continue; }
                it -= N_N;
                { LANEIDS
                    const int t = it * 16 + (tid >> 5), j = tid & 31;
                    const float invf = exp2f(-(float)j * 0.41524101186092029f);
                    const float ang = (float)positions[t] * invf;
                    double rev = (double)ang * 0.15915494309189535; rev -= floor(rev + 0.5);
                    const float fr_ = (float)rev; const float c = __builtin_amdgcn_cosf(fr_), s = __builtin_amdgcn_sinf(fr_);
                    CS[(size_t)t * 32 + j] = c; SN[(size_t)t * 32 + j] = s;
                    const float lo = PS[(size_t)t * 128 + 48 + j], hi = PS[(size_t)t * 128 + 80 + j];
                    KROPE[(size_t)t * 64 + j] = (bf16_t)f2bf(lo * c - hi * s); KROPE[(size_t)t * 64 + 32 + j] = (bf16_t)f2bf(lo * s + hi * c);
                    continue; }
            }
        } else if (kph == 2 && (PHMASK >> 2 & 1)) {
            constexpr int N_M = 512, N_X = 1024, N_S = 2048, N_K = 1024, NTOT = N_M + N_X + N_S + N_K;
            for (;;) {
                int it = next_item(ctr, lds); if (it >= NTOT) break;
                if (it < N_M) { const int qb = 15 - (it >> 5), rem = it & 31;
                    attn_unit<192, 128, false, false, MLA_FAST>(lds, rem >> 3, rem & 7, qb, ws); continue; }
                it -= N_M;
                if (it < N_X) { const int qb = 15 - (it >> 6), rem = it & 63;
                    attn_unit<64, 64, true, true, FOX_FAST>(lds, rem >> 4, rem & 15, qb, ws); continue; }
                it -= N_X;
                if (it < N_S) { LANEIDS
                    const int h = it & 15, chunk = it >> 4, t0 = chunk * 128, g = h >> 3;
                    const float alast = ACUM[(size_t)(t0 + 127) * 16 + h];
                    f32x4 acc[4];
#pragma unroll
                    for (int p = 0; p < 4; ++p) acc[p] = (f32x4){0.f, 0.f, 0.f, 0.f};
#pragma unroll
                    for (int ks = 0; ks < 4; ++ks) {
                        float bv[8]; unpack8(ld16(XBCT + ((size_t)chunk * 1280 + 1024 + g * 128 + 16 * wave + r16) * 128 + ks * 32 + fq * 8), bv);
#pragma unroll
                        for (int i = 0; i < 8; ++i) { const int tl = t0 + ks * 32 + fq * 8 + i; bv[i] *= DTV[(size_t)tl * 16 + h] * __expf(alast - ACUM[(size_t)tl * 16 + h]); }
                        const bf16x8 bw = pack8(bv);
#pragma unroll
                        for (int p = 0; p < 4; ++p) acc[p] = MFMA16(bw, ld16(XBCT + ((size_t)chunk * 1280 + h * 64 + 16 * p + r16) * 128 + ks * 32 + fq * 8), acc[p]);
                    }
#pragma unroll
                    for (int p = 0; p < 4; ++p) *(u32x2*)(SST + ((size_t)chunk * 16 + h) * 8192 + (16 * p + r16) * 128 + 16 * wave + 4 * fq) = pack4(acc[p]);
                    continue; }
                it -= N_S;
                { LANEIDS
                    const int gc = it >> 2, h = it & 3, b = gc >> 6, c = gc & 63, bh = b * 4 + h;
                    bf16x8 kf[2];
#pragma unroll
                    for (int ks = 0; ks < 2; ++ks) kf[ks] = ld16(KTT + ((size_t)gc * 512 + h * 128 + 16 * wave + r16) * 64 + ks * 32 + fq * 8);
                    const f32x4 eb = *(const f32x4*)(BLAST + (size_t)gc * 512 + h * 128 + 16 * wave + 4 * fq);
                    const f32x4 ee = {__expf(eb[0]), __expf(eb[1]), __expf(eb[2]), __expf(eb[3])};
#pragma unroll 4
                    for (int et = 0; et < 16; ++et) { f32x4 acc = {0.f, 0.f, 0.f, 0.f};
#pragma unroll
                        for (int ks = 0; ks < 2; ++ks) acc = MFMA16(kf[ks], ld16(VTG + ((size_t)gc * 1024 + h * 256 + 16 * et + r16) * 64 + ks * 32 + fq * 8), acc);
                        *(u32x2*)(GST + (((size_t)bh * 64 + c) * 256 + 16 * et + r16) * 128 + 16 * wave + 4 * fq) = pack4(acc * ee); }
                }
            }
        } else if (kph == 3 && (PHMASK >> 3 & 1)) {
            for (int it = bid; it < 256; it += G) {
                if (it < 128) { const int e8 = (it * 512 + tid) * 8, bh = e8 >> 13, off = e8 & 8191, b = bh >> 4, h = bh & 15;
                    float st[8];
#pragma unroll
                    for (int i = 0; i < 8; ++i) st[i] = 0.f;
                    for (int cg8 = 0; cg8 < 4; ++cg8) { bf16x8 vv[8]; float dec[8];
#pragma unroll
                        for (int q = 0; q < 8; ++q) { const int c = cg8 * 8 + q; vv[q] = *(const bf16x8*)(SST + ((size_t)(b * 32 + c) * 16 + h) * 8192 + off); dec[q] = ACUM[(size_t)(b * S_ + c * 128 + 127) * 16 + h]; }
#pragma unroll
                        for (int q = 0; q < 8; ++q) { const int c = cg8 * 8 + q; float v[8]; unpack8(vv[q], v); const float d = __expf(dec[q]);
                            *(bf16x8*)(SST + ((size_t)(b * 32 + c) * 16 + h) * 8192 + off) = pack8(st);
#pragma unroll
                            for (int i = 0; i < 8; ++i) st[i] = st[i] * d + v[i]; } }
                } else { const int e8 = ((it - 128) * 512 + tid) * 8, bh = e8 >> 15, off = e8 & 32767, d0 = off & 127, b = bh >> 2, h = bh & 3;
                    float st[8];
#pragma unroll
                    for (int i = 0; i < 8; ++i) st[i] = 0.f;
                    for (int cg8 = 0; cg8 < 8; ++cg8) { bf16x8 vv[8]; f32x4 e0[8], e1[8];
#pragma unroll
                        for (int q = 0; q < 8; ++q) { const int c = cg8 * 8 + q; vv[q] = *(const bf16x8*)(GST + ((size_t)bh * 64 + c) * 32768 + off);
                            e0[q] = *(const f32x4*)(BLAST + (size_t)(b * 64 + c) * 512 + h * 128 + d0); e1[q] = *(const f32x4*)(BLAST + (size_t)(b * 64 + c) * 512 + h * 128 + d0 + 4); }
#pragma unroll
                        for (int q = 0; q < 8; ++q) { const int c = cg8 * 8 + q; float v[8]; unpack8(vv[q], v);
                            *(bf16x8*)(GST + ((size_t)bh * 64 + c) * 32768 + off) = pack8(st);
#pragma unroll
                            for (int i = 0; i < 8; ++i) st[i] = st[i] * __expf(i < 4 ? e0[q][i & 3] : e1[q][i & 3]) + v[i]; } }
                }
            }
        } else if (kph == 4 && (PHMASK >> 4 & 1)) {
            constexpr int N_S = 256, N_G = 1024, NTOT = N_S + N_G;
            for (;;) {
                int it = next_item(ctr, lds); if (it >= NTOT) break;
                if (it < N_S) { LANEIDS
                    const int g = it & 1, chunk = it >> 1, t0 = chunk * 128;
                    LAS float* sAc = (LAS float*)lds; LAS float* sDt = sAc + 1024;
                    for (int i = tid; i < 1024; i += 512) { const int hh = i >> 7, s = i & 127; sAc[i] = ACUM[(size_t)(t0 + s) * 16 + g * 8 + hh]; sDt[i] = DTV[(size_t)(t0 + s) * 16 + g * 8 + hh]; }
                    __syncthreads();
                    const int tl = t0 + 16 * wave + r16, lpos = 16 * wave + r16;
                    bf16x8 cf[4];
#pragma unroll
                    for (int ks = 0; ks < 4; ++ks) cf[ks] = ld16(XBC + (size_t)tl * 1536 + 1280 + g * 128 + ks * 32 + fq * 8);
                    f32x4 gacc[8];
#pragma unroll
                    for (int mt = 0; mt < 8; ++mt) { gacc[mt] = (f32x4){0.f, 0.f, 0.f, 0.f};
                        if (mt <= wave) {
#pragma unroll
                            for (int ks = 0; ks < 4; ++ks) gacc[mt] = MFMA16(ld16(XBC + (size_t)(t0 + 16 * mt + r16) * 1536 + 1024 + g * 128 + ks * 32 + fq * 8), cf[ks], gacc[mt]); } }
                    float ssq = 0.f;
#pragma unroll 2
                    for (int hh = 0; hh < 8; ++hh) { const int h = g * 8 + hh;
                        const float al = sAc[hh * 128 + lpos], el = __expf(al);
                        f32x4 acc1[4], acc2[4];
#pragma unroll
                        for (int p = 0; p < 4; ++p) { acc1[p] = (f32x4){0.f, 0.f, 0.f, 0.f}; acc2[p] = (f32x4){0.f, 0.f, 0.f, 0.f}; }
#pragma unroll
                        for (int ss = 0; ss < 4; ++ss) if (2 * ss <= wave) {
                            f32x4 wv[2];
#pragma unroll
                            for (int q = 0; q < 2; ++q) { const int mt = 2 * ss + q; const f32x4 as = *(const LAS f32x4*)(sAc + hh * 128 + 16 * mt + 4 * fq), ds = *(const LAS f32x4*)(sDt + hh * 128 + 16 * mt + 4 * fq);
#pragma unroll
                                for (int j = 0; j < 4; ++j) { const int spos = 16 * mt + 4 * fq + j; wv[q][j] = (spos <= lpos) ? gacc[mt][j] * __expf(fminf(al - as[j], 0.f)) * ds[j] : 0.f; } }
                            const bf16x8 wp = pack44(wv[0], wv[1]);
#pragma unroll
                            for (int p = 0; p < 4; ++p) { const bf16_t* xp = XBCT + ((size_t)chunk * 1280 + h * 64 + 16 * p + r16) * 128 + 32 * ss + 4 * fq;
                                acc1[p] = MFMA16(ld8x2(xp, xp + 16), wp, acc1[p]); }
                        }
#pragma unroll
                        for (int ks = 0; ks < 4; ++ks)
#pragma unroll
                            for (int p = 0; p < 4; ++p) acc2[p] = MFMA16(ld16(SST + ((size_t)chunk * 16 + h) * 8192 + (16 * p + r16) * 128 + ks * 32 + fq * 8), cf[ks], acc2[p]);
                        const float dsk = d_skip[l * 16 + h];
#pragma unroll
                        for (int p = 0; p < 4; ++p) { const int pc = h * 64 + 16 * p + 4 * fq;
                            const f32x4 xv = unpack4(*(const u32x2*)(XBC + (size_t)tl * 1536 + pc)), zv = unpack4(*(const u32x2*)(P1 + (size_t)tl * NP1 + C_MZ + pc));
                            f32x4 y = acc1[p] + acc2[p] * el + xv * dsk;
                            y = (f32x4){y[0] * silu(zv[0]), y[1] * silu(zv[1]), y[2] * silu(zv[2]), y[3] * silu(zv[3])};
                            ssq += y[0] * y[0] + y[1] * y[1] + y[2] * y[2] + y[3] * y[3];
                            *(u32x2*)(OUT + (size_t)tl * 1024 + pc) = pack4(y); }
                    }
                    ssq += __shfl_xor(ssq, 16); ssq += __shfl_xor(ssq, 32);
                    const float rs = rsqrtf(ssq * (1.f / 512.f) + EPS);
                    asm volatile("s_waitcnt vmcnt(0)" ::: "memory");
                    for (int hh = 0; hh < 8; ++hh)
#pragma unroll
                        for (int p = 0; p < 4; ++p) { const int pc = (g * 8 + hh) * 64 + 16 * p + 4 * fq; bf16_t* op = OUT + (size_t)tl * 1024 + pc;
                            const f32x4 nw = *(const f32x4*)(ssm_norm + l * 1024 + pc); *(u32x2*)op = pack4(unpack4(*(const u32x2*)op) * nw * rs); }
                    continue; }
                it -= N_S;
                { LANEIDS
                    const int gc = it >> 2, h = it & 3, b = gc >> 6, c = gc & 63, bh = b * 4 + h, t0 = gc * 64;
                    const int itl = wave & 3, eh = wave >> 2, ti = t0 + 16 * itl + r16, ipos = 16 * itl + r16;
                    LAS float* sSS = (LAS float*)(lds + MISC_OFF + 64);
                    bf16x8 qf[4];
#pragma unroll
                    for (int ks = 0; ks < 4; ++ks) qf[ks] = ld16(P1 + (size_t)ti * NP1 + C_GQ + h * 128 + ks * 32 + fq * 8);
                    f32x4 aacc[4];
#pragma unroll
                    for (int mt = 0; mt < 4; ++mt) { aacc[mt] = (f32x4){0.f, 0.f, 0.f, 0.f};
                        if (mt <= itl) {
#pragma unroll
                            for (int ks = 0; ks < 4; ++ks) aacc[mt] = MFMA16(ld16(P1 + (size_t)(t0 + 16 * mt + r16) * NP1 + C_GK + h * 128 + ks * 32 + fq * 8), qf[ks], aacc[mt]);
#pragma unroll
                            for (int j = 0; j < 4; ++j) if (16 * mt + 4 * fq + j > ipos) aacc[mt][j] = 0.f; } }
                    bf16x8 wp[2]; wp[0] = pack44(aacc[0], aacc[1]); wp[1] = pack44(aacc[2], aacc[3]);
                    f32x4 oacc[8]; float ssq = 0.f;
#pragma unroll
                    for (int et = 0; et < 8; ++et) { const int e = 16 * (8 * eh + et) + r16; f32x4 o = {0.f, 0.f, 0.f, 0.f};
#pragma unroll
                        for (int ss = 0; ss < 2; ++ss) if (2 * ss <= itl) { const bf16_t* vp = VTG + ((size_t)gc * 1024 + h * 256 + e) * 64 + 32 * ss + 4 * fq; o = MFMA16(ld8x2(vp, vp + 16), wp[ss], o); }
#pragma unroll
                        for (int ks = 0; ks < 4; ++ks) o = MFMA16(ld16(GST + (((size_t)bh * 64 + c) * 256 + e) * 128 + ks * 32 + fq * 8), qf[ks], o);
                        oacc[et] = o; ssq += o[0] * o[0] + o[1] * o[1] + o[2] * o[2] + o[3] * o[3]; }
                    ssq += __shfl_xor(ssq, 16); ssq += __shfl_xor(ssq, 32);
                    if (fq == 0) sSS[eh * 64 + ipos] = ssq;
                    __syncthreads();
                    const float rs = rsqrtf((sSS[ipos] + sSS[64 + ipos]) * (1.f / 256.f) + EPS);
#pragma unroll
                    for (int et = 0; et < 8; ++et) { const int e0 = 16 * (8 * eh + et) + 4 * fq;
                        const f32x4 gv = unpack4(*(const u32x2*)(P1 + (size_t)ti * NP1 + C_GG + h * 256 + e0)), nw = *(const f32x4*)(gla_norm + l * 256 + e0);
                        f32x4 o = oacc[et] * nw * rs; o = (f32x4){o[0] * silu(gv[0]), o[1] * silu(gv[1]), o[2] * silu(gv[2]), o[3] * silu(gv[3])};
                        *(u32x2*)(OUT + ((size_t)2 * T_ + ti) * 1024 + h * 256 + e0) = pack4(o); }
                }
            }
        } else if (kph == 5 && (PHMASK >> 5 & 1)) {
            pg8::MergeOrder S{(const char*)OUT, (const char*)(WBT + (size_t)l * 8192 * 1024), G, bid};
            pg8::EpiMerge E{PM, MIXF, MIXB};
            pg8::gemm_phase(lds, 1024, 1024, 1024, S, E);
        } else if (kph == 6 && (PHMASK >> 6 & 1)) {
            pg8::PlainOrder S{(const char*)MIXB, (const char*)(WOT + (size_t)l * 2048 * 2048), 64, 8, G, bid, (size_t)256 * 2048 * 2, (size_t)256 * 2048 * 2};
            pg8::EpiOut E{Y};
            pg8::gemm_phase(lds, 2048, 2048, 2048, S, E);
        }
    }
}
__global__ void __launch_bounds__(512, 2) mk_fwd(Args args) {
    extern __shared__ __attribute__((aligned(16))) unsigned char lds_raw[];
    LAS unsigned char* lds = (LAS unsigned char*)lds_raw;
    const int lo = args.ph_lo, hi = args.ph_hi;
    volatile LAS unsigned* xst = (volatile LAS unsigned*)(lds + MISC_OFF + 16);
    if (threadIdx.x == 0) { xst[0] = 0u; xst[1] = 0u; }
    __syncthreads();
    XcdBarrier xb; xb.bar = (unsigned*)(args.ws + O_CTL) + 4096; xb.x = 0; xb.st = xst;
    if (hi - lo > 1) xb = xcd_barrier_post((unsigned*)(args.ws + O_CTL) + 4096, xst);
#define SEAM(k) do { if ((k) == 0) cg::this_grid().sync(); else xcd_barrier(xb); } while (0)
#define PH(k) if (lo <= (k) && (k) < hi) { phase_body((k), lds); if ((k) > 0 && (((k) - 1) & 7) == REP_KPH) { cg::this_grid().sync(); phase_body((k), lds, 1); } if ((k) + 1 < hi) SEAM(k); }
    PH(0) PH(1) PH(2) PH(3) PH(4) PH(5) PH(6) PH(7) PH(8) PH(9) PH(10) PH(11) PH(12) PH(13) PH(14) PH(15) PH(16)
#undef PH
#undef SEAM
}

extern "C" void kernel_launch(void* const* d_in, const int* in_sizes, int n_in, void* d_out, int out_size, void* d_ws, size_t ws_size, hipStream_t stream) {
    static int grid = 0;
    if (grid == 0) {
        if (n_in != 21 || ws_size < WS_END) { fprintf(stderr, "kernel_launch: unexpected n_in %d or ws_size %zu (< %zu)\n", n_in, ws_size, (size_t)WS_END); }
        int dev = 0, cus = 0, per_cu = 0;
        hipGetDevice(&dev); hipDeviceGetAttribute(&cus, hipDeviceAttributeMultiprocessorCount, dev);
        hipFuncSetAttribute((const void*)mk_fwd, hipFuncAttributeMaxDynamicSharedMemorySize, LDS_BYTES);
        hipOccupancyMaxActiveBlocksPerMultiprocessor(&per_cu, (const void*)mk_fwd, 512, LDS_BYTES);
        if (per_cu < 1) { fprintf(stderr, "kernel_launch: occupancy query says %d blocks/CU\n", per_cu); per_cu = 1; }
        (void)hipGetLastError();
        grid = cus * 1;
        if (grid <= 0) grid = 256;
    }
    Args a{};
    for (int i = 0; i < 21; ++i) a.in[i] = d_in[i];
    a.out = (float*)d_out; a.ws = (unsigned char*)d_ws;
#if MK_SINGLE
    a.ph_lo = 0; a.ph_hi = NPHASE;
    (void)hipMemsetAsync((char*)d_ws + O_CTL + 4096 * 4, 0, XCD_BAR_WORDS * 4, stream);
    void* kargs[] = {&a};
    hipError_t e = hipLaunchCooperativeKernel((const void*)mk_fwd, dim3(grid), dim3(512), kargs, LDS_BYTES, stream);
    if (e != hipSuccess) fprintf(stderr, "cooperative launch failed: %s (grid %d)\n", hipGetErrorString(e), grid);
#else
    for (int ph = 0; ph < NPHASE; ++ph) { a.ph_lo = ph; a.ph_hi = ph + 1;
        hipLaunchKernelGGL(mk_fwd, dim3(grid), dim3(512), LDS_BYTES, stream, a); }
#endif
}
```

```cpp
#include <hip/hip_runtime.h>
#include <hip/hip_cooperative_groups.h>
#include <cstdio>
#include <cstdint>
namespace cg = cooperative_groups;

#ifndef PHMASK
#define PHMASK 0x1ff
#endif
#ifndef MLA_FAST
#define MLA_FAST false
#endif
#ifndef FOX_FAST
#define FOX_FAST true
#endif
#ifndef REP_KPH
#define REP_KPH -2
#endif
#ifndef MK_SINGLE
#define MK_SINGLE 1
#endif

#define LAS __attribute__((address_space(3)))
#define DI __device__ __forceinline__
typedef unsigned short bf16_t;
typedef short bf16x8 __attribute__((ext_vector_type(8)));
typedef short s16x4 __attribute__((ext_vector_type(4)));
typedef float f32x4 __attribute__((ext_vector_type(4)));
typedef unsigned u32x4 __attribute__((ext_vector_type(4)));
typedef unsigned u32x2 __attribute__((ext_vector_type(2)));
#define MFMA16(a, b, c) __builtin_amdgcn_mfma_f32_16x16x32_bf16((a), (b), (c), 0, 0, 0)

constexpr int T_ = 16384, S_ = 4096, DM = 2048;
constexpr int NIN = 20080, NP1 = 11776, NPM = 8192, NW1 = 20224;
constexpr int C_MZ = 0, C_XBC = 1024, C_FQ = 2560, C_FK = 3584, C_FV = 4608, C_FG = 5632, C_GQ = 6656, C_GK = 7168, C_GV = 7680,
              C_GG = 8704, C_LCQ = 9728, C_LCKV = 10240, C_LG = 10752;
constexpr float EPS = 1e-6f;
constexpr float LOG2E = 1.4426950408889634f;

constexpr size_t MiB = 1u << 20;
constexpr size_t O_CTL = 0;
constexpr size_t O_SSQ = 1 * MiB;
constexpr size_t O_DT = 2 * MiB;
constexpr size_t O_ACUM = 3 * MiB;
constexpr size_t O_FCUM = 4 * MiB;
constexpr size_t O_CS = 5 * MiB;
constexpr size_t O_SN = 7 * MiB;
constexpr size_t O_KROPE = 9 * MiB;
constexpr size_t O_BLAST = 11 * MiB;
constexpr size_t O_PSMALL = 12 * MiB;
constexpr size_t O_WBT = 20 * MiB;
constexpr size_t O_WOT = 52 * MiB;
constexpr size_t O_WUQT = 68 * MiB;
constexpr size_t O_WUKVT = 71 * MiB;
constexpr size_t O_P1 = 75 * MiB;
constexpr size_t O_PM = 443 * MiB;
constexpr size_t O_OUT = 699 * MiB;
constexpr size_t O_WINT = O_OUT;
constexpr size_t O_H = 827 * MiB;
constexpr size_t O_GST = O_H;
constexpr size_t O_QM = 891 * MiB;
constexpr size_t O_KN = 939 * MiB;
constexpr size_t O_VTM = 971 * MiB;
constexpr size_t O_VTF = 1003 * MiB;
constexpr size_t O_XBC = 1035 * MiB;
constexpr size_t O_XBCT = 1083 * MiB;
constexpr size_t O_SST = 1123 * MiB;
constexpr size_t O_KTT = 1155 * MiB;
constexpr size_t O_VTG = 1171 * MiB;
constexpr size_t WS_END = 1203 * MiB;
constexpr size_t O_MIXF = O_P1;
constexpr size_t O_MIXB = O_P1 + 128 * MiB;
constexpr size_t O_Y = O_P1 + 192 * MiB;

constexpr int LDS_BYTES = 135168;
constexpr int MISC_OFF = 131072;
constexpr int NPHASE = 17;

DI unsigned f2bf(float f) { unsigned u = __float_as_uint(f); return (u + 0x7fffu + ((u >> 16) & 1u)) >> 16; }
typedef float f32x2_t __attribute__((ext_vector_type(2)));
typedef __bf16 bf16x2_t __attribute__((ext_vector_type(2)));
DI unsigned pk2(float lo, float hi) { f32x2_t v = {lo, hi}; bf16x2_t b = __builtin_convertvector(v, bf16x2_t); return __builtin_bit_cast(unsigned, b); }
DI float bflo(unsigned u) { return __uint_as_float(u << 16); }
DI float bfhi(unsigned u) { return __uint_as_float(u & 0xffff0000u); }
DI float bf1(bf16_t b) { return __uint_as_float(((unsigned)b) << 16); }
DI float sigm(float x) { return __builtin_amdgcn_rcpf(1.f + __expf(-x)); }
DI float silu(float x) { return x * __builtin_amdgcn_rcpf(1.f + __expf(-x)); }
DI float softplus_(float x) { return fmaxf(x, 0.f) + log1pf(__expf(-fabsf(x))); }
DI float logsig(float x) { return fminf(x, 0.f) - log1pf(__expf(-fabsf(x))); }
DI float xmax_fq(float x) {
    auto a = __builtin_amdgcn_permlane32_swap(__float_as_uint(x), __float_as_uint(x), false, false);
    x = fmaxf(__uint_as_float(a[0]), __uint_as_float(a[1]));
    auto b = __builtin_amdgcn_permlane16_swap(__float_as_uint(x), __float_as_uint(x), false, false);
    return fmaxf(__uint_as_float(b[0]), __uint_as_float(b[1]));
}
DI float wave_sum(float v) {
#pragma unroll
    for (int o = 1; o < 64; o <<= 1) v += __shfl_xor(v, o);
    return v;
}
DI void unpack8(bf16x8 v, float (&f)[8]) {
    u32x4 u = __builtin_bit_cast(u32x4, v);
    f[0] = bflo(u.x); f[1] = bfhi(u.x); f[2] = bflo(u.y); f[3] = bfhi(u.y); f[4] = bflo(u.z); f[5] = bfhi(u.z); f[6] = bflo(u.w); f[7] = bfhi(u.w);
}
DI bf16x8 pack8(const float (&f)[8]) {
    u32x4 u; u.x = pk2(f[0], f[1]); u.y = pk2(f[2], f[3]); u.z = pk2(f[4], f[5]); u.w = pk2(f[6], f[7]);
    return __builtin_bit_cast(bf16x8, u);
}
DI bf16x8 pack44(f32x4 a, f32x4 b) {
    u32x4 u; u.x = pk2(a[0], a[1]); u.y = pk2(a[2], a[3]); u.z = pk2(b[0], b[1]); u.w = pk2(b[2], b[3]);
    return __builtin_bit_cast(bf16x8, u);
}
DI u32x2 pack4(f32x4 a) { u32x2 u; u.x = pk2(a[0], a[1]); u.y = pk2(a[2], a[3]); return u; }
DI f32x4 unpack4(u32x2 u) { return (f32x4){bflo(u.x), bfhi(u.x), bflo(u.y), bfhi(u.y)}; }
DI bf16x8 ld16(const bf16_t* p) { return *(const bf16x8*)p; }
DI bf16x8 ld8x2(const bf16_t* p0, const bf16_t* p1) {
    s16x4 a = *(const s16x4*)p0, b = *(const s16x4*)p1;
    return __builtin_shufflevector(a, b, 0, 1, 2, 3, 4, 5, 6, 7);
}

DI int otid() { int t = threadIdx.x; asm volatile("" : "+v"(t)); return t; }
#define LANEIDS const int tid = otid(), lane = tid & 63, wave = __builtin_amdgcn_readfirstlane(tid >> 6), r16 = lane & 15, fq = lane >> 4; (void)tid; (void)lane; (void)wave; (void)r16; (void)fq;
DI int osg(int v) { asm volatile("" : "+s"(v)); return v; }
struct Args { const void* in[21]; float* out; unsigned char* ws; int ph_lo, ph_hi; };

DI int next_item(unsigned* ctr, LAS unsigned char* lds) {
    volatile LAS int* s = (volatile LAS int*)(lds + MISC_OFF);
    __syncthreads();
    if (threadIdx.x == 0) *s = (int)atomicAdd(ctr, 1u);
    __syncthreads();
    return *s;
}

namespace pg8 {
constexpr int BM = 256, BK = 64, HALF = 128, HTB = HALF * BK * 2, STAGE_BYTES = 8 * HTB, NXCD = 8, WGM = 8;
DI int lds_byte(int r, int c) { const int st = (r >> 4) * 2 + (c >> 5), rr = r & 15, cc = c & 31, ob = rr * 64 + cc * 2; return st * 1024 + (ob ^ (((ob >> 9) & 1) << 5)); }
DI void stage_rc(int b, int& R, int& C) { const int st = b / 1024, sb = b % 1024, swz = sb ^ (((sb >> 9) & 1) << 5); R = (st >> 1) * 16 + swz / 64; C = (st & 1) * 32 + (swz % 64) / 2; }
DI int perm32(int rho) { const int n = rho >> 4, i = rho & 15; return 8 * (i >> 2) + 4 * n + (i & 3); }

struct Unit { int pm, pn, aux; const char* A; const char* B; };

DI void tile_of(int L, int nM, int nN, int& pm, int& pn) {
    const int nwg = nM * nN; int wgid = L;
    { const int q = nwg / NXCD, r = nwg % NXCD, xcd = wgid % NXCD, off = wgid / NXCD; wgid = (xcd < r ? xcd * (q + 1) : r * (q + 1) + (xcd - r) * q) + off; }
    const int nig = WGM * nN, gid = wgid / nig, fm = gid * WGM, gsz = (nM - fm) < WGM ? (nM - fm) : WGM;
    pm = fm + ((wgid % nig) % gsz); pn = (wgid % nig) / gsz;
}
struct PlainOrder {
    const char* A; const char* B; int nM, nN, G, c; size_t tsA, tsB;
    DI bool next(int i, Unit& u) const {
        const long L = (long)i * G + c; if (L >= (long)nM * nN) return false;
        tile_of((int)L, nM, nN, u.pm, u.pn); u.aux = 0; u.A = A + (size_t)u.pm * tsA; u.B = B + (size_t)u.pn * tsB; return true;
    }
};
struct ProjOrder {
    const char* A; const char* B; int G, c;
    DI bool next(int i, Unit& u) const {
        const long L = (long)i * G + c; if (L >= 64 * 79) return false;
        int pm, pn; tile_of((int)L, 64, 79, pm, pn);
        const size_t ts = (size_t)256 * 2048 * 2;
        const bool fv = (pn >= 18 && pn < 22), gv = (pn >= 30 && pn < 34);
        if (fv || gv) { u.pm = pn; u.pn = pm; u.aux = fv ? 1 : 2; u.A = B + (size_t)pn * ts; u.B = A + (size_t)pm * ts; }
        else { u.pm = pm; u.pn = pn; u.aux = 0; u.A = A + (size_t)pm * ts; u.B = B + (size_t)pn * ts; }
        return true;
    }
};
struct MlaOrder {
    const char* P1; const char* Wq; const char* Wkv; int G, c;
    DI bool next(int i, Unit& u) const {
        const long L = (long)i * G + c; if (L >= 64 * 10) return false;
        const int pm = (int)L / 10, rem = (int)L % 10; u.pm = pm; u.aux = rem;
        if (rem < 6) { u.pn = rem; u.A = P1 + ((size_t)pm * 256 * NP1 + C_LCQ) * 2; u.B = Wq + (size_t)rem * 256 * 512 * 2; }
        else { u.pn = rem - 6; u.A = P1 + ((size_t)pm * 256 * NP1 + C_LCKV) * 2; u.B = Wkv + (size_t)(rem - 6) * 256 * 512 * 2; }
        return true;
    }
};
struct MlaVOrder {
    const char* P1; const char* Wv; int G, c;
    DI bool next(int i, Unit& u) const {
        const long L = (long)i * G + c; if (L >= 256) return false;
        u.pm = (int)L & 3; u.pn = (int)L >> 2; u.aux = 0;
        u.A = Wv + (size_t)u.pm * 256 * 512 * 2; u.B = P1 + ((size_t)u.pn * 256 * NP1 + C_LCKV) * 2; return true;
    }
};
struct MergeOrder {
    const char* OUTp; const char* Wb; int G, c;
    DI bool next(int i, Unit& u) const {
        const int j = i >> 2, br = i & 3; const long L = (long)j * G + c; if (L >= 512) return false;
        tile_of((int)L, 64, 8, u.pm, u.pn); u.aux = br;
        u.A = OUTp + ((size_t)br * T_ + (size_t)u.pm * 256) * 1024 * 2; u.B = Wb + ((size_t)br * 2048 + u.pn * 256) * 1024 * 2; return true;
    }
};

template <class Epi, class Sched>
DI void gemm_phase(LAS unsigned char* lds, const int K, const int lda, const int ldb, const Sched& S, const Epi& E) {
    const int tid = otid(), wid = __builtin_amdgcn_readfirstlane(tid >> 6), lane = tid & 63, wr = wid >> 2, wc = wid & 3, fr = lane & 15, fq = lane >> 4;
    const int nt = K / BK;
    unsigned voffA[2], voffB[2];
#pragma unroll
    for (int i = 0; i < 2; ++i) { int R, C; stage_rc(tid * 16 + i * 8192, R, C); const int Rb = (R & ~31) + perm32(R & 31);
        voffA[i] = (unsigned)(R * lda + C) * 2u; voffB[i] = (unsigned)(Rb * ldb + C) * 2u; }
    const size_t kstep = (size_t)(BK * 2);
    const size_t hstepA = (size_t)HALF * lda * 2, hstepB = (size_t)HALF * ldb * 2;
    const unsigned ldsw = (unsigned)wid * 1024u;
    const int aoff = lds_byte(wr * 64 + fr, fq * 8), boff = lds_byte(wc * 32 + fr, fq * 8);
#define PG8_SA(b, h) (((b) * 2 + (h)) * HTB)
#define PG8_SB(b, h) ((4 + (b) * 2 + (h)) * HTB)
#define PG8_STAGE(bufoff, gbase, voff) do { _Pragma("unroll") for (int _i = 0; _i < 2; ++_i) \
        __builtin_amdgcn_global_load_lds((const unsigned*)((const char*)(gbase) + (voff)[_i]), (LAS unsigned*)(lds + (bufoff) + ldsw + _i * 8192), 16, 0, 0); } while (0)
#define PG8_LDA(dst, b, h) do { _Pragma("unroll") for (int m = 0; m < 4; ++m) _Pragma("unroll") for (int k = 0; k < 2; ++k) dst[m][k] = *(const LAS bf16x8*)(lds + PG8_SA(b, h) + aoff + m * 2048 + k * 1024); } while (0)
#define PG8_LDB(dst, b, h) do { _Pragma("unroll") for (int n = 0; n < 2; ++n) _Pragma("unroll") for (int k = 0; k < 2; ++k) dst[n][k] = *(const LAS bf16x8*)(lds + PG8_SB(b, h) + boff + n * 2048 + k * 1024); } while (0)
#define PG8_MMA(ai, bj, At, Bt) do { __builtin_amdgcn_s_setprio(1); _Pragma("unroll") for (int m = 0; m < 4; ++m) _Pragma("unroll") for (int n = 0; n < 2; ++n) _Pragma("unroll") for (int k = 0; k < 2; ++k) \
        acc[ai][bj][m][n] = __builtin_amdgcn_mfma_f32_16x16x32_bf16(Bt[n][k], At[m][k], acc[ai][bj][m][n], 0, 0, 0); __builtin_amdgcn_s_setprio(0); } while (0)
#define PG8_WAIT_V(n) asm volatile("s_waitcnt vmcnt(" #n ")" ::: "memory")
#define PG8_WAIT_L(n) asm volatile("s_waitcnt lgkmcnt(" #n ")" ::: "memory")
#define PG8_BAR __builtin_amdgcn_s_barrier()
#define PG8_SCHED __builtin_amdgcn_sched_barrier(0)
    Unit cur, nxt; int ui = 0;
    if (!S.next(0, cur)) return;
    f32x4 acc[2][2][4][2];
#pragma unroll
    for (int a = 0; a < 2; ++a)
#pragma unroll
        for (int b = 0; b < 2; ++b)
#pragma unroll
            for (int m = 0; m < 4; ++m)
#pragma unroll
                for (int n = 0; n < 2; ++n) acc[a][b][m][n] = (f32x4){0.f, 0.f, 0.f, 0.f};
    bf16x8 At[4][2], B0[2][2], B1[2][2];
    const char* cA = cur.A; const char* cB = cur.B;
    PG8_STAGE(PG8_SB(0, 0), cB, voffB); PG8_STAGE(PG8_SB(0, 1), cB + hstepB, voffB); PG8_STAGE(PG8_SA(0, 0), cA, voffA); PG8_STAGE(PG8_SA(0, 1), cA + hstepA, voffA);
    if (wr == 1) PG8_BAR;
    PG8_WAIT_V(2); PG8_BAR;
    PG8_STAGE(PG8_SB(1, 0), cB + kstep, voffB); PG8_STAGE(PG8_SA(1, 0), cA + kstep, voffA); PG8_STAGE(PG8_SB(1, 1), cB + hstepB + kstep, voffB);
    PG8_WAIT_V(6); PG8_BAR;
    for (;;) {
        const bool has_next = S.next(ui + 1, nxt);
        const char* nA = has_next ? nxt.A : cA; const char* nB = has_next ? nxt.B : cB;
        for (int t = 0; t < nt; t += 2) {
            const bool last = (t == nt - 2);
            const char* a1 = cA + (size_t)(t + 1) * kstep;
            const char* a2 = last ? nA : cA + (size_t)(t + 2) * kstep; const char* b2 = last ? nB : cB + (size_t)(t + 2) * kstep;
            const char* a3 = a2 + kstep; const char* b3 = b2 + kstep;
            PG8_LDB(B0, 0, 0); PG8_LDB(B1, 0, 1); PG8_SCHED; PG8_LDA(At, 0, 0); PG8_STAGE(PG8_SA(1, 1), a1 + hstepA, voffA);
            PG8_WAIT_V(8); PG8_WAIT_L(0); PG8_BAR; PG8_MMA(0, 0, At, B0); PG8_MMA(0, 1, At, B1); PG8_BAR; PG8_SCHED;
            PG8_LDA(At, 0, 1); PG8_STAGE(PG8_SB(0, 0), b2, voffB); PG8_STAGE(PG8_SB(0, 1), b2 + hstepB, voffB); PG8_STAGE(PG8_SA(0, 0), a2, voffA);
            PG8_WAIT_V(8); PG8_WAIT_L(0); PG8_BAR; PG8_MMA(1, 0, At, B0); PG8_MMA(1, 1, At, B1); PG8_BAR; PG8_SCHED;
            PG8_LDB(B0, 1, 0); PG8_LDB(B1, 1, 1); PG8_SCHED; PG8_LDA(At, 1, 0); PG8_STAGE(PG8_SA(0, 1), a2 + hstepA, voffA);
            PG8_WAIT_V(8); PG8_WAIT_L(0); PG8_BAR; PG8_MMA(0, 0, At, B0); PG8_MMA(0, 1, At, B1); PG8_BAR; PG8_SCHED;
            PG8_LDA(At, 1, 1); PG8_STAGE(PG8_SB(1, 0), b3, voffB); PG8_STAGE(PG8_SB(1, 1), b3 + hstepB, voffB); PG8_STAGE(PG8_SA(1, 0), a3, voffA);
            PG8_WAIT_V(8); PG8_WAIT_L(0); PG8_BAR; PG8_MMA(1, 0, At, B0); PG8_MMA(1, 1, At, B1); PG8_BAR; PG8_SCHED;
        }
        if (wr == 0) PG8_BAR;
        E(acc, cur, wr, wc, fr, fq);
        if (!has_next) break;
#pragma unroll
        for (int a = 0; a < 2; ++a)
#pragma unroll
            for (int b = 0; b < 2; ++b)
#pragma unroll
                for (int m = 0; m < 4; ++m)
#pragma unroll
                    for (int n = 0; n < 2; ++n) acc[a][b][m][n] = (f32x4){0.f, 0.f, 0.f, 0.f};
        cur = nxt; cA = nA; cB = nB; ++ui;
        if (wr == 1) PG8_BAR;
    }
    PG8_WAIT_V(0);
    PG8_BAR;
#undef PG8_SA
#undef PG8_SB
#undef PG8_STAGE
#undef PG8_LDA
#undef PG8_LDB
#undef PG8_MMA
#undef PG8_WAIT_V
#undef PG8_WAIT_L
#undef PG8_BAR
#undef PG8_SCHED
}

#define EPI_LOOP_BEGIN _Pragma("unroll") for (int ai = 0; ai < 2; ++ai) _Pragma("unroll") for (int m = 0; m < 4; ++m) { const int row = u.pm * 256 + ai * 128 + wr * 64 + m * 16 + fr;
#define EPI_BJ_BEGIN _Pragma("unroll") for (int bj = 0; bj < 2; ++bj) { const int lc = bj * 128 + wc * 32 + 8 * fq; const f32x4 v0 = acc[ai][bj][m][0], v1 = acc[ai][bj][m][1];
#define EPI_END __builtin_amdgcn_sched_barrier(0); } }

struct EpiProj {
    bf16_t* P1; bf16_t* PM; float* PS; float* SSQ; bf16_t* VTF; bf16_t* VTG;
    DI void operator()(const f32x4 (&acc)[2][2][4][2], const Unit& u, int wr, int wc, int fr, int fq) const {
        const int pn = u.pn;
        if (u.aux != 0) {
            EPI_LOOP_BEGIN
                EPI_BJ_BEGIN
                    const int tok = u.pn * 256 + lc;
                    if (u.aux == 1) *(bf16x8*)(VTF + ((size_t)(tok >> 12) * 1024 + (row - C_FV)) * 4096 + (tok & 4095)) = pack44(v0, v1);
                    else *(bf16x8*)(VTG + ((size_t)(tok >> 6) * 1024 + (row - C_GV)) * 64 + (tok & 63)) = pack44(v0, v1);
            EPI_END
        } else if (pn < 46) {
            const bool stat = (pn >= 38 && pn < 42);
            EPI_LOOP_BEGIN
                float ss = 0.f;
                EPI_BJ_BEGIN
                    *(bf16x8*)(P1 + (size_t)row * NP1 + pn * 256 + lc) = pack44(v0, v1);
                    ss += v0[0] * v0[0] + v0[1] * v0[1] + v0[2] * v0[2] + v0[3] * v0[3] + v1[0] * v1[0] + v1[1] * v1[1] + v1[2] * v1[2] + v1[3] * v1[3];
                    __builtin_amdgcn_sched_barrier(0);
                }
                if (stat && SSQ) { ss += __shfl_xor(ss, 16); ss += __shfl_xor(ss, 32); if (fq == 0) SSQ[(row * 2 + (pn >= 40 ? 1 : 0)) * 8 + (pn & 1) * 4 + wc] = ss; }
            }
        } else if (pn < 78) {
            EPI_LOOP_BEGIN
                EPI_BJ_BEGIN
                    f32x4 a = {sigm(v0[0]), sigm(v0[1]), sigm(v0[2]), sigm(v0[3])}, b = {sigm(v1[0]), sigm(v1[1]), sigm(v1[2]), sigm(v1[3])};
                    *(bf16x8*)(PM + (size_t)row * NPM + (pn - 46) * 256 + lc) = pack44(a, b);
            EPI_END
        } else {
            EPI_LOOP_BEGIN
                EPI_BJ_BEGIN
                    if (lc < 128) { *(f32x4*)(PS + (size_t)row * 128 + lc) = v0; *(f32x4*)(PS + (size_t)row * 128 + lc + 4) = v1; }
            EPI_END
        }
    }
};
struct EpiMla {
    const float* SSQ; bf16_t* QM; bf16_t* KN;
    DI void operator()(const f32x4 (&acc)[2][2][4][2], const Unit& u, int wr, int wc, int fr, int fq) const {
        const bool isq = u.aux < 6;
        bf16_t* dst = isq ? QM : KN; const int ld = isq ? 1536 : 1024;
#pragma unroll
        for (int ai = 0; ai < 2; ++ai) {
            f32x4 sa[4], sb[4];
#pragma unroll
            for (int m = 0; m < 4; ++m) { const int row = u.pm * 256 + ai * 128 + wr * 64 + m * 16 + fr;
                sa[m] = *(const f32x4*)(SSQ + (row * 2 + (isq ? 0 : 1)) * 8); sb[m] = *(const f32x4*)(SSQ + (row * 2 + (isq ? 0 : 1)) * 8 + 4); }
#pragma unroll
            for (int m = 0; m < 4; ++m) { const int row = u.pm * 256 + ai * 128 + wr * 64 + m * 16 + fr;
                const float rs = rsqrtf((((sa[m][0] + sa[m][1]) + (sa[m][2] + sa[m][3])) + ((sb[m][0] + sb[m][1]) + (sb[m][2] + sb[m][3]))) * (1.f / 512.f) + EPS);
#pragma unroll
                for (int bj = 0; bj < 2; ++bj) { const int lc = bj * 128 + wc * 32 + 8 * fq;
                    *(bf16x8*)(dst + (size_t)row * ld + u.pn * 256 + lc) = pack44(acc[ai][bj][m][0] * rs, acc[ai][bj][m][1] * rs); __builtin_amdgcn_sched_barrier(0); } }
        }
    }
};
struct EpiMlaV {
    const float* SSQ; bf16_t* VTM;
    DI void operator()(const f32x4 (&acc)[2][2][4][2], const Unit& u, int wr, int wc, int fr, int fq) const {
#pragma unroll
        for (int bj = 0; bj < 2; ++bj) { const int tok = u.pn * 256 + bj * 128 + wc * 32 + 8 * fq; const int bb = tok >> 12, s = tok & 4095;
            float rs[8];
#pragma unroll
            for (int e = 0; e < 8; ++e) { const f32x4 sa = *(const f32x4*)(SSQ + ((tok + e) * 2 + 1) * 8), sb = *(const f32x4*)(SSQ + ((tok + e) * 2 + 1) * 8 + 4);
                rs[e] = rsqrtf((((sa[0] + sa[1]) + (sa[2] + sa[3])) + ((sb[0] + sb[1]) + (sb[2] + sb[3]))) * (1.f / 512.f) + EPS); }
#pragma unroll
            for (int ai = 0; ai < 2; ++ai)
#pragma unroll
                for (int m = 0; m < 4; ++m) { const int row = u.pm * 256 + ai * 128 + wr * 64 + m * 16 + fr;
                    const f32x4 v0 = acc[ai][bj][m][0], v1 = acc[ai][bj][m][1];
                    const f32x4 a = {v0[0] * rs[0], v0[1] * rs[1], v0[2] * rs[2], v0[3] * rs[3]}, b = {v1[0] * rs[4], v1[1] * rs[5], v1[2] * rs[6], v1[3] * rs[7]};
                    *(bf16x8*)(VTM + ((size_t)bb * 1024 + row) * 4096 + s) = pack44(a, b); __builtin_amdgcn_sched_barrier(0); } }
    }
};
struct EpiMerge {
    const bf16_t* PM; float* MIXF; bf16_t* MIXB;
    DI void operator()(const f32x4 (&acc)[2][2][4][2], const Unit& u, int wr, int wc, int fr, int fq) const {
        const int br = u.aux;
#pragma unroll
        for (int ai = 0; ai < 2; ++ai) {
            bf16x8 gt[4][2], pv[4][2];
#pragma unroll
            for (int m = 0; m < 4; ++m)
#pragma unroll
                for (int bj = 0; bj < 2; ++bj) { const int row = u.pm * 256 + ai * 128 + wr * 64 + m * 16 + fr, gc = u.pn * 256 + bj * 128 + wc * 32 + 8 * fq;
                    gt[m][bj] = *(const bf16x8*)(PM + (size_t)row * NPM + br * 2048 + gc);
                    if (br != 0) pv[m][bj] = *(const bf16x8*)(MIXB + (size_t)row * 2048 + gc); }
#pragma unroll
            for (int m = 0; m < 4; ++m)
#pragma unroll
                for (int bj = 0; bj < 2; ++bj) { const int row = u.pm * 256 + ai * 128 + wr * 64 + m * 16 + fr, gc = u.pn * 256 + bj * 128 + wc * 32 + 8 * fq;
                    const f32x4 v0 = acc[ai][bj][m][0], v1 = acc[ai][bj][m][1]; float g[8]; unpack8(gt[m][bj], g);
                    f32x4 a = {v0[0] * g[0], v0[1] * g[1], v0[2] * g[2], v0[3] * g[3]}, b = {v1[0] * g[4], v1[1] * g[5], v1[2] * g[6], v1[3] * g[7]};
                    if (br != 0) { float p[8]; unpack8(pv[m][bj], p); a += (f32x4){p[0], p[1], p[2], p[3]}; b += (f32x4){p[4], p[5], p[6], p[7]}; }
                    *(bf16x8*)(MIXB + (size_t)row * 2048 + gc) = pack44(a, b); }
            __builtin_amdgcn_sched_barrier(0);
        }
    }
};
struct EpiOut {
    float* Y;
    DI void operator()(const f32x4 (&acc)[2][2][4][2], const Unit& u, int wr, int wc, int fr, int fq) const {
        EPI_LOOP_BEGIN
            EPI_BJ_BEGIN
                float* yp = Y + (size_t)row * 2048 + u.pn * 256 + lc; *(f32x4*)yp = v0; *(f32x4*)(yp + 4) = v1;
        EPI_END
    }
};
}

DI int win_src(int n) {
    if (n < 2560) return n;
    if (n < 5632) return n + 16;
    if (n < 8704) return n + 32;
    if (n < 10752) return n + 48;
    if (n < 19968) return n + 112;
    const int r = n - 19968;
    if (r < 16) return 2560 + r;
    if (r < 32) return 5648 + (r - 16);
    if (r < 48) return 8736 + (r - 32);
    if (r < 112) return 10800 + (r - 48);
    return -1;
}
struct WtDesc { const float* src; bf16_t* dst; const float* ks; int ld, K, k0, n0, mode; };
DI void wt_load(const WtDesc& d, int tid, f32x4 (&v)[2]) {
    const int kk = tid >> 4, c4 = (tid & 15) * 4;
    int sc = d.n0 + c4; if (d.mode == 1) sc = win_src(sc);
    if (d.mode == 2) sc = ((sc >> 7) & 7) * 256 + (sc >> 10) * 128 + (sc & 127);
#pragma unroll
    for (int p = 0; p < 2; ++p) { const int k = kk + 32 * p;
        v[p] = (f32x4){0.f, 0.f, 0.f, 0.f}; if (sc >= 0) v[p] = *(const f32x4*)(d.src + (size_t)(d.k0 + k) * d.ld + sc);
        if (d.ks) v[p] = v[p] * d.ks[d.k0 + k]; }
}
DI void wt_to_lds(int tid, const f32x4 (&v)[2], LAS float* scr) {
    const int kk = tid >> 4, c4 = (tid & 15) * 4;
#pragma unroll
    for (int p = 0; p < 2; ++p) { const int k = kk + 32 * p;
        scr[k * 65 + c4] = v[p][0]; scr[k * 65 + c4 + 1] = v[p][1]; scr[k * 65 + c4 + 2] = v[p][2]; scr[k * 65 + c4 + 3] = v[p][3]; }
}
DI void wt_write(const WtDesc& d, int tid, LAS float* scr) {
    const int n = tid >> 3, c = tid & 7; const LAS float* s = scr + (8 * c) * 65 + n;
    u32x4 o; o.x = pk2(s[0], s[65]); o.y = pk2(s[2 * 65], s[3 * 65]); o.z = pk2(s[4 * 65], s[5 * 65]); o.w = pk2(s[6 * 65], s[7 * 65]);
    *(u32x4*)(d.dst + (size_t)(d.n0 + n) * d.K + d.k0 + 8 * c) = o;
}
DI void bt_item(const bf16_t* src, bf16_t* dst, size_t rowbase, int rowlen, int pos0, LAS bf16_t* scr) {
    const int tid = otid(), a = tid >> 3, c8 = (tid & 7) * 8;
    *(LAS bf16x8*)(scr + a * 72 + c8) = *(const bf16x8*)(src + (size_t)a * NP1 + c8);
    __syncthreads();
    { u32x4 o; const LAS bf16_t* s = scr + c8 * 72 + a;
      o.x = (unsigned)s[0] | ((unsigned)s[72] << 16); o.y = (unsigned)s[2 * 72] | ((unsigned)s[3 * 72] << 16);
      o.z = (unsigned)s[4 * 72] | ((unsigned)s[5 * 72] << 16); o.w = (unsigned)s[6 * 72] | ((unsigned)s[7 * 72] << 16);
      *(u32x4*)(dst + (rowbase + a) * (size_t)rowlen + pos0 + c8) = o; }
    __syncthreads();
}
DI void rms_row_to_bf16(const float* xr, const float* w, bf16_t* o, int lane) {
    f32x4 v[8]; float s = 0.f;
#pragma unroll
    for (int j = 0; j < 8; ++j) { v[j] = ((const f32x4*)xr)[lane + 64 * j]; s += v[j][0] * v[j][0] + v[j][1] * v[j][1] + v[j][2] * v[j][2] + v[j][3] * v[j][3]; }
    const float r = rsqrtf(wave_sum(s) * (1.f / 2048.f) + EPS);
#pragma unroll
    for (int j = 0; j < 8; ++j) { const f32x4 ww = ((const f32x4*)w)[lane + 64 * j]; *(u32x2*)(o + (size_t)(lane + 64 * j) * 4) = pack4(v[j] * ww * r); }
}

template <int DQK, int DV, bool FOX, bool PIPE, bool FASTSM>
DI void attn_unit(LAS unsigned char* lds, int b, int h, int qb, const unsigned char* ws) {
    constexpr int KS = DQK / 32, DT = DV / 16, NH = FOX ? 16 : 8;
    constexpr int KROWB = DQK * 2, CPR = DQK / 8, KB = 64 * KROWB, VB = DV * 128, FB = FOX ? 2048 : 0, SLOT = KB + VB + FB;
    constexpr int NS = FOX ? 4 : 3, NKI = KB / 8192, NVI = VB / 8192, PER = NKI + NVI + (FOX ? 1 : 0);
    static_assert(NS * SLOT <= MISC_OFF, "attention LDS");
    const bf16_t* P1 = (const bf16_t*)(ws + O_P1); const bf16_t* QM = (const bf16_t*)(ws + O_QM); const float* FCUM = (const float*)(ws + O_FCUM);
    const float* CS = (const float*)(ws + O_CS); const float* SN = (const float*)(ws + O_SN); bf16_t* OUT = (bf16_t*)(ws + O_OUT);
    const int tid = otid(), wave = __builtin_amdgcn_readfirstlane(tid >> 6), lane = tid & 63, r16 = lane & 15, fq = lane >> 4;
    const float sc2 = (FOX ? 0.125f : 0.07216878364870322f) * LOG2E;
    const int tq0 = b * S_ + qb * 256 + wave * 32;
    const int q0 = qb * 256 + wave * 32;
    bf16x8 qf[KS][2]; float Fq2[2] = {0.f, 0.f};
#pragma unroll
    for (int nq = 0; nq < 2; ++nq) {
        const int t = tq0 + nq * 16 + r16;
        if constexpr (FOX) {
#pragma unroll
            for (int ks = 0; ks < KS; ++ks) qf[ks][nq] = ld16(P1 + (size_t)t * NP1 + C_FQ + h * 64 + ks * 32 + fq * 8);
            Fq2[nq] = FCUM[(size_t)(b * 16 + h) * S_ + q0 + nq * 16 + r16];
        } else {
#pragma unroll
            for (int ks = 0; ks < KS; ++ks) qf[ks][nq] = ld16(QM + (size_t)t * 1536 + h * 192 + ks * 32 + fq * 8);
            float r4[8], r5[8], o4[8], o5[8]; unpack8(qf[4][nq], r4); unpack8(qf[5][nq], r5);
            const f32x4 c0 = *(const f32x4*)(CS + (size_t)t * 32 + fq * 8), c1 = *(const f32x4*)(CS + (size_t)t * 32 + fq * 8 + 4);
            const f32x4 s0 = *(const f32x4*)(SN + (size_t)t * 32 + fq * 8), s1 = *(const f32x4*)(SN + (size_t)t * 32 + fq * 8 + 4);
#pragma unroll
            for (int j = 0; j < 8; ++j) { const float c = j < 4 ? c0[j & 3] : c1[j & 3], s = j < 4 ? s0[j & 3] : s1[j & 3];
                o4[j] = r4[j] * c - r5[j] * s; o5[j] = r4[j] * s + r5[j] * c; }
            qf[4][nq] = pack8(o4); qf[5][nq] = pack8(o5);
        }
    }
    f32x4 oacc[DT][2];
#pragma unroll
    for (int d = 0; d < DT; ++d) { oacc[d][0] = (f32x4){0.f, 0.f, 0.f, 0.f}; oacc[d][1] = (f32x4){0.f, 0.f, 0.f, 0.f}; }
    float mrow[2] = {-INFINITY, -INFINITY}, lsum[2] = {0.f, 0.f};
    const int ntiles = 4 * qb + 4;
    int kt0 = 0;
    if constexpr (FOX) {
        const unsigned* nm = (const unsigned*)(ws + O_CTL) + 256 + (b * 16 + h) * 2;
        const float smax2 = sqrtf(__uint_as_float(nm[0]) * __uint_as_float(nm[1])) * sc2, thr = -(2.f * smax2 + 40.f);
        const float f0 = FCUM[(size_t)(b * 16 + h) * S_ + qb * 256];
        const bool skip = (lane < 4 * qb) && (f0 - FCUM[(size_t)(b * 16 + h) * S_ + lane * 64 + 63] < thr);
        const unsigned long long mk = __ballot(skip);
        kt0 = __builtin_amdgcn_readfirstlane((int)__builtin_ctzll(~mk));
    }
    unsigned kof[NKI], kst[NKI], vof[NVI];
#pragma unroll
    for (int i = 0; i < NKI; ++i) { const int L = (wave + 8 * i) * 64 + lane, r = L / CPR, pos = L % CPR, c = (pos & ~7) | ((pos ^ (r >> 1)) & 7);
        if constexpr (FOX) { kof[i] = (unsigned)(O_P1 + ((size_t)(b * S_ + r) * NP1 + C_FK + h * 64 + c * 8) * 2); kst[i] = 64u * NP1 * 2u; }
        else if (c < 16) { kof[i] = (unsigned)(O_KN + ((size_t)(b * S_ + r) * 1024 + h * 128 + c * 8) * 2); kst[i] = 64u * 1024u * 2u; }
        else { kof[i] = (unsigned)(O_KROPE + ((size_t)(b * S_ + r) * 64 + (c - 16) * 8) * 2); kst[i] = 64u * 64u * 2u; } }
#pragma unroll
    for (int i = 0; i < NVI; ++i) { const int L = (wave + 8 * i) * 64 + lane, dv = L >> 3, pos = L & 7, c = pos ^ ((dv >> 1) & 7);
        vof[i] = (unsigned)((FOX ? O_VTF : O_VTM) + (((size_t)(b * NH + h) * DV + dv) * S_ + c * 8) * 2); }
    const unsigned fof = (unsigned)(O_FCUM + ((size_t)(b * 16 + h) * S_ + lane) * 4);
    int klo[2], vlo[2][2];
#pragma unroll
    for (int p = 0; p < 2; ++p) klo[p] = r16 * KROWB + (((p * 4 + fq) ^ ((r16 >> 1) & 7)) * 16);
#pragma unroll
    for (int ss = 0; ss < 2; ++ss)
#pragma unroll
        for (int q = 0; q < 2; ++q) vlo[ss][q] = KB + r16 * 128 + (((4 * ss + (fq >> 1) + 2 * q) ^ ((r16 >> 1) & 7)) * 16) + 8 * (fq & 1);
#define ATT_ISSUE(kt) do { LAS unsigned char* sp = lds + ((kt) % NS) * SLOT; \
        _Pragma("unroll") for (int i = 0; i < NKI; ++i) __builtin_amdgcn_global_load_lds((const unsigned*)(ws + (kof[i] + (unsigned)(kt) * kst[i])), (LAS unsigned*)(sp + (wave + 8 * i) * 1024), 16, 0, 0); \
        _Pragma("unroll") for (int i = 0; i < NVI; ++i) __builtin_amdgcn_global_load_lds((const unsigned*)(ws + (vof[i] + (unsigned)(kt) * 128u)), (LAS unsigned*)(sp + KB + (wave + 8 * i) * 1024), 16, 0, 0); \
        if constexpr (FOX) __builtin_amdgcn_global_load_lds((const unsigned*)(ws + (fof + (unsigned)(kt) * 256u)), (LAS unsigned*)(sp + KB + VB + wave * 256), 4, 0, 0); } while (0)
#define ATT_S(kt_, SA) do { const LAS unsigned char* bp = lds + ((kt_) % NS) * SLOT; \
        _Pragma("unroll") for (int mt = 0; mt < 4; ++mt) { SA[mt][0] = (f32x4){0.f, 0.f, 0.f, 0.f}; SA[mt][1] = (f32x4){0.f, 0.f, 0.f, 0.f}; } \
        bf16x8 kf[2][4]; \
        _Pragma("unroll") for (int mt = 0; mt < 4; ++mt) kf[0][mt] = *(const LAS bf16x8*)(bp + klo[0] + (mt * 16 * KROWB)); \
        _Pragma("unroll") for (int ks = 0; ks < KS; ++ks) { \
            if (ks + 1 < KS) { _Pragma("unroll") for (int mt = 0; mt < 4; ++mt) kf[(ks + 1) & 1][mt] = *(const LAS bf16x8*)(bp + klo[(ks + 1) & 1] + (mt * 16 * KROWB + ((ks + 1) >> 1) * 128)); } \
            _Pragma("unroll") for (int mt = 0; mt < 4; ++mt) { SA[mt][0] = MFMA16(kf[ks & 1][mt], qf[ks][0], SA[mt][0]); SA[mt][1] = MFMA16(kf[ks & 1][mt], qf[ks][1], SA[mt][1]); } \
            if (!PIPE) __builtin_amdgcn_sched_barrier(0); } } while (0)
#define ATT_SOFTMAX_(kt_, SA, MASKED) do { const LAS unsigned char* bp = lds + ((kt_) % NS) * SLOT; \
        _Pragma("unroll") for (int nq = 0; nq < 2; ++nq) { \
            const int qpos = q0 + nq * 16 + r16; float mx = -INFINITY; \
            _Pragma("unroll") for (int mt = 0; mt < 4; ++mt) { f32x4 fk = {0.f, 0.f, 0.f, 0.f}; if constexpr (FOX) fk = *(const LAS f32x4*)(bp + KB + VB + wave * 256 + (mt * 16 + fq * 4) * 4); \
                _Pragma("unroll") for (int j = 0; j < 4; ++j) { float x = FOX ? SA[mt][nq][j] * sc2 + (Fq2[nq] - fk[j]) : SA[mt][nq][j] * sc2; \
                    if (MASKED) { const int kpos = (kt_) * 64 + mt * 16 + fq * 4 + j; x = (kpos <= qpos) ? x : -INFINITY; } \
                    SA[mt][nq][j] = x; mx = fmaxf(mx, x); } } \
            mx = xmax_fq(mx); \
            const float mnew = fmaxf(mrow[nq], mx), alpha = __builtin_amdgcn_exp2f(mrow[nq] - mnew); mrow[nq] = mnew; \
            float ps = 0.f; \
            _Pragma("unroll") for (int mt = 0; mt < 4; ++mt) _Pragma("unroll") for (int j = 0; j < 4; ++j) { const float p = __builtin_amdgcn_exp2f(SA[mt][nq][j] - mnew); SA[mt][nq][j] = p; ps += p; } \
            lsum[nq] = lsum[nq] * alpha + ps; \
            _Pragma("unroll") for (int d = 0; d < DT; ++d) oacc[d][nq] = oacc[d][nq] * alpha; \
            pb[0][nq] = pack44(SA[0][nq], SA[1][nq]); pb[1][nq] = pack44(SA[2][nq], SA[3][nq]); } } while (0)
#define ATT_SOFTMAX_F(kt_, SA) do { const LAS unsigned char* bp = lds + ((kt_) % NS) * SLOT; float dlt[2], rmx[2]; \
        _Pragma("unroll") for (int nq = 0; nq < 2; ++nq) { float mx = -INFINITY; \
            _Pragma("unroll") for (int mt = 0; mt < 4; ++mt) { \
                if constexpr (FOX) { const f32x4 fk = *(const LAS f32x4*)(bp + KB + VB + wave * 256 + (mt * 16 + fq * 4) * 4); \
                    _Pragma("unroll") for (int j = 0; j < 4; ++j) SA[mt][nq][j] = SA[mt][nq][j] * sc2 - fk[j]; } \
                _Pragma("unroll") for (int j = 0; j < 4; ++j) mx = fmaxf(mx, SA[mt][nq][j]); } \
            mx = xmax_fq(mx); \
            rmx[nq] = FOX ? mx + Fq2[nq] : mx * sc2; dlt[nq] = rmx[nq] - mrow[nq]; } \
        const bool fast = __all((dlt[0] <= 8.f) && (dlt[1] <= 8.f)); \
        _Pragma("unroll") for (int nq = 0; nq < 2; ++nq) { \
            const float mnew = fast ? mrow[nq] : fmaxf(mrow[nq], rmx[nq]); \
            const float alpha = __builtin_amdgcn_exp2f(mrow[nq] - mnew); \
            const float cc = FOX ? Fq2[nq] - mnew : -mnew; mrow[nq] = mnew; float ps = 0.f; \
            _Pragma("unroll") for (int mt = 0; mt < 4; ++mt) _Pragma("unroll") for (int j = 0; j < 4; ++j) { \
                const float p = __builtin_amdgcn_exp2f(FOX ? SA[mt][nq][j] + cc : SA[mt][nq][j] * sc2 + cc); SA[mt][nq][j] = p; ps += p; } \
            lsum[nq] = lsum[nq] * alpha + ps; \
            pb[0][nq] = pack44(SA[0][nq], SA[1][nq]); pb[1][nq] = pack44(SA[2][nq], SA[3][nq]); \
            if (!fast) { _Pragma("unroll") for (int d = 0; d < DT; ++d) oacc[d][nq] = oacc[d][nq] * alpha; } } \
        } while (0)
#define ATT_SOFTMAX(kt_, SA) do { if ((kt_) * 64 + 63 > q0) ATT_SOFTMAX_(kt_, SA, true); else if constexpr (FASTSM) ATT_SOFTMAX_F(kt_, SA); else ATT_SOFTMAX_(kt_, SA, false); } while (0)
#define ATT_PV(kt_) do { const LAS unsigned char* bp = lds + ((kt_) % NS) * SLOT; constexpr int NG = 2 * DT / 4; \
        s16x4 vl[2][4], vh[2][4]; \
        _Pragma("unroll") for (int q = 0; q < 4; ++q) { vl[0][q] = *(const LAS s16x4*)(bp + vlo[0][0] + q * 2048); vh[0][q] = *(const LAS s16x4*)(bp + vlo[0][1] + q * 2048); } \
        _Pragma("unroll") for (int g = 0; g < NG; ++g) { \
            if (g + 1 < NG) { const int ss1 = ((g + 1) * 4) / DT, d1 = ((g + 1) * 4) % DT; \
                _Pragma("unroll") for (int q = 0; q < 4; ++q) { vl[(g + 1) & 1][q] = *(const LAS s16x4*)(bp + vlo[ss1][0] + (d1 + q) * 2048); vh[(g + 1) & 1][q] = *(const LAS s16x4*)(bp + vlo[ss1][1] + (d1 + q) * 2048); } } \
            const int ss = (g * 4) / DT, d0 = (g * 4) % DT; \
            _Pragma("unroll") for (int q = 0; q < 4; ++q) { const bf16x8 vf = __builtin_shufflevector(vl[g & 1][q], vh[g & 1][q], 0, 1, 2, 3, 4, 5, 6, 7); \
                oacc[d0 + q][0] = MFMA16(vf, pb[ss][0], oacc[d0 + q][0]); oacc[d0 + q][1] = MFMA16(vf, pb[ss][1], oacc[d0 + q][1]); } \
            __builtin_amdgcn_sched_barrier(0); } } while (0)
#define ATT_BAR() do { asm volatile("s_waitcnt lgkmcnt(0)" ::: "memory"); __builtin_amdgcn_s_barrier(); asm volatile("" ::: "memory"); } while (0)
#pragma unroll
    for (int p = 0; p < NS - 1; ++p) ATT_ISSUE(kt0 + p);
    bf16x8 pb[2][2];
    if constexpr (PIPE) {
        static_assert(!PIPE || NS == 4, "pipelined form needs a 4-slot ring");
        asm volatile("s_waitcnt vmcnt(%0)" :: "n"(2 * PER) : "memory");
        ATT_BAR();
        f32x4 sA[4][2];
        ATT_S(kt0, sA);
        for (int kt = kt0; kt < ntiles; ++kt) {
            if (kt + 2 < ntiles) asm volatile("s_waitcnt vmcnt(%0)" :: "n"(PER) : "memory");
            else asm volatile("s_waitcnt vmcnt(0)" ::: "memory");
            ATT_BAR();
            if (kt + 3 < ntiles) ATT_ISSUE(kt + 3);
            const bool a0 = (kt * 64 <= q0 + 31), a1 = (kt + 1 < ntiles) && ((kt + 1) * 64 <= q0 + 31);
            if (a1) {
                f32x4 sB[4][2];
                if (kt * 64 + 63 > q0) { ATT_S(kt + 1, sB); ATT_SOFTMAX_(kt, sA, true); }
                else { ATT_S(kt + 1, sB); if constexpr (FASTSM) ATT_SOFTMAX_F(kt, sA); else ATT_SOFTMAX_(kt, sA, false); }
                ATT_PV(kt);
#pragma unroll
                for (int mt = 0; mt < 4; ++mt) { sA[mt][0] = sB[mt][0]; sA[mt][1] = sB[mt][1]; }
            } else if (a0) {
                ATT_SOFTMAX(kt, sA);
                ATT_PV(kt);
            }
        }
    } else {
        for (int kt = 0; kt < ntiles; ++kt) {
            if (kt + NS - 2 < ntiles) asm volatile("s_waitcnt vmcnt(%0)" :: "n"((NS - 2) * PER) : "memory");
            else asm volatile("s_waitcnt vmcnt(0)" ::: "memory");
            ATT_BAR();
            if (kt + NS - 1 < ntiles) ATT_ISSUE(kt + NS - 1);
            if (kt * 64 <= q0 + 31) {
                f32x4 sA[4][2];
                ATT_S(kt, sA);
                ATT_SOFTMAX(kt, sA);
                ATT_PV(kt);
            }
        }
    }
#undef ATT_S
#undef ATT_SOFTMAX
#undef ATT_SOFTMAX_
#undef ATT_SOFTMAX_F
#undef ATT_PV
#undef ATT_BAR
#undef ATT_ISSUE
#pragma unroll
    for (int nq = 0; nq < 2; ++nq) {
        float l = lsum[nq]; l += __shfl_xor(l, 16); l += __shfl_xor(l, 32); const float inv = 1.f / l;
        const int t = tq0 + nq * 16 + r16;
#pragma unroll
        for (int d = 0; d < DT; ++d) { const int dv0 = d * 16 + fq * 4;
            const f32x4 g = unpack4(*(const u32x2*)(P1 + (size_t)t * NP1 + (FOX ? C_FG : C_LG) + h * DV + dv0));
            f32x4 o = oacc[d][nq] * inv; o = (f32x4){o[0] * silu(g[0]), o[1] * silu(g[1]), o[2] * silu(g[2]), o[3] * silu(g[3])};
            *(u32x2*)(OUT + ((size_t)(FOX ? 1 : 3) * T_ + t) * 1024 + h * DV + dv0) = pack4(o); }
    }
}

#define XB_TMO      128
#define XB_XCNT(j)  (256  + 64 * (j))
#define XB_XSUB(j)  (1280 + 64 * (j))
#define XB_XGEN(j)  (2304 + 64 * (j))
#define XB_TOP      3328
#define XB_TOPGEN   3392
#define XCD_BAR_WORDS 3456
#define XB_SPIN_CAP (1u << 18)

DI unsigned xb_ld(unsigned* p)              { return __hip_atomic_load(p, __ATOMIC_RELAXED, __HIP_MEMORY_SCOPE_AGENT); }
DI unsigned xb_add(unsigned* p, unsigned v) { return __hip_atomic_fetch_add(p, v, __ATOMIC_RELAXED, __HIP_MEMORY_SCOPE_AGENT); }
DI unsigned xb_xcc_id() { return (unsigned)__builtin_amdgcn_s_getreg((3 << 11) | 20) & 0xFu; }
#define XB_SPIN(cond, bar) do { unsigned _sp = 0; while (cond) { __builtin_amdgcn_s_sleep(1); \
    if ((++_sp & 255u) == 0u) { if (xb_ld(&(bar)[XB_TMO])) break; if (_sp > XB_SPIN_CAP) { atomicAdd(&(bar)[XB_TMO], 1u); break; } } } } while (0)

struct XcdBarrier {
    unsigned* bar; unsigned x;
    volatile LAS unsigned* st;
};

DI XcdBarrier xcd_barrier_post(unsigned* bar, volatile LAS unsigned* st) {
    XcdBarrier b; b.bar = bar; b.x = xb_xcc_id(); b.st = st;
    if (threadIdx.x == 0) (void)xb_add(&bar[XB_XCNT(b.x)], 1u);
    return b;
}
DI void xcd_barrier_complete(unsigned* bar, unsigned x, unsigned& nloc, unsigned& nx) {
    const unsigned G = gridDim.x * gridDim.y * gridDim.z;
    unsigned sum, cnt, mine, sp = 0u;
    for (;;) {
        sum = 0u; cnt = 0u; mine = 0u;
#pragma unroll
        for (unsigned j = 0; j < 16; ++j) { const unsigned c = xb_ld(&bar[XB_XCNT(j)]); sum += c; cnt += (c > 0u) ? 1u : 0u; mine = (j == x) ? c : mine; }
        if (sum == G) break;
        __builtin_amdgcn_s_sleep(1);
        if ((++sp & 255u) == 0u) { if (xb_ld(&bar[XB_TMO])) break; if (sp > XB_SPIN_CAP) { atomicAdd(&bar[XB_TMO], 1u); break; } }
    }
    nloc = mine > 0u ? mine : 1u; nx = cnt > 0u ? cnt : 1u;
}

DI void xcd_barrier(const XcdBarrier& b) {
    asm volatile("s_waitcnt vmcnt(0)" ::: "memory");
    __syncthreads();
    if (threadIdx.x == 0) {
        unsigned* bar = b.bar;
        __builtin_amdgcn_s_waitcnt(0);
        unsigned nloc = b.st[0], nx = b.st[1];
        if (nloc == 0u) { xcd_barrier_complete(bar, b.x, nloc, nx); b.st[0] = nloc; b.st[1] = nx; }
        const unsigned old = xb_add(&bar[XB_XSUB(b.x)], 1u);
        const unsigned gen = old / nloc;
        if (old + 1u == (gen + 1u) * nloc) {
            __builtin_amdgcn_fence(__ATOMIC_RELEASE, "agent");
            asm volatile("s_waitcnt vmcnt(0)" ::: "memory");
            const unsigned og = xb_add(&bar[XB_TOP], 1u);
            const unsigned tg = og / nx;
            if (og + 1u == (tg + 1u) * nx) xb_add(&bar[XB_TOPGEN], 1u);
            else XB_SPIN(xb_ld(&bar[XB_TOPGEN]) == tg, bar);
            __builtin_amdgcn_fence(__ATOMIC_ACQUIRE, "agent");
            xb_add(&bar[XB_XGEN(b.x)], 1u);
            asm volatile("s_waitcnt vmcnt(0)" ::: "memory");
        } else {
            XB_SPIN(xb_ld(&bar[XB_XGEN(b.x)]) == gen, bar);
            __builtin_amdgcn_fence(__ATOMIC_ACQUIRE, "agent");
            asm volatile("s_waitcnt vmcnt(0)" ::: "memory");
        }
    }
    __syncthreads();
}


typedef const __attribute__((address_space(4))) unsigned char* kaptr_t;
DI const void* kaload(int off) { kaptr_t ka = (kaptr_t)__builtin_amdgcn_kernarg_segment_ptr(); asm volatile("" : "+s"(ka)); typedef const void* cvp_t; return *(const __attribute__((address_space(4))) cvp_t*)(ka + off); }
#define INP(k) ((const float*)kaload(8 * (k)))
#define x_in INP(0)
#define positions ((const int*)kaload(8))
#define pre_norm INP(2)
#define post_norm INP(3)
#define w_in INP(4)
#define conv_w INP(5)
#define conv_b INP(6)
#define dt_bias INP(7)
#define a_log INP(8)
#define d_skip INP(9)
#define ssm_norm INP(10)
#define fgate_b INP(11)
#define gla_w2 INP(12)
#define gla_b INP(13)
#define gla_norm INP(14)
#define q_norm INP(15)
#define kv_norm INP(16)
#define w_uq INP(17)
#define w_ukv INP(18)
#define w_branch INP(19)
#define w_out INP(20)
#define CTL ((unsigned*)(ws + O_CTL))
#define SSQ ((float*)(ws + O_SSQ))
#define DTV ((float*)(ws + O_DT))
#define ACUM ((float*)(ws + O_ACUM))
#define FCUM ((float*)(ws + O_FCUM))
#define CS ((float*)(ws + O_CS))
#define SN ((float*)(ws + O_SN))
#define KROPE ((bf16_t*)(ws + O_KROPE))
#define BLAST ((float*)(ws + O_BLAST))
#define PS ((float*)(ws + O_PSMALL))
#define WBT ((bf16_t*)(ws + O_WBT))
#define WOT ((bf16_t*)(ws + O_WOT))
#define WUQT ((bf16_t*)(ws + O_WUQT))
#define WUKVT ((bf16_t*)(ws + O_WUKVT))
#define P1 ((bf16_t*)(ws + O_P1))
#define PM ((bf16_t*)(ws + O_PM))
#define OUT ((bf16_t*)(ws + O_OUT))
#define WINT ((bf16_t*)(ws + O_WINT))
#define H ((bf16_t*)(ws + O_H))
#define GST ((bf16_t*)(ws + O_GST))
#define QM ((bf16_t*)(ws + O_QM))
#define KN ((bf16_t*)(ws + O_KN))
#define VTM ((bf16_t*)(ws + O_VTM))
#define VTF ((bf16_t*)(ws + O_VTF))
#define XBC ((bf16_t*)(ws + O_XBC))
#define XBCT ((bf16_t*)(ws + O_XBCT))
#define SST ((bf16_t*)(ws + O_SST))
#define KTT ((bf16_t*)(ws + O_KTT))
#define VTG ((bf16_t*)(ws + O_VTG))
#define MIXF ((float*)(ws + O_MIXF))
#define MIXB ((bf16_t*)(ws + O_MIXB))
#define Y ((float*)(ws + O_Y))
DI void phase_body(const int ph, LAS unsigned char* lds, const int rep = 0) {
    LAS float* scrf = (LAS float*)lds; LAS bf16_t* scrb = (LAS bf16_t*)lds;
    {
        const int l = ph == 0 ? 0 : (ph - 1) >> 3, kph = ph == 0 ? -1 : (ph - 1) & 7;
        unsigned char* ws = (unsigned char*)kaload(176);
        float* const outp = (float*)kaload(168);
        const int tid = otid(), lane = tid & 63, wave = __builtin_amdgcn_readfirstlane(tid >> 6), r16 = lane & 15, fq = lane >> 4;
        const int G = osg(gridDim.x), bid = osg(blockIdx.x);
        unsigned* ctr = CTL + 16 + ph + 32 * rep;
        if ((kph == -1 || kph == 7) && (PHMASK & 0x100)) {
            const int lw = (kph == -1) ? 0 : l + 1;
            if (kph == -1) {
                if (bid == 0 && tid < 128) CTL[tid] = 0u;
                const int NI = 2 * (2048 + 1024 + 192 + 256);
#define WT_DECODE(it_, d_) do { const int ll = (it_) / 3520; int r = (it_) % 3520; \
                    if (r < 2048) { const int br = r / 512, q = r % 512; d_ = WtDesc{w_branch + (size_t)(ll * 4 + br) * 1024 * 2048, WBT + ((size_t)ll * 8192 + br * 2048) * 1024, nullptr, 2048, 1024, (q % 16) * 64, (q / 16) * 64, 0}; } \
                    else if (r < 3072) { r -= 2048; d_ = WtDesc{w_out + (size_t)ll * 2048 * 2048, WOT + (size_t)ll * 2048 * 2048, nullptr, 2048, 2048, (r % 32) * 64, (r / 32) * 64, 0}; } \
                    else if (r < 3264) { r -= 3072; d_ = WtDesc{w_uq + (size_t)ll * 512 * 1536, WUQT + (size_t)ll * 1536 * 512, q_norm + ll * 512, 1536, 512, (r % 8) * 64, (r / 8) * 64, 0}; } \
                    else { r -= 3264; d_ = WtDesc{w_ukv + (size_t)ll * 512 * 2048, WUKVT + (size_t)ll * 2048 * 512, kv_norm + ll * 512, 2048, 512, (r % 8) * 64, (r / 8) * 64, 2}; } } while (0)
                { int it = bid; WtDesc d{}; f32x4 v[2];
                  if (it < NI) { WT_DECODE(it, d); wt_load(d, tid, v); }
                  while (it < NI) {
                      wt_to_lds(tid, v, scrf); __syncthreads();
                      const int nx = it + G; WtDesc dn{}; if (nx < NI) { WT_DECODE(nx, dn); wt_load(dn, tid, v); }
                      wt_write(d, tid, scrf); __syncthreads();
                      d = dn; it = nx; } }
#undef WT_DECODE
                for (int row = bid * 8 + wave; row < T_; row += G * 8) rms_row_to_bf16(x_in + (size_t)row * DM, pre_norm, H + (size_t)row * DM, lane);
            } else {
                const float* xsrc = (l == 0) ? x_in : outp;
                for (int row = bid * 8 + wave; row < T_; row += G * 8) {
                    f32x4 v[8]; float s = 0.f;
#pragma unroll
                    for (int j = 0; j < 8; ++j) { v[j] = ((const f32x4*)(Y + (size_t)row * DM))[lane + 64 * j]; s += v[j][0] * v[j][0] + v[j][1] * v[j][1] + v[j][2] * v[j][2] + v[j][3] * v[j][3]; }
                    const float r = rsqrtf(wave_sum(s) * (1.f / 2048.f) + EPS); float s2 = 0.f;
#pragma unroll
                    for (int j = 0; j < 8; ++j) { const f32x4 pw = ((const f32x4*)(post_norm + l * DM))[lane + 64 * j]; const f32x4 xv = ((const f32x4*)(xsrc + (size_t)row * DM))[lane + 64 * j];
                        v[j] = xv + v[j] * pw * r; ((f32x4*)(outp + (size_t)row * DM))[lane + 64 * j] = v[j]; s2 += v[j][0] * v[j][0] + v[j][1] * v[j][1] + v[j][2] * v[j][2] + v[j][3] * v[j][3]; }
                    if (l == 0) { const float r2 = rsqrtf(wave_sum(s2) * (1.f / 2048.f) + EPS);
#pragma unroll
                        for (int j = 0; j < 8; ++j) { const f32x4 ww = ((const f32x4*)(pre_norm + DM))[lane + 64 * j]; *(u32x2*)(H + (size_t)row * DM + (size_t)(lane + 64 * j) * 4) = pack4(v[j] * ww * r2); } }
                }
            }
            if (lw < 2) {
                if (bid == 0 && tid < 128) CTL[256 + tid] = 0u;
                { int it = bid; const int NI = 316 * 32; const float* wsrc = w_in + (size_t)lw * 2048 * NIN; bf16_t* wdst = WINT; WtDesc d{}; f32x4 v[2];
                  if (it < NI) { d = WtDesc{wsrc, wdst, nullptr, NIN, 2048, (it % 32) * 64, (it / 32) * 64, 1}; wt_load(d, tid, v); }
                  while (it < NI) {
                      wt_to_lds(tid, v, scrf); __syncthreads();
                      const int nx = it + G; WtDesc dn{}; if (nx < NI) { dn = WtDesc{wsrc, wdst, nullptr, NIN, 2048, (nx % 32) * 64, (nx / 32) * 64, 1}; wt_load(dn, tid, v); }
                      wt_write(d, tid, scrf); __syncthreads();
                      d = dn; it = nx; } }
            }
        } else if (kph == 0 && (PHMASK >> 0 & 1)) {
            pg8::ProjOrder S{(const char*)H, (const char*)WINT, G, bid};
            pg8::EpiProj E{P1, PM, PS, rep ? nullptr : SSQ, VTF, VTG};
            pg8::gemm_phase(lds, 2048, 2048, 2048, S, E);
        } else if (kph == 1 && (PHMASK >> 1 & 1)) {
#ifndef NO_M1GEMM
            { pg8::MlaOrder S{(const char*)P1, (const char*)(WUQT + (size_t)l * 1536 * 512), (const char*)(WUKVT + (size_t)l * 2048 * 512), G, bid};
              pg8::EpiMla E{SSQ, QM, KN};
              pg8::gemm_phase(lds, 512, NP1, 512, S, E); }
            { pg8::MlaVOrder S{(const char*)P1, (const char*)(WUKVT + ((size_t)l * 2048 + 1024) * 512), G, bid};
              pg8::EpiMlaV E{SSQ, VTM};
              pg8::gemm_phase(lds, 512, 512, NP1, S, E); }
#endif
            constexpr int N_C = 8, N_A = 384, N_E = 256, N_B = 128, N_N = 256, N_D = 1024;
            constexpr int NTOT = N_C + N_A + N_E + N_B + N_N + N_D;
            for (;;) {
                int it = next_item(ctr, lds); if (it >= NTOT) break;
                if (it < N_C) { LANEIDS
                    const int b = it >> 1, h = (it & 1) * 8 + wave; const float fb = fgate_b[l * 16 + h];
                    float v[64];
#pragma unroll
                    for (int j = 0; j < 64; ++j) v[j] = PS[(size_t)(b * S_ + 64 * lane + j) * 128 + 16 + h];
#pragma unroll
                    for (int j = 0; j < 64; ++j) { v[j] = logsig(v[j] + fb); if (j) v[j] += v[j - 1]; }
                    float tot = v[63];
#pragma unroll
                    for (int o = 1; o < 64; o <<= 1) { const float y = __shfl_up(tot, o); if (lane >= o) tot += y; }
                    const float off = tot - v[63];
#pragma unroll
                    for (int j = 0; j < 64; j += 4) *(f32x4*)(FCUM + (size_t)(b * 16 + h) * S_ + 64 * lane + j) = (f32x4){(v[j] + off) * LOG2E, (v[j + 1] + off) * LOG2E, (v[j + 2] + off) * LOG2E, (v[j + 3] + off) * LOG2E};
                    continue; }
                it -= N_C;
                if (it < N_A) { LANEIDS
                    const int cgp = it % 3, bc = it / 3, ch = cgp * 512 + tid, t0 = bc * 128; const bool first = (bc & 31) == 0;
                    const float w0 = conv_w[(size_t)l * 4 * 1536 + ch], w1 = conv_w[(size_t)l * 4 * 1536 + 1536 + ch], w2 = conv_w[(size_t)l * 4 * 1536 + 2 * 1536 + ch], w3 = conv_w[(size_t)l * 4 * 1536 + 3 * 1536 + ch];
                    const float cb = conv_b[l * 1536 + ch];
                    float xm3 = 0.f, xm2 = 0.f, xm1 = 0.f;
                    if (!first) { xm3 = bf1(P1[(size_t)(t0 - 3) * NP1 + C_XBC + ch]); xm2 = bf1(P1[(size_t)(t0 - 2) * NP1 + C_XBC + ch]); xm1 = bf1(P1[(size_t)(t0 - 1) * NP1 + C_XBC + ch]); }
                    for (int l16 = 0; l16 < 8; ++l16) { float xi[16], oa[8], ob[8];
#pragma unroll
                        for (int i = 0; i < 16; ++i) xi[i] = bf1(P1[(size_t)(t0 + l16 * 16 + i) * NP1 + C_XBC + ch]);
#pragma unroll
                        for (int i = 0; i < 16; ++i) { const int t = t0 + l16 * 16 + i; const float xin = xi[i];
                            const float y = cb + w0 * xm3 + w1 * xm2 + w2 * xm1 + w3 * xin; const float a = silu(y); if (i < 8) oa[i] = a; else ob[i - 8] = a;
                            XBC[(size_t)t * 1536 + ch] = (bf16_t)f2bf(a); xm3 = xm2; xm2 = xm1; xm1 = xin; }
                        if (ch < 1280) { *(bf16x8*)(XBCT + ((size_t)bc * 1280 + ch) * 128 + l16 * 16) = pack8(oa); *(bf16x8*)(XBCT + ((size_t)bc * 1280 + ch) * 128 + l16 * 16 + 8) = pack8(ob); } }
                    continue; }
                it -= N_A;
                if (it < N_E) { LANEIDS
                    const int col = tid, t0 = it * 64; float w2r[16];
#pragma unroll
                    for (int r = 0; r < 16; ++r) w2r[r] = gla_w2[(size_t)l * 16 * 512 + r * 512 + col];
                    const float gb = gla_b[l * 512 + col]; float cum = 0.f;
                    for (int j16 = 0; j16 < 4; ++j16) { float z[16], qr[16], kr[16], ka[8], kb[8];
#pragma unroll
                        for (int i = 0; i < 16; ++i) { const int t = t0 + j16 * 16 + i;
                            qr[i] = bf1(P1[(size_t)t * NP1 + C_GQ + col]); kr[i] = bf1(P1[(size_t)t * NP1 + C_GK + col]);
                            float zz = gb;
#pragma unroll
                            for (int r4 = 0; r4 < 4; ++r4) { const f32x4 pv = *(const f32x4*)(PS + (size_t)t * 128 + 32 + r4 * 4);
                                zz += pv[0] * w2r[r4 * 4] + pv[1] * w2r[r4 * 4 + 1] + pv[2] * w2r[r4 * 4 + 2] + pv[3] * w2r[r4 * 4 + 3]; }
                            z[i] = zz; }
#pragma unroll
                        for (int i = 0; i < 16; ++i) { const int t = t0 + j16 * 16 + i;
                            cum += logsig(z[i]) * (1.f / 16.f);
                            const float qt = qr[i] * 0.08838834764831845f * __expf(cum), kt = kr[i] * __expf(-cum);
                            P1[(size_t)t * NP1 + C_GQ + col] = (bf16_t)f2bf(qt); P1[(size_t)t * NP1 + C_GK + col] = (bf16_t)f2bf(kt);
                            if (i < 8) ka[i] = kt; else kb[i - 8] = kt; }
                        *(bf16x8*)(KTT + ((size_t)it * 512 + col) * 64 + j16 * 16) = pack8(ka); *(bf16x8*)(KTT + ((size_t)it * 512 + col) * 64 + j16 * 16 + 8) = pack8(kb); }
                    BLAST[(size_t)it * 512 + col] = cum;
                    continue; }
                it -= N_E;
                if (it < N_B) { LANEIDS
                    const int t0 = it * 128;
#pragma unroll
                    for (int hh = 0; hh < 2; ++hh) { const int h = wave * 2 + hh; const float a = -__expf(a_log[l * 16 + h]), db = dt_bias[l * 16 + h];
                        const float d0 = softplus_(PS[(size_t)(t0 + 2 * lane) * 128 + h] + db), d1 = softplus_(PS[(size_t)(t0 + 2 * lane + 1) * 128 + h] + db);
                        const float c0 = d0 * a, c1 = c0 + d1 * a; float v = c1;
#pragma unroll
                        for (int o = 1; o < 64; o <<= 1) { const float y = __shfl_up(v, o); if (lane >= o) v += y; }
                        const float pre = v - c1;
                        DTV[(size_t)(t0 + 2 * lane) * 16 + h] = d0; DTV[(size_t)(t0 + 2 * lane + 1) * 16 + h] = d1;
                        ACUM[(size_t)(t0 + 2 * lane) * 16 + h] = pre + c0; ACUM[(size_t)(t0 + 2 * lane + 1) * 16 + h] = pre + c1; }
                    continue; }
                it -= N_B;
                if (it < N_N) { LANEIDS
                    const int hh = tid & 15, t0 = it * 64, b = t0 >> 12; float qm = 0.f, km = 0.f;
#pragma unroll
                    for (int p = 0; p < 2; ++p) { const int t = t0 + p * 32 + (tid >> 4); float qs = 0.f, ks = 0.f;
#pragma unroll
                        for (int c = 0; c < 8; ++c) { float a[8], k8[8]; unpack8(ld16(P1 + (size_t)t * NP1 + C_FQ + hh * 64 + c * 8), a); unpack8(ld16(P1 + (size_t)t * NP1 + C_FK + hh * 64 + c * 8), k8);
#pragma unroll
                            for (int e = 0; e < 8; ++e) { qs += a[e] * a[e]; ks += k8[e] * k8[e]; } }
                        qm = fmaxf(qm, qs); km = fmaxf(km, ks); }
                    qm = fmaxf(qm, __shfl_xor(qm, 16)); qm = fmaxf(qm, __shfl_xor(qm, 32)); km = fmaxf(km, __shfl_xor(km, 16)); km = fmaxf(km, __shfl_xor(km, 32));
                    if (lane < 16) { atomicMax(CTL + 256 + (b * 16 + hh) * 2, __float_as_uint(qm)); atomicMax(CTL + 256 + (b * 16 + hh) * 2 + 1, __float_as_uint(km)); }
                    continue; }
                it -= N_N;
                { LANEIDS
                    const int t = it * 16 + (tid >> 5), j = tid & 31;
                    const float invf = exp2f(-(float)j * 0.41524101186092029f);
                    const float ang = (float)positions[t] * invf;
                    double rev = (double)ang * 0.15915494309189535; rev -= floor(rev + 0.5);
                    const float fr_ = (float)rev; const float c = __builtin_amdgcn_cosf(fr_), s = __builtin_amdgcn_sinf(fr_);
                    CS[(size_t)t * 32 + j] = c; SN[(size_t)t * 32 + j] = s;
                    const float lo = PS[(size_t)t * 128 + 48 + j], hi = PS[(size_t)t * 128 + 80 + j];
                    KROPE[(size_t)t * 64 + j] = (bf16_t)f2bf(lo * c - hi * s); KROPE[(size_t)t * 64 + 32 + j] = (bf16_t)f2bf(lo * s + hi * c);
                    continue; }
            }
        } else if (kph == 2 && (PHMASK >> 2 & 1)) {
            constexpr int N_M = 512, N_X = 1024, N_S = 2048, N_K = 1024, NTOT = N_M + N_X + N_S + N_K;
            for (;;) {
                int it = next_item(ctr, lds); if (it >= NTOT) break;
                if (it < N_M) { const int qb = 15 - (it >> 5), rem = it & 31;
                    attn_unit<192, 128, false, false, MLA_FAST>(lds, rem >> 3, rem & 7, qb, ws); continue; }
                it -= N_M;
                if (it < N_X) { const int qb = 15 - (it >> 6), rem = it & 63;
                    attn_unit<64, 64, true, true, FOX_FAST>(lds, rem >> 4, rem & 15, qb, ws); continue; }
                it -= N_X;
                if (it < N_S) { LANEIDS
                    const int h = it & 15, chunk = it >> 4, t0 = chunk * 128, g = h >> 3;
                    const float alast = ACUM[(size_t)(t0 + 127) * 16 + h];
                    f32x4 acc[4];
#pragma unroll
                    for (int p = 0; p < 4; ++p) acc[p] = (f32x4){0.f, 0.f, 0.f, 0.f};
#pragma unroll
                    for (int ks = 0; ks < 4; ++ks) {
                        float bv[8]; unpack8(ld16(XBCT + ((size_t)chunk * 1280 + 1024 + g * 128 + 16 * wave + r16) * 128 + ks * 32 + fq * 8), bv);
#pragma unroll
                        for (int i = 0; i < 8; ++i) { const int tl = t0 + ks * 32 + fq * 8 + i; bv[i] *= DTV[(size_t)tl * 16 + h] * __expf(alast - ACUM[(size_t)tl * 16 + h]); }
                        const bf16x8 bw = pack8(bv);
#pragma unroll
                        for (int p = 0; p < 4; ++p) acc[p] = MFMA16(bw, ld16(XBCT + ((size_t)chunk * 1280 + h * 64 + 16 * p + r16) * 128 + ks * 32 + fq * 8), acc[p]);
                    }
#pragma unroll
                    for (int p = 0; p < 4; ++p) *(u32x2*)(SST + ((size_t)chunk * 16 + h) * 8192 + (16 * p + r16) * 128 + 16 * wave + 4 * fq) = pack4(acc[p]);
                    continue; }
                it -= N_S;
                { LANEIDS
                    const int gc = it >> 2, h = it & 3, b = gc >> 6, c = gc & 63, bh = b * 4 + h;
                    bf16x8 kf[2];
#pragma unroll
                    for (int ks = 0; ks < 2; ++ks) kf[ks] = ld16(KTT + ((size_t)gc * 512 + h * 128 + 16 * wave + r16) * 64 + ks * 32 + fq * 8);
                    const f32x4 eb = *(const f32x4*)(BLAST + (size_t)gc * 512 + h * 128 + 16 * wave + 4 * fq);
                    const f32x4 ee = {__expf(eb[0]), __expf(eb[1]), __expf(eb[2]), __expf(eb[3])};
#pragma unroll 4
                    for (int et = 0; et < 16; ++et) { f32x4 acc = {0.f, 0.f, 0.f, 0.f};
#pragma unroll
                        for (int ks = 0; ks < 2; ++ks) acc = MFMA16(kf[ks], ld16(VTG + ((size_t)gc * 1024 + h * 256 + 16 * et + r16) * 64 + ks * 32 + fq * 8), acc);
                        *(u32x2*)(GST + (((size_t)bh * 64 + c) * 256 + 16 * et + r16) * 128 + 16 * wave + 4 * fq) = pack4(acc * ee); }
                }
            }
        } else if (kph == 3 && (PHMASK >> 3 & 1)) {
            for (int it = bid; it < 256; it += G) {
                if (it < 128) { const int e8 = (it * 512 + tid) * 8, bh = e8 >> 13, off = e8 & 8191, b = bh >> 4, h = bh & 15;
                    float st[8];
#pragma unroll
                    for (int i = 0; i < 8; ++i) st[i] = 0.f;
                    for (int cg8 = 0; cg8 < 4; ++cg8) { bf16x8 vv[8]; float dec[8];
#pragma unroll
                        for (int q = 0; q < 8; ++q) { const int c = cg8 * 8 + q; vv[q] = *(const bf16x8*)(SST + ((size_t)(b * 32 + c) * 16 + h) * 8192 + off); dec[q] = ACUM[(size_t)(b * S_ + c * 128 + 127) * 16 + h]; }
#pragma unroll
                        for (int q = 0; q < 8; ++q) { const int c = cg8 * 8 + q; float v[8]; unpack8(vv[q], v); const float d = __expf(dec[q]);
                            *(bf16x8*)(SST + ((size_t)(b * 32 + c) * 16 + h) * 8192 + off) = pack8(st);
#pragma unroll
                            for (int i = 0; i < 8; ++i) st[i] = st[i] * d + v[i]; } }
                } else { const int e8 = ((it - 128) * 512 + tid) * 8, bh = e8 >> 15, off = e8 & 32767, d0 = off & 127, b = bh >> 2, h = bh & 3;
                    float st[8];
#pragma unroll
                    for (int i = 0; i < 8; ++i) st[i] = 0.f;
                    for (int cg8 = 0; cg8 < 8; ++cg8) { bf16x8 vv[8]; f32x4 e0[8], e1[8];
#pragma unroll
                        for (int q = 0; q < 8; ++q) { const int c = cg8 * 8 + q; vv[q] = *(const bf16x8*)(GST + ((size_t)bh * 64 + c) * 32768 + off);
                            e0[q] = *(const f32x4*)(BLAST + (size_t)(b * 64 + c) * 512 + h * 128 + d0); e1[q] = *(const f32x4*)(BLAST + (size_t)(b * 64 + c) * 512 + h * 128 + d0 + 4); }
#pragma unroll
                        for (int q = 0; q < 8; ++q) { const int c = cg8 * 8 + q; float v[8]; unpack8(vv[q], v);
                            *(bf16x8*)(GST + ((size_t)bh * 64 + c) * 32768 + off) = pack8(st);
#pragma unroll
                            for (int i = 0; i < 8; ++i) st[i] = st[i] * __expf(i < 4 ? e0[q][i & 3] : e1[q][i & 3]) + v[i]; } }
                }
            }
        } else if (kph == 4 && (PHMASK >> 4 & 1)) {
            constexpr int N_S = 256, N_G = 1024, NTOT = N_S + N_G;
            for (;;) {
                int it = next_item(ctr, lds); if (it >= NTOT) break;
                if (it < N_S) { LANEIDS
                    const int g = it & 1, chunk = it >> 1, t0 = chunk * 128;
                    LAS float* sAc = (LAS float*)lds; LAS float* sDt = sAc + 1024;
                    for (int i = tid; i < 1024; i += 512) { const int hh = i >> 7, s = i & 127; sAc[i] = ACUM[(size_t)(t0 + s) * 16 + g * 8 + hh]; sDt[i] = DTV[(size_t)(t0 + s) * 16 + g * 8 + hh]; }
                    __syncthreads();
                    const int tl = t0 + 16 * wave + r16, lpos = 16 * wave + r16;
                    bf16x8 cf[4];
#pragma unroll
                    for (int ks = 0; ks < 4; ++ks) cf[ks] = ld16(XBC + (size_t)tl * 1536 + 1280 + g * 128 + ks * 32 + fq * 8);
                    f32x4 gacc[8];
#pragma unroll
                    for (int mt = 0; mt < 8; ++mt) { gacc[mt] = (f32x4){0.f, 0.f, 0.f, 0.f};
                        if (mt <= wave) {
#pragma unroll
                            for (int ks = 0; ks < 4; ++ks) gacc[mt] = MFMA16(ld16(XBC + (size_t)(t0 + 16 * mt + r16) * 1536 + 1024 + g * 128 + ks * 32 + fq * 8), cf[ks], gacc[mt]); } }
                    float ssq = 0.f;
#pragma unroll 2
                    for (int hh = 0; hh < 8; ++hh) { const int h = g * 8 + hh;
                        const float al = sAc[hh * 128 + lpos], el = __expf(al);
                        f32x4 acc1[4], acc2[4];
#pragma unroll
                        for (int p = 0; p < 4; ++p) { acc1[p] = (f32x4){0.f, 0.f, 0.f, 0.f}; acc2[p] = (f32x4){0.f, 0.f, 0.f, 0.f}; }
#pragma unroll
                        for (int ss = 0; ss < 4; ++ss) if (2 * ss <= wave) {
                            f32x4 wv[2];
#pragma unroll
                            for (int q = 0; q < 2; ++q) { const int mt = 2 * ss + q; const f32x4 as = *(const LAS f32x4*)(sAc + hh * 128 + 16 * mt + 4 * fq), ds = *(const LAS f32x4*)(sDt + hh * 128 + 16 * mt + 4 * fq);
#pragma unroll
                                for (int j = 0; j < 4; ++j) { const int spos = 16 * mt + 4 * fq + j; wv[q][j] = (spos <= lpos) ? gacc[mt][j] * __expf(fminf(al - as[j], 0.f)) * ds[j] : 0.f; } }
                            const bf16x8 wp = pack44(wv[0], wv[1]);
#pragma unroll
                            for (int p = 0; p < 4; ++p) { const bf16_t* xp = XBCT + ((size_t)chunk * 1280 + h * 64 + 16 * p + r16) * 128 + 32 * ss + 4 * fq;
                                acc1[p] = MFMA16(ld8x2(xp, xp + 16), wp, acc1[p]); }
                        }
#pragma unroll
                        for (int ks = 0; ks < 4; ++ks)
#pragma unroll
                            for (int p = 0; p < 4; ++p) acc2[p] = MFMA16(ld16(SST + ((size_t)chunk * 16 + h) * 8192 + (16 * p + r16) * 128 + ks * 32 + fq * 8), cf[ks], acc2[p]);
                        const float dsk = d_skip[l * 16 + h];
#pragma unroll
                        for (int p = 0; p < 4; ++p) { const int pc = h * 64 + 16 * p + 4 * fq;
                            const f32x4 xv = unpack4(*(const u32x2*)(XBC + (size_t)tl * 1536 + pc)), zv = unpack4(*(const u32x2*)(P1 + (size_t)tl * NP1 + C_MZ + pc));
                            f32x4 y = acc1[p] + acc2[p] * el + xv * dsk;
                            y = (f32x4){y[0] * silu(zv[0]), y[1] * silu(zv[1]), y[2] * silu(zv[2]), y[3] * silu(zv[3])};
                            ssq += y[0] * y[0] + y[1] * y[1] + y[2] * y[2] + y[3] * y[3];
                            *(u32x2*)(OUT + (size_t)tl * 1024 + pc) = pack4(y); }
                    }
                    ssq += __shfl_xor(ssq, 16); ssq += __shfl_xor(ssq, 32);
                    const float rs = rsqrtf(ssq * (1.f / 512.f) + EPS);
                    asm volatile("s_waitcnt vmcnt(0)" ::: "memory");
                    for (int hh = 0; hh < 8; ++hh)
#pragma unroll
                        for (int p = 0; p < 4; ++p) { const int pc = (g * 8 + hh) * 64 + 16 * p + 4 * fq; bf16_t* op = OUT + (size_t)tl * 1024 + pc;
                            const f32x4 nw = *(const f32x4*)(ssm_norm + l * 1024 + pc); *(u32x2*)op = pack4(unpack4(*(const u32x2*)op) * nw * rs); }
                    continue; }
                it -= N_S;
                { LANEIDS
                    const int gc = it >> 2, h = it & 3, b = gc >> 6, c = gc & 63, bh = b * 4 + h, t0 = gc * 64;
                    const int itl = wave & 3, eh = wave >> 2, ti = t0 + 16 * itl + r16, ipos = 16 * itl + r16;
                    LAS float* sSS = (LAS float*)(lds + MISC_OFF + 64);
                    bf16x8 qf[4];
#pragma unroll
                    for (int ks = 0; ks < 4; ++ks) qf[ks] = ld16(P1 + (size_t)ti * NP1 + C_GQ + h * 128 + ks * 32 + fq * 8);
                    f32x4 aacc[4];
#pragma unroll
                    for (int mt = 0; mt < 4; ++mt) { aacc[mt] = (f32x4){0.f, 0.f, 0.f, 0.f};
                        if (mt <= itl) {
#pragma unroll
                            for (int ks = 0; ks < 4; ++ks) aacc[mt] = MFMA16(ld16(P1 + (size_t)(t0 + 16 * mt + r16) * NP1 + C_GK + h * 128 + ks * 32 + fq * 8), qf[ks], aacc[mt]);
#pragma unroll
                            for (int j = 0; j < 4; ++j) if (16 * mt + 4 * fq + j > ipos) aacc[mt][j] = 0.f; } }
                    bf16x8 wp[2]; wp[0] = pack44(aacc[0], aacc[1]); wp[1] = pack44(aacc[2], aacc[3]);
                    f32x4 oacc[8]; float ssq = 0.f;
#pragma unroll
                    for (int et = 0; et < 8; ++et) { const int e = 16 * (8 * eh + et) + r16; f32x4 o = {0.f, 0.f, 0.f, 0.f};
#pragma unroll
                        for (int ss = 0; ss < 2; ++ss) if (2 * ss <= itl) { const bf16_t* vp = VTG + ((size_t)gc * 1024 + h * 256 + e) * 64 + 32 * ss + 4 * fq; o = MFMA16(ld8x2(vp, vp + 16), wp[ss], o); }
#pragma unroll
                        for (int ks = 0; ks < 4; ++ks) o = MFMA16(ld16(GST + (((size_t)bh * 64 + c) * 256 + e) * 128 + ks * 32 + fq * 8), qf[ks], o);
                        oacc[et] = o; ssq += o[0] * o[0] + o[1] * o[1] + o[2] * o[2] + o[3] * o[3]; }
                    ssq += __shfl_xor(ssq, 16); ssq += __shfl_xor(ssq, 32);
                    if (fq == 0) sSS[eh * 64 + ipos] = ssq;
                    __syncthreads();
                    const float rs = rsqrtf((sSS[ipos] + sSS[64 + ipos]) * (1.f / 256.f) + EPS);
#pragma unroll
                    for (int et = 0; et < 8; ++et) { const int e0 = 16 * (8 * eh + et) + 4 * fq;
                        const f32x4 gv = unpack4(*(const u32x2*)(P1 + (size_t)ti * NP1 + C_GG + h * 256 + e0)), nw = *(const f32x4*)(gla_norm + l * 256 + e0);
                        f32x4 o = oacc[et] * nw * rs; o = (f32x4){o[0] * silu(gv[0]), o[1] * silu(gv[1]), o[2] * silu(gv[2]), o[3] * silu(gv[3])};
                        *(u32x2*)(OUT + ((size_t)2 * T_ + ti) * 1024 + h * 256 + e0) = pack4(o); }
                }
            }
        } else if (kph == 5 && (PHMASK >> 5 & 1)) {
            pg8::MergeOrder S{(const char*)OUT, (const char*)(WBT + (size_t)l * 8192 * 1024), G, bid};
            pg8::EpiMerge E{PM, MIXF, MIXB};
            pg8::gemm_phase(lds, 1024, 1024, 1024, S, E);
        } else if (kph == 6 && (PHMASK >> 6 & 1)) {
            pg8::PlainOrder S{(const char*)MIXB, (const char*)(WOT + (size_t)l * 2048 * 2048), 64, 8, G, bid, (size_t)256 * 2048 * 2, (size_t)256 * 2048 * 2};
            pg8::EpiOut E{Y};
            pg8::gemm_phase(lds, 2048, 2048, 2048, S, E);
        }
    }
}
__global__ void __launch_bounds__(512, 2) mk_fwd(Args args) {
    extern __shared__ __attribute__((aligned(16))) unsigned char lds_raw[];
    LAS unsigned char* lds = (LAS unsigned char*)lds_raw;
    const int lo = args.ph_lo, hi = args.ph_hi;
    volatile LAS unsigned* xst = (volatile LAS unsigned*)(lds + MISC_OFF + 16);
    if (threadIdx.x == 0) { xst[0] = 0u; xst[1] = 0u; }
    __syncthreads();
    XcdBarrier xb; xb.bar = (unsigned*)(args.ws + O_CTL) + 4096; xb.x = 0; xb.st = xst;
    if (hi - lo > 1) xb = xcd_barrier_post((unsigned*)(args.ws + O_CTL) + 4096, xst);
#define SEAM(k) do { if ((k) == 0) cg::this_grid().sync(); else xcd_barrier(xb); } while (0)
#define PH(k) if (lo <= (k) && (k) < hi) { phase_body((k), lds); if ((k) > 0 && (((k) - 1) & 7) == REP_KPH) { cg::this_grid().sync(); phase_body((k), lds, 1); } if ((k) + 1 < hi) SEAM(k); }
    PH(0) PH(1) PH(2) PH(3) PH(4) PH(5) PH(6) PH(7) PH(8) PH(9) PH(10) PH(11) PH(12) PH(13) PH(14) PH(15) PH(16)
#undef PH
#undef SEAM
}

extern "C" void kernel_launch(void* const* d_in, const int* in_sizes, int n_in, void* d_out, int out_size, void* d_ws, size_t ws_size, hipStream_t stream) {
    static int grid = 0;
    if (grid == 0) {
        if (n_in != 21 || ws_size < WS_END) { fprintf(stderr, "kernel_launch: unexpected n_in %d or ws_size %zu (< %zu)\n", n_in, ws_size, (size_t)WS_END); }
        int dev = 0, cus = 0, per_cu = 0;
        hipGetDevice(&dev); hipDeviceGetAttribute(&cus, hipDeviceAttributeMultiprocessorCount, dev);
        hipFuncSetAttribute((const void*)mk_fwd, hipFuncAttributeMaxDynamicSharedMemorySize, LDS_BYTES);
        hipOccupancyMaxActiveBlocksPerMultiprocessor(&per_cu, (const void*)mk_fwd, 512, LDS_BYTES);
        if (per_cu < 1) { fprintf(stderr, "kernel_launch: occupancy query says %d blocks/CU\n", per_cu); per_cu = 1; }
        (void)hipGetLastError();
        grid = cus * 1;
        if (grid <= 0) grid = 256;
    }
    Args a{};
    for (int i = 0; i < 21; ++i) a.in[i] = d_in[i];
    a.out = (float*)d_out; a.ws = (unsigned char*)d_ws;
#if MK_SINGLE
    a.ph_lo = 0; a.ph_hi = NPHASE;
    (void)hipMemsetAsync((char*)d_ws + O_CTL + 4096 * 4, 0, XCD_BAR_WORDS * 4, stream);
    void* kargs[] = {&a};
    hipError_t e = hipLaunchCooperativeKernel((const void*)mk_fwd, dim3(grid), dim3(512), kargs, LDS_BYTES, stream);
    if (e != hipSuccess) fprintf(stderr, "cooperative launch failed: %s (grid %d)\n", hipGetErrorString(e), grid);
#else
    for (int ph = 0; ph < NPHASE; ++ph) { a.ph_lo = ph; a.ph_hi = ph + 1;
        hipLaunchKernelGGL(mk_fwd, dim3(grid), dim3(512), LDS_BYTES, stream, a); }
#endif
}
```
